# Optimizing an MI355X kernel written in HIP

```python
import math
import jax, jax.numpy as jnp
from jax import lax
import numpy as np

D_MODEL = 2048
BATCH = 2
SEQ = 8192
DEPTH = 4

D_MIX = D_MODEL
POOL_WIDTH = D_MIX // 4
POOL_WINDOWS = (2, 4, 8, 16)
POOL_GROUP = POOL_WIDTH // len(POOL_WINDOWS)
SSD_WIDTH = D_MIX // 2
SSD_HEAD_DIM = 64
SSD_HEADS = SSD_WIDTH // SSD_HEAD_DIM
SSD_GROUPS = 2
SSD_STATE = 128
SSD_CONV = 4
SSD_CHUNK = 256
ATTN_WIDTH = D_MIX - POOL_WIDTH - SSD_WIDTH
ATTN_HEAD_DIM = 64
ATTN_HEADS = ATTN_WIDTH // ATTN_HEAD_DIM
ATTN_BLOCK = 128
XBC_WIDTH = SSD_WIDTH + 2 * SSD_GROUPS * SSD_STATE
IN_WIDTH = POOL_WIDTH + SSD_WIDTH + XBC_WIDTH + SSD_HEADS + 3 * ATTN_WIDTH
D_FF = ((8 * D_MODEL // 3 + 255) // 256) * 256
RMS_EPS = 1e-6

kernel_name = "hymba_pool_ssd_stickbreak_macaron"

F32 = jnp.float32


def rms_norm(x, g):
    xf = x.astype(F32)
    y = xf * lax.rsqrt(jnp.mean(xf * xf, axis=-1, keepdims=True) + RMS_EPS)
    return (y * g.astype(F32)).astype(x.dtype)


def swiglu(u, w_gate, w_up, w_down):
    a = jnp.einsum('bsd,df->bsf', u, w_gate)
    b = jnp.einsum('bsd,df->bsf', u, w_up)
    return jnp.einsum('bsf,fd->bsd', jax.nn.silu(a) * b, w_down)


def multiscale_pool(v, w_pool, scale):
    s_len = v.shape[1]
    vf = v.astype(F32)
    cs = jnp.cumsum(vf, axis=1)
    pos = jnp.arange(1, s_len + 1, dtype=F32)
    outs = []
    for i, w in enumerate(POOL_WINDOWS):
        sl = slice(i * POOL_GROUP, (i + 1) * POOL_GROUP)
        c = cs[..., sl]
        prev = jnp.pad(c, ((0, 0), (w, 0), (0, 0)))[:, :s_len]
        mean = (c - prev) / jnp.minimum(pos, float(w))[None, :, None]
        outs.append(jnp.einsum('bsc,cd->bsd', mean - vf[..., sl], w_pool[i].astype(F32)))
    return (jnp.concatenate(outs, axis=-1) * scale.astype(F32)).astype(v.dtype)


def causal_dwconv(x, w, b):
    k_len = w.shape[0]
    s_len = x.shape[1]
    xp = jnp.pad(x, ((0, 0), (k_len - 1, 0), (0, 0)))
    y = xp[:, 0:s_len] * w[0]
    for k in range(1, k_len):
        y = y + xp[:, k:k + s_len] * w[k]
    return y + b


def segsum_exp(a):
    t = a.shape[-1]
    strict = jnp.tril(jnp.ones((t, t), dtype=bool), -1)
    incl = jnp.tril(jnp.ones((t, t), dtype=bool))
    rep = jnp.where(strict, a[..., :, None], 0.0)
    ss = jnp.cumsum(rep, axis=-2)
    return jnp.where(incl, jnp.exp(ss), 0.0)


def ssd_chunked(X, A, Bm, Cm):
    b, s_len, h, p = X.shape
    pad = (-s_len) % SSD_CHUNK
    if pad:
        X = jnp.pad(X, ((0, 0), (0, pad), (0, 0), (0, 0)))
        A = jnp.pad(A, ((0, 0), (0, pad), (0, 0)))
        Bm = jnp.pad(Bm, ((0, 0), (0, pad), (0, 0), (0, 0)))
        Cm = jnp.pad(Cm, ((0, 0), (0, pad), (0, 0), (0, 0)))
    t_len = s_len + pad
    nc, L, g = t_len // SSD_CHUNK, SSD_CHUNK, SSD_GROUPS
    e = h // g
    n = Bm.shape[-1]
    X = X.reshape(b, nc, L, g, e, p)
    A = A.reshape(b, nc, L, g, e).transpose(0, 3, 4, 1, 2)
    Bm = Bm.reshape(b, nc, L, g, n)
    Cm = Cm.reshape(b, nc, L, g, n)
    A_cs = jnp.cumsum(A, axis=-1)
    decay_in = segsum_exp(A)
    CB = jnp.einsum('bclgn,bcsgn->bgcls', Cm, Bm)
    Y_diag = jnp.einsum('bgcls,bgecls,bcsgep->bclgep', CB, decay_in, X)
    decay_states = jnp.exp(A_cs[..., -1:] - A_cs)
    states = jnp.einsum('bclgn,bgecl,bclgep->bcgepn', Bm, decay_states, X)
    chunk_decay = jnp.moveaxis(jnp.exp(A_cs[..., -1]), -1, 0)
    states_c = jnp.moveaxis(states, 1, 0)

    def step(carry, inp):
        s_c, d_c = inp
        return carry * d_c[..., None, None] + s_c, carry

    init = jnp.zeros(states_c.shape[1:], dtype=states_c.dtype)
    _, states_in = lax.scan(step, init, (states_c, chunk_decay))
    Y_off = jnp.einsum('bclgn,cbgepn,bgecl->bclgep', Cm, states_in, jnp.exp(A_cs))
    Y = (Y_diag + Y_off).reshape(b, t_len, h, p)
    return Y[:, :s_len]


def ssd_mixer(z, xbc, dt_raw, conv_w, conv_b, dt_bias, a_log, d_skip, norm_g):
    bsz, s_len, _ = z.shape
    xbc = jax.nn.silu(causal_dwconv(xbc, conv_w, conv_b)).astype(F32)
    gn = SSD_GROUPS * SSD_STATE
    xs, Bm, Cm = jnp.split(xbc, [SSD_WIDTH, SSD_WIDTH + gn], axis=-1)
    xs = xs.reshape(bsz, s_len, SSD_HEADS, SSD_HEAD_DIM)
    Bm = Bm.reshape(bsz, s_len, SSD_GROUPS, SSD_STATE)
    Cm = Cm.reshape(bsz, s_len, SSD_GROUPS, SSD_STATE)
    dt = jax.nn.softplus(dt_raw.astype(F32) + dt_bias.astype(F32))
    A = -jnp.exp(a_log.astype(F32))
    y = ssd_chunked(xs * dt[..., None], A * dt, Bm, Cm)
    y = y + d_skip.astype(F32)[:, None] * xs
    y = y.reshape(bsz, s_len, SSD_WIDTH) * jax.nn.silu(z.astype(F32))
    yg = y.reshape(bsz, s_len, SSD_GROUPS, SSD_WIDTH // SSD_GROUPS)
    yg = yg * lax.rsqrt(jnp.mean(yg * yg, axis=-1, keepdims=True) + RMS_EPS)
    y = yg.reshape(bsz, s_len, SSD_WIDTH) * norm_g.astype(F32)
    return y.astype(z.dtype)


def stick_breaking_attention(q, k, v):
    bsz, s_len, nh, dh = q.shape
    nb = s_len // ATTN_BLOCK
    qf = (q.astype(F32) * (dh ** -0.5)).reshape(bsz, nb, ATTN_BLOCK, nh, dh).transpose(1, 0, 3, 2, 4)
    kf = k.astype(F32).transpose(0, 2, 1, 3)
    vf = v.astype(F32).transpose(0, 2, 1, 3)
    key_pos = jnp.arange(s_len, dtype=jnp.int32)
    starts = jnp.arange(nb, dtype=jnp.int32) * ATTN_BLOCK
    q_off = jnp.arange(ATTN_BLOCK, dtype=jnp.int32)

    def one_block(args):
        qb, q0 = args
        logits = jnp.einsum('bhqd,bhkd->bhqk', qb, kf)
        mask = key_pos[None, :] < (q0 + q_off)[:, None]
        log_1m = jnp.where(mask, jax.nn.log_sigmoid(-logits), 0.0)
        suffix = lax.cumsum(log_1m, axis=3, reverse=True) - log_1m
        weights = jnp.where(mask, jnp.exp(jax.nn.log_sigmoid(logits) + suffix), 0.0)
        return jnp.einsum('bhqk,bhkd->bhqd', weights, vf)

    out = lax.map(one_block, (qf, starts))
    return out.transpose(1, 0, 3, 2, 4).reshape(bsz, s_len, nh * dh).astype(q.dtype)


def hybrid_mixer(u, w_in, pool_w, pool_scale, conv_w, conv_b, dt_bias, a_log, d_skip, ssd_norm, w_out):
    bsz, s_len, _ = u.shape
    proj = jnp.einsum('bsd,dn->bsn', u, w_in)
    idx = np.cumsum([POOL_WIDTH, SSD_WIDTH, XBC_WIDTH, SSD_HEADS, ATTN_WIDTH, ATTN_WIDTH]).tolist()
    pool_in, z, xbc, dt_raw, q, k, v = jnp.split(proj, idx, axis=-1)
    pool_out = multiscale_pool(pool_in, pool_w, pool_scale)
    ssd_out = ssd_mixer(z, xbc, dt_raw, conv_w, conv_b, dt_bias, a_log, d_skip, ssd_norm)
    shp = (bsz, s_len, ATTN_HEADS, ATTN_HEAD_DIM)
    attn_out = stick_breaking_attention(q.reshape(shp), k.reshape(shp), v.reshape(shp))
    mixed = jnp.concatenate([pool_out, ssd_out, attn_out], axis=-1)
    return jnp.einsum('bsm,md->bsd', mixed, w_out)


def setup_inputs(seed: int = 0) -> dict:
    key = jax.random.key(seed)
    ks = jax.random.split(key, 24)

    def nrm(k, shape, scale):
        return jax.random.normal(k, shape, dtype=F32) * scale

    def gain(k, shape):
        return 1.0 + 0.02 * jax.random.normal(k, shape, dtype=F32)

    dt0 = jnp.exp(jax.random.uniform(ks[13], (DEPTH, SSD_HEADS), dtype=F32)
                  * (math.log(0.1) - math.log(0.001)) + math.log(0.001))
    return {
        "x": jax.random.normal(ks[0], (BATCH, SEQ, D_MODEL), dtype=F32),
        "ffn1_norm": gain(ks[1], (DEPTH, D_MODEL)),
        "ffn1_w_gate": nrm(ks[2], (DEPTH, D_MODEL, D_FF), D_MODEL ** -0.5),
        "ffn1_w_up": nrm(ks[3], (DEPTH, D_MODEL, D_FF), D_MODEL ** -0.5),
        "ffn1_w_down": nrm(ks[4], (DEPTH, D_FF, D_MODEL), D_FF ** -0.5),
        "mix_norm": gain(ks[5], (DEPTH, D_MODEL)),
        "w_in": nrm(ks[6], (DEPTH, D_MODEL, IN_WIDTH), D_MODEL ** -0.5),
        "pool_w": nrm(ks[7], (DEPTH, len(POOL_WINDOWS), POOL_GROUP, POOL_GROUP), POOL_GROUP ** -0.5),
        "pool_scale": gain(ks[8], (DEPTH, POOL_WIDTH)),
        "conv_w": nrm(ks[9], (DEPTH, SSD_CONV, XBC_WIDTH), SSD_CONV ** -0.5),
        "conv_b": nrm(ks[10], (DEPTH, XBC_WIDTH), 0.01),
        "dt_bias": dt0 + jnp.log(-jnp.expm1(-dt0)),
        "a_log": jnp.log(jax.random.uniform(ks[11], (DEPTH, SSD_HEADS), dtype=F32, minval=1.0, maxval=16.0)),
        "d_skip": 1.0 + 0.1 * jax.random.normal(ks[12], (DEPTH, SSD_HEADS), dtype=F32),
        "ssd_norm": gain(ks[14], (DEPTH, SSD_WIDTH)),
        "w_out": nrm(ks[15], (DEPTH, D_MIX, D_MODEL), D_MIX ** -0.5),
        "ffn2_norm": gain(ks[16], (DEPTH, D_MODEL)),
        "ffn2_w_gate": nrm(ks[17], (DEPTH, D_MODEL, D_FF), D_MODEL ** -0.5),
        "ffn2_w_up": nrm(ks[18], (DEPTH, D_MODEL, D_FF), D_MODEL ** -0.5),
        "ffn2_w_down": nrm(ks[19], (DEPTH, D_FF, D_MODEL), D_FF ** -0.5),
        "final_norm": gain(ks[20], (D_MODEL,)),
    }


def reference(x, ffn1_norm, ffn1_w_gate, ffn1_w_up, ffn1_w_down, mix_norm, w_in, pool_w, pool_scale,
              conv_w, conv_b, dt_bias, a_log, d_skip, ssd_norm, w_out, ffn2_norm, ffn2_w_gate,
              ffn2_w_up, ffn2_w_down, final_norm):
    h = x
    for l in range(DEPTH):
        u = rms_norm(h, ffn1_norm[l])
        h = h + 0.5 * swiglu(u, ffn1_w_gate[l], ffn1_w_up[l], ffn1_w_down[l])
        u = rms_norm(h, mix_norm[l])
        h = h + hybrid_mixer(u, w_in[l], pool_w[l], pool_scale[l], conv_w[l], conv_b[l], dt_bias[l],
                             a_log[l], d_skip[l], ssd_norm[l], w_out[l])
        u = rms_norm(h, ffn2_norm[l])
        h = h + 0.5 * swiglu(u, ffn2_w_gate[l], ffn2_w_up[l], ffn2_w_down[l])
    return rms_norm(h, final_norm)
```

```cpp
#include <hip/hip_runtime.h>
#include <cstdio>
#include <cstdint>
namespace pg8 {
#define PG8_LAS __attribute__((address_space(3)))
typedef unsigned short bf16_t;
typedef short bf16x8 __attribute__((ext_vector_type(8)));
typedef float f32x4 __attribute__((ext_vector_type(4)));
typedef unsigned u32x4 __attribute__((ext_vector_type(4)));
constexpr int BM = 256, BK = 64, HALF = 128, HTB = HALF * BK * 2  , STAGE_BYTES = 8 * HTB, NXCD = 8, WGM = 8;

__host__ __device__ __forceinline__ int lds_byte(int r, int c) { const int st = (r >> 4) * 2 + (c >> 5), rr = r & 15, cc = c & 31, ob = rr * 64 + cc * 2; return st * 1024 + (ob ^ (((ob >> 9) & 1) << 5)); }
__host__ __device__ __forceinline__ void stage_rc(int b, int& R, int& C) { const int st = b / 1024, sb = b % 1024, swz = sb ^ (((sb >> 9) & 1) << 5); R = (st >> 1) * 16 + swz / 64; C = (st & 1) * 32 + (swz % 64) / 2; }
__host__ __device__ __forceinline__ int perm32(int rho) { const int n = rho >> 4, i = rho & 15; return 8 * (i >> 2) + 4 * n + (i & 3); }

struct Unit { int pm, pn; };
struct Gemm { const bf16_t* A; const bf16_t* Bt; int M, N, K; };

struct StaticOrder {
    int nM, nN, nwg, G, c;
    __host__ __device__ void init(int M, int N, int G_, int c_) { nM = M / BM; nN = N / BM; nwg = nM * nN; G = G_; c = c_; }
    __host__ __device__ bool next(int i, Unit& u) const {
        const long L = (long)i * G + c; if (L >= nwg) return false;
        int wgid = (int)L; { const int q = nwg / NXCD, r = nwg % NXCD, xcd = wgid % NXCD, off = wgid / NXCD; wgid = (xcd < r ? xcd * (q + 1) : r * (q + 1) + (xcd - r) * q) + off; }
        const int nig = WGM * nN, gid = wgid / nig, fm = gid * WGM, gsz = (nM - fm) < WGM ? (nM - fm) : WGM;
        u.pm = fm + ((wgid % nig) % gsz); u.pn = (wgid % nig) / gsz; return true;
    }
    __device__ __forceinline__ void a_ready(const Unit&) const {}
    __device__ __forceinline__ void done(const Unit&) const {}
};

__device__ __forceinline__ unsigned cvt_pk_bf16(float lo, float hi) { unsigned r; asm volatile("v_cvt_pk_bf16_f32 %0, %1, %2" : "=v"(r) : "v"(lo), "v"(hi)); return r; }
__device__ __forceinline__ float fast_silu(float g) { return g * __builtin_amdgcn_rcpf(1.0f + __builtin_amdgcn_exp2f(-1.4426950408889634f * g)); }
struct EpiSwiGLU {
    static constexpr bool PERM = true, AFTER_DRAIN = false;
    bf16_t* O; int ldc; const PG8_LAS float* rstd;
    __device__ __forceinline__ void operator()(const f32x4 (&acc)[2][2][4][2], const Unit& u, int wr, int wc, int fr_, int fq_) const {
        int fr = fr_, fq = fq_; asm volatile("" : "+v"(fr), "+v"(fq));
        const int rl0 = wr * 64 + fr;
        bf16_t* base = O + (size_t)(u.pm * BM) * ldc + u.pn * HALF + wc * 32 + 8 * fq;
#pragma unroll
        for (int ai = 0; ai < 2; ++ai)
#pragma unroll
            for (int m = 0; m < 4; ++m) {
                const int rl = rl0 + ai * HALF + m * 16; const float r = rstd[rl];
                const f32x4 g0 = acc[ai][0][m][0] * r, g1 = acc[ai][0][m][1] * r, u0 = acc[ai][1][m][0] * r, u1 = acc[ai][1][m][1] * r;
                u32x4 w;
                w.x = cvt_pk_bf16(fast_silu(g0[0]) * u0[0], fast_silu(g0[1]) * u0[1]); w.y = cvt_pk_bf16(fast_silu(g0[2]) * u0[2], fast_silu(g0[3]) * u0[3]);
                w.z = cvt_pk_bf16(fast_silu(g1[0]) * u1[0], fast_silu(g1[1]) * u1[1]); w.w = cvt_pk_bf16(fast_silu(g1[2]) * u1[2], fast_silu(g1[3]) * u1[3]);
                *(u32x4*)(base + (size_t)rl * ldc) = w;
            }
    }
};
struct EpiResid {
    static constexpr bool PERM = true, AFTER_DRAIN = false;
    const float* Hin; float* Hout; bf16_t* Hb; float* part; float scale;
    __device__ __forceinline__ void operator()(const f32x4 (&acc)[2][2][4][2], const Unit& u, int wr, int wc, int fr_, int fq_) const {
        int fr = fr_, fq = fq_; asm volatile("" : "+v"(fr), "+v"(fq));
        const int row0 = u.pm * BM + wr * 64 + fr, col0 = u.pn * BM + wc * 32 + 8 * fq;
#pragma unroll
        for (int ai = 0; ai < 2; ++ai)
#pragma unroll
            for (int m = 0; m < 4; ++m) {
                const int row = row0 + ai * HALF + m * 16; float ss = 0.f;
#pragma unroll
                for (int bj = 0; bj < 2; ++bj) {
                    const size_t off = (size_t)row * 2048 + col0 + bj * HALF;
                    const f32x4 h0 = *(const f32x4*)(Hin + off), h1 = *(const f32x4*)(Hin + off + 4);
                    const f32x4 v0 = h0 + acc[ai][bj][m][0] * scale, v1 = h1 + acc[ai][bj][m][1] * scale;
                    *(f32x4*)(Hout + off) = v0; *(f32x4*)(Hout + off + 4) = v1;
                    u32x4 w; w.x = cvt_pk_bf16(v0[0], v0[1]); w.y = cvt_pk_bf16(v0[2], v0[3]); w.z = cvt_pk_bf16(v1[0], v1[1]); w.w = cvt_pk_bf16(v1[2], v1[3]);
                    *(u32x4*)(Hb + off) = w;
                    ss += (v0[0] * v0[0] + v0[1] * v0[1]) + (v0[2] * v0[2] + v0[3] * v0[3]) + (v1[0] * v1[0] + v1[1] * v1[1]) + (v1[2] * v1[2] + v1[3] * v1[3]);
                }
                ss += __shfl_xor(ss, 16); ss += __shfl_xor(ss, 32);
                if (fq == 0) part[(size_t)row * 32 + u.pn * 4 + wc] = ss;
            }
    }
};
struct EpiProj {
    static constexpr bool PERM = true, AFTER_DRAIN = false;
    bf16_t* O; float* dtraw; const PG8_LAS float* rstd;
    __device__ __forceinline__ void operator()(const f32x4 (&acc)[2][2][4][2], const Unit& u, int wr, int wc, int fr_, int fq_) const {
        int fr = fr_, fq = fq_; asm volatile("" : "+v"(fr), "+v"(fq));
        const int rl0 = wr * 64 + fr;
        if (u.pn < 18) {
            bf16_t* base = O + (size_t)(u.pm * BM) * 4608 + u.pn * BM + wc * 32 + 8 * fq;
#pragma unroll
            for (int ai = 0; ai < 2; ++ai)
#pragma unroll
                for (int m = 0; m < 4; ++m) {
                    const int rl = rl0 + ai * HALF + m * 16; const float r = rstd[rl];
#pragma unroll
                    for (int bj = 0; bj < 2; ++bj) {
                        const f32x4 v0 = acc[ai][bj][m][0] * r, v1 = acc[ai][bj][m][1] * r;
                        u32x4 w; w.x = cvt_pk_bf16(v0[0], v0[1]); w.y = cvt_pk_bf16(v0[2], v0[3]); w.z = cvt_pk_bf16(v1[0], v1[1]); w.w = cvt_pk_bf16(v1[2], v1[3]);
                        *(u32x4*)(base + (size_t)rl * 4608 + bj * HALF) = w;
                    }
                }
        } else if (wc == 0 && fq < 2) {
#pragma unroll
            for (int ai = 0; ai < 2; ++ai)
#pragma unroll
                for (int m = 0; m < 4; ++m) {
                    const int rl = rl0 + ai * HALF + m * 16; const float r = rstd[rl];
                    float* d = dtraw + (size_t)(u.pm * BM + rl) * 16 + 8 * fq;
                    *(f32x4*)d = acc[ai][0][m][0] * r; *(f32x4*)(d + 4) = acc[ai][0][m][1] * r;
                }
        }
    }
};
template <class Epi, class Sched, bool ALIGN_EPI = false, bool SP2 = false>
__device__ __forceinline__ void gemm_phase(PG8_LAS unsigned char* lds, const Gemm g, const Sched& S, const Epi& E) {
    int tid_ = threadIdx.x; asm volatile("" : "+v"(tid_));
    const int tid = tid_, wid = __builtin_amdgcn_readfirstlane(tid >> 6), lane = tid & 63, wr = wid >> 2, wc = wid & 3, fr = lane & 15, fq = lane >> 4;
    const int K = g.K, nt = K / BK;
    unsigned voffA[2], voffB[2];
#pragma unroll
    for (int i = 0; i < 2; ++i) { int R, C; stage_rc(tid * 16 + i * 8192, R, C); const int Rb = Epi::PERM ? ((R & ~31) + perm32(R & 31)) : R;
        voffA[i] = (unsigned)(R * K + C) * 2u; voffB[i] = (unsigned)(Rb * K + C) * 2u; }
    const size_t kstep = (size_t)(BK * 2);
    const size_t hstep = (size_t)HALF * K * 2;
    const size_t tstep = 2 * hstep;
    const unsigned ldsw = (unsigned)wid * 1024u;
    const int aoff = lds_byte(wr * 64 + fr, fq * 8), boff = lds_byte(wc * 32 + fr, fq * 8);
#define PG8_SA(b, h) (((b) * 2 + (h)) * HTB)
#define PG8_SB(b, h) ((4 + (b) * 2 + (h)) * HTB)
#define PG8_STAGE(bufoff, gbase, voff) do { _Pragma("unroll") for (int _i = 0; _i < 2; ++_i) \
        __builtin_amdgcn_global_load_lds((const unsigned*)((const char*)(gbase) + (voff)[_i]), (PG8_LAS unsigned*)(lds + (bufoff) + ldsw + _i * 8192), 16, 0, 0); } while (0)
#define PG8_LDA(dst, b, h) do { _Pragma("unroll") for (int m = 0; m < 4; ++m) _Pragma("unroll") for (int k = 0; k < 2; ++k) dst[m][k] = *(const PG8_LAS bf16x8*)(lds + PG8_SA(b, h) + aoff + m * 2048 + k * 1024); } while (0)
#define PG8_LDB(dst, b, h) do { _Pragma("unroll") for (int n = 0; n < 2; ++n) _Pragma("unroll") for (int k = 0; k < 2; ++k) dst[n][k] = *(const PG8_LAS bf16x8*)(lds + PG8_SB(b, h) + boff + n * 2048 + k * 1024); } while (0)
#define PG8_MMA(ai, bj, At, Bt) do { __builtin_amdgcn_s_setprio(1); _Pragma("unroll") for (int m = 0; m < 4; ++m) _Pragma("unroll") for (int n = 0; n < 2; ++n) _Pragma("unroll") for (int k = 0; k < 2; ++k) \
        acc[ai][bj][m][n] = __builtin_amdgcn_mfma_f32_16x16x32_bf16(Bt[n][k], At[m][k], acc[ai][bj][m][n], 0, 0, 0); __builtin_amdgcn_s_setprio(0); } while (0)
#define PG8_WAIT_V(n) asm volatile("s_waitcnt vmcnt(" #n ")" ::: "memory")
#define PG8_WAIT_L(n) asm volatile("s_waitcnt lgkmcnt(" #n ")" ::: "memory")
#define PG8_BAR __builtin_amdgcn_s_barrier()
#define PG8_SCHED __builtin_amdgcn_sched_barrier(0)
    Unit cur, nxt; int ui = 0;
    if (!S.next(0, cur)) return;
    f32x4 acc[2][2][4][2];
#pragma unroll
    for (int a = 0; a < 2; ++a)
#pragma unroll
        for (int b = 0; b < 2; ++b)
#pragma unroll
            for (int m = 0; m < 4; ++m)
#pragma unroll
                for (int n = 0; n < 2; ++n) acc[a][b][m][n] = (f32x4){0.f, 0.f, 0.f, 0.f};
    bf16x8 At[4][2], B0[2][2], B1[2][2];
    const char* cA = (const char*)g.A + (size_t)cur.pm * tstep; const char* cB = (const char*)g.Bt + (size_t)cur.pn * tstep;
    S.a_ready(cur);
    if constexpr (SP2) {
        PG8_STAGE(PG8_SB(0, 0), cB, voffB); PG8_STAGE(PG8_SB(0, 1), cB + hstep, voffB); PG8_STAGE(PG8_SA(0, 0), cA, voffA); PG8_STAGE(PG8_SA(0, 1), cA + hstep, voffA);
        if (wr == 1) PG8_BAR;
        PG8_WAIT_V(2); PG8_BAR;
        PG8_STAGE(PG8_SB(1, 0), cB + kstep, voffB); PG8_STAGE(PG8_SA(1, 0), cA + kstep, voffA); PG8_STAGE(PG8_SB(1, 1), cB + hstep + kstep, voffB);
        PG8_WAIT_V(6); PG8_BAR;
    } else {
        PG8_STAGE(PG8_SB(0, 0), cB, voffB); PG8_STAGE(PG8_SA(0, 0), cA, voffA); PG8_STAGE(PG8_SB(0, 1), cB + hstep, voffB); PG8_STAGE(PG8_SA(0, 1), cA + hstep, voffA);
        if (wr == 1) PG8_BAR;
        PG8_WAIT_V(4); PG8_BAR;
        PG8_STAGE(PG8_SB(1, 0), cB + kstep, voffB); PG8_STAGE(PG8_SA(1, 0), cA + kstep, voffA); PG8_STAGE(PG8_SB(1, 1), cB + hstep + kstep, voffB);
        PG8_WAIT_V(6); PG8_BAR;
    }
    for (;;) {
        const bool has_next = S.next(ui + 1, nxt);
        const char* nA = has_next ? (const char*)g.A + (size_t)nxt.pm * tstep : cA; const char* nB = has_next ? (const char*)g.Bt + (size_t)nxt.pn * tstep : cB;
        for (int t = 0; t < nt; t += 2) {
            const bool last = (t == nt - 2);
            const char* a1 = cA + (size_t)(t + 1) * kstep;
            const char* a2 = last ? nA : cA + (size_t)(t + 2) * kstep; const char* b2 = last ? nB : cB + (size_t)(t + 2) * kstep;
            const char* a3 = a2 + kstep; const char* b3 = b2 + kstep;
            if (last && has_next) S.a_ready(nxt);
            if constexpr (SP2) {
            PG8_LDB(B0, 0, 0); PG8_LDB(B1, 0, 1); PG8_SCHED; PG8_LDA(At, 0, 0); PG8_STAGE(PG8_SA(1, 1), a1 + hstep, voffA);
            PG8_WAIT_V(8); PG8_WAIT_L(0); PG8_BAR; PG8_MMA(0, 0, At, B0); PG8_MMA(0, 1, At, B1); PG8_BAR; PG8_SCHED;
            PG8_LDA(At, 0, 1); PG8_STAGE(PG8_SB(0, 0), b2, voffB); PG8_STAGE(PG8_SB(0, 1), b2 + hstep, voffB); PG8_STAGE(PG8_SA(0, 0), a2, voffA);
            PG8_WAIT_V(8); PG8_WAIT_L(0); PG8_BAR; PG8_MMA(1, 0, At, B0); PG8_MMA(1, 1, At, B1); PG8_BAR; PG8_SCHED;
            PG8_LDB(B0, 1, 0); PG8_LDB(B1, 1, 1); PG8_SCHED; PG8_LDA(At, 1, 0); PG8_STAGE(PG8_SA(0, 1), a2 + hstep, voffA);
            PG8_WAIT_V(8); PG8_WAIT_L(0); PG8_BAR; PG8_MMA(0, 0, At, B0); PG8_MMA(0, 1, At, B1); PG8_BAR; PG8_SCHED;
            PG8_LDA(At, 1, 1); PG8_STAGE(PG8_SB(1, 0), b3, voffB); PG8_STAGE(PG8_SB(1, 1), b3 + hstep, voffB); PG8_STAGE(PG8_SA(1, 0), a3, voffA);
            PG8_WAIT_V(8); PG8_WAIT_L(0); PG8_BAR; PG8_MMA(1, 0, At, B0); PG8_MMA(1, 1, At, B1); PG8_BAR; PG8_SCHED;
            } else {
            PG8_LDB(B0, 0, 0); PG8_SCHED; PG8_LDA(At, 0, 0); PG8_STAGE(PG8_SA(1, 1), a1 + hstep, voffA);
            PG8_WAIT_L(8); PG8_BAR; PG8_WAIT_L(0); PG8_MMA(0, 0, At, B0); PG8_BAR; PG8_SCHED;
            PG8_LDB(B1, 0, 1); PG8_STAGE(PG8_SB(0, 0), b2, voffB);
            PG8_BAR; PG8_WAIT_L(0); PG8_MMA(0, 1, At, B1); PG8_BAR;
            PG8_LDA(At, 0, 1); PG8_STAGE(PG8_SA(0, 0), a2, voffA);
            PG8_BAR; PG8_WAIT_L(0); PG8_MMA(1, 0, At, B0); PG8_BAR; PG8_SCHED;
            PG8_STAGE(PG8_SB(0, 1), b2 + hstep, voffB);
            PG8_WAIT_V(6); PG8_BAR; PG8_MMA(1, 1, At, B1); PG8_BAR;
            PG8_LDB(B0, 1, 0); PG8_SCHED; PG8_LDA(At, 1, 0); PG8_STAGE(PG8_SA(0, 1), a2 + hstep, voffA);
            PG8_WAIT_L(8); PG8_BAR; PG8_WAIT_L(0); PG8_MMA(0, 0, At, B0); PG8_BAR; PG8_SCHED;
            PG8_LDB(B1, 1, 1); PG8_STAGE(PG8_SB(1, 0), b3, voffB);
            PG8_BAR; PG8_WAIT_L(0); PG8_MMA(0, 1, At, B1); PG8_BAR;
            PG8_LDA(At, 1, 1); PG8_STAGE(PG8_SA(1, 0), a3, voffA);
            PG8_BAR; PG8_WAIT_L(0); PG8_MMA(1, 0, At, B0); PG8_BAR; PG8_SCHED;
            PG8_STAGE(PG8_SB(1, 1), b3 + hstep, voffB);
            PG8_WAIT_V(6); PG8_BAR; PG8_MMA(1, 1, At, B1); PG8_BAR;
            }
        }
        if constexpr (ALIGN_EPI) { if (wr == 0) PG8_BAR; }
        if constexpr (!Epi::AFTER_DRAIN) { E(acc, cur, wr, wc, fr, fq); S.done(cur); }
        if (!has_next) break;
#pragma unroll
        for (int a = 0; a < 2; ++a)
#pragma unroll
            for (int b = 0; b < 2; ++b)
#pragma unroll
                for (int m = 0; m < 4; ++m)
#pragma unroll
                    for (int n = 0; n < 2; ++n) acc[a][b][m][n] = (f32x4){0.f, 0.f, 0.f, 0.f};
        cur = nxt; cA = nA; cB = nB; ++ui;
        if constexpr (ALIGN_EPI) { if (wr == 1) PG8_BAR; }
    }
    PG8_WAIT_V(0);
    if constexpr (!ALIGN_EPI) { if (wr == 0) PG8_BAR; }
    PG8_BAR;
    if constexpr (Epi::AFTER_DRAIN) { E.fused(acc, cur, wr, wc, fr, fq, lds, wid, lane); S.done(cur); }
#undef PG8_SA
#undef PG8_SB
#undef PG8_STAGE
#undef PG8_LDA
#undef PG8_LDB
#undef PG8_MMA
#undef PG8_WAIT_V
#undef PG8_WAIT_L
#undef PG8_BAR
#undef PG8_SCHED
}
}
#define GAS __attribute__((address_space(1)))
#define LAS __attribute__((address_space(3)))
typedef unsigned short bf16;
typedef unsigned v4u __attribute__((ext_vector_type(4)));
typedef float f32x4 __attribute__((ext_vector_type(4)));
typedef short bf16x8 __attribute__((ext_vector_type(8)));
typedef GAS unsigned gu32;
typedef GAS unsigned long long gu64;
#define RLX_AGENT __ATOMIC_RELAXED, __HIP_MEMORY_SCOPE_AGENT
#define LDS_WAIT() asm volatile("s_waitcnt lgkmcnt(0)" ::: "memory")
#define VM_WAIT() asm volatile("s_waitcnt vmcnt(0)" ::: "memory")
__device__ __forceinline__ unsigned long long rt() { return __builtin_amdgcn_s_memrealtime(); }
__device__ __forceinline__ unsigned f2bf(float f) { unsigned u = __builtin_bit_cast(unsigned, f); return (u + 0x7fffu + ((u >> 16) & 1u)) >> 16; }
__device__ __forceinline__ unsigned pk2(float lo, float hi) { return f2bf(lo) | (f2bf(hi) << 16); }

#define XB_TMO      128
#define XB_XCNT(j)  (256  + 64 * (j))
#define XB_XSUB(j)  (1280 + 64 * (j))
#define XB_XGEN(j)  (2304 + 64 * (j))
#define XB_TOP      3328
#define XB_TOPGEN   3392
#define XCD_BAR_WORDS 3456
#define XB_SPIN_CAP (1u << 18)

__device__ __forceinline__ unsigned xb_ld(unsigned* p)              { return __hip_atomic_load(p, __ATOMIC_RELAXED, __HIP_MEMORY_SCOPE_AGENT); }
__device__ __forceinline__ unsigned xb_add(unsigned* p, unsigned v) { return __hip_atomic_fetch_add(p, v, __ATOMIC_RELAXED, __HIP_MEMORY_SCOPE_AGENT); }
__device__ __forceinline__ unsigned xb_xcc_id() { return (unsigned)__builtin_amdgcn_s_getreg((3 << 11) | 20) & 0xFu; }
#define XB_SPIN(cond, bar) do { unsigned _sp = 0; while (cond) { __builtin_amdgcn_s_sleep(1); \
    if ((++_sp & 255u) == 0u) { if (xb_ld(&(bar)[XB_TMO])) break; if (_sp > XB_SPIN_CAP) { atomicAdd(&(bar)[XB_TMO], 1u); break; } } } } while (0)

struct XcdBarrier {
    unsigned* bar; unsigned x;
    volatile LAS unsigned* st;
};

__device__ __forceinline__ XcdBarrier xcd_barrier_post(unsigned* bar, volatile LAS unsigned* st) {
    XcdBarrier b; b.bar = bar; b.x = xb_xcc_id(); b.st = st;
    if (threadIdx.x == 0) (void)xb_add(&bar[XB_XCNT(b.x)], 1u);
    return b;
}
__device__ __forceinline__ void xcd_barrier_complete(unsigned* bar, unsigned x, unsigned& nloc, unsigned& nx) {
    const unsigned G = gridDim.x * gridDim.y * gridDim.z;
    unsigned sum, cnt, mine, sp = 0u;
    for (;;) {
        sum = 0u; cnt = 0u; mine = 0u;
#pragma unroll
        for (unsigned j = 0; j < 16; ++j) { const unsigned c = xb_ld(&bar[XB_XCNT(j)]); sum += c; cnt += (c > 0u) ? 1u : 0u; mine = (j == x) ? c : mine; }
        if (sum == G) break;
        __builtin_amdgcn_s_sleep(1);
        if ((++sp & 255u) == 0u) { if (xb_ld(&bar[XB_TMO])) break; if (sp > XB_SPIN_CAP) { atomicAdd(&bar[XB_TMO], 1u); break; } }
    }
    nloc = mine > 0u ? mine : 1u; nx = cnt > 0u ? cnt : 1u;
}

__device__ __forceinline__ void xcd_barrier(const XcdBarrier& b) {
    asm volatile("s_waitcnt vmcnt(0)" ::: "memory");
    __syncthreads();
    if (threadIdx.x == 0) {
        unsigned* bar = b.bar;
        __builtin_amdgcn_s_waitcnt(0);
        unsigned nloc = b.st[0], nx = b.st[1];
        if (nloc == 0u) { xcd_barrier_complete(bar, b.x, nloc, nx); b.st[0] = nloc; b.st[1] = nx; }
        const unsigned old = xb_add(&bar[XB_XSUB(b.x)], 1u);
        const unsigned gen = old / nloc;
        if (old + 1u == (gen + 1u) * nloc) {
            __builtin_amdgcn_fence(__ATOMIC_RELEASE, "agent");
            asm volatile("s_waitcnt vmcnt(0)" ::: "memory");
            const unsigned og = xb_add(&bar[XB_TOP], 1u);
            const unsigned tg = og / nx;
            if (og + 1u == (tg + 1u) * nx) xb_add(&bar[XB_TOPGEN], 1u);
            else XB_SPIN(xb_ld(&bar[XB_TOPGEN]) == tg, bar);
            __builtin_amdgcn_fence(__ATOMIC_ACQUIRE, "agent");
            xb_add(&bar[XB_XGEN(b.x)], 1u);
            asm volatile("s_waitcnt vmcnt(0)" ::: "memory");
        } else {
            XB_SPIN(xb_ld(&bar[XB_XGEN(b.x)]) == gen, bar);
            __builtin_amdgcn_fence(__ATOMIC_ACQUIRE, "agent");
            asm volatile("s_waitcnt vmcnt(0)" ::: "memory");
        }
    }
    __syncthreads();
}

constexpr int NWAVES = 8;
constexpr int BATCH = 2, SEQ = 8192, M = BATCH * SEQ, D = 2048, FF = 5632, NGU = 2 * FF, DEPTH = 4;
constexpr int NIN = 4864, PROJ_LD = 4608;
constexpr int P_POOL = 0, P_Z = 512, P_XBC = 1536, P_Q = 3072, P_K = 3584, P_V = 4096;
constexpr int IN_W = 4624;
constexpr float RMS_EPS = 1e-6f;
constexpr int GRID = 256;

constexpr size_t MiB = 1u << 20;
constexpr size_t WS_CTL = 0, CTL_ZERO_BYTES = 1 * MiB;
constexpr size_t WS_WGU = 2 * MiB;        constexpr size_t WGU_STRIDE = (size_t)NGU * D;
constexpr size_t WS_WD = 354 * MiB;       constexpr size_t WD_STRIDE = (size_t)D * FF;
constexpr size_t WS_WIN = 530 * MiB;      constexpr size_t WIN_STRIDE = (size_t)NIN * D;
constexpr size_t WS_WOUT = 606 * MiB;     constexpr size_t WOUT_STRIDE = (size_t)D * D;
constexpr size_t WS_H = 638 * MiB, WS_HB = 766 * MiB, WS_PART = 830 * MiB, WS_DTRAW = 832 * MiB, WS_DT = 833 * MiB;
constexpr size_t WS_X = 834 * MiB;
constexpr size_t WS_ACT = WS_X;
constexpr size_t WS_PROJ = WS_X, WS_MIXED = WS_X + 144 * MiB, WS_XC = WS_X + 208 * MiB, WS_Y = WS_X + 304 * MiB;
constexpr size_t WS_END = WS_X + 368 * MiB;
static_assert(WS_WGU + 8 * WGU_STRIDE * 2 <= WS_WD && WS_WD + 8 * WD_STRIDE * 2 <= WS_WIN && WS_WIN + 4 * WIN_STRIDE * 2 <= WS_WOUT && WS_WOUT + 4 * WOUT_STRIDE * 2 <= WS_H, "ws map: weights");
static_assert(WS_H + (size_t)M * D * 4 <= WS_HB && WS_HB + (size_t)M * D * 2 <= WS_PART && WS_PART + (size_t)M * 32 * 4 <= WS_DTRAW && WS_DTRAW + (size_t)M * 16 * 4 <= WS_DT && WS_DT + (size_t)M * 16 * 4 <= WS_X, "ws map: state");
static_assert(WS_ACT + (size_t)M * FF * 2 <= WS_END && WS_PROJ + (size_t)M * PROJ_LD * 2 <= WS_MIXED && WS_MIXED + (size_t)M * D * 2 <= WS_XC && WS_XC + (size_t)M * 1536 * 4 <= WS_Y && WS_Y + (size_t)M * 1024 * 4 <= WS_END, "ws map: overlay");
constexpr int CW_BAR = 4096;

constexpr int RING_OFF = 0, RING_BYTES = 131072;
constexpr int LDSCTL_OFF = RING_BYTES, MISC_OFF = LDSCTL_OFF + 320, RSTD_OFF = LDSCTL_OFF + 1024;
constexpr int LDS_BYTES = 147456;
static_assert(RSTD_OFF + 1024 <= LDS_BYTES, "LDS map");

struct Args { const float* in[21]; float* out; unsigned char* ws; int ph_lo, ph_hi; };
static_assert(sizeof(Args) == 21 * 8 + 8 + 8 + 8, "Args has no padding");

__device__ __forceinline__ float bf2f(bf16 b) { return __builtin_bit_cast(float, (unsigned)b << 16); }
__device__ __forceinline__ float wave_sum(float v) {
#pragma unroll
    for (int o = 1; o < 64; o <<= 1) v += __shfl_xor(v, o);
    return v;
}
__device__ __forceinline__ float softplus_f(float z) { return fmaxf(z, 0.f) + __logf(1.0f + __expf(-fabsf(z))); }
__device__ __forceinline__ float silu_f(float z) { return z / (1.0f + __expf(-z)); }

__device__ __forceinline__ void transpose_item(const float* W, int K, int N, const float* gain, bf16* WT, int drow0, int scol, int k0, LAS float* scr, int lane) {
#pragma unroll 8
    for (int i = 0; i < 32; ++i) { const int kk = 2 * i + (lane >> 5); scr[kk * 33 + (lane & 31)] = (scol >= 0) ? W[(size_t)(k0 + kk) * N + scol] : 0.f; }
    LDS_WAIT(); asm volatile("" ::: "memory");
    const int c = lane & 7;
    float g[8];
#pragma unroll
    for (int e = 0; e < 8; ++e) g[e] = gain ? gain[k0 + 8 * c + e] : 1.f;
#pragma unroll
    for (int j = 0; j < 4; ++j) { const int n = (lane >> 3) + 8 * j; const LAS float* s = scr + (8 * c) * 33 + n;
        v4u o; o.x = pk2(s[0 * 33] * g[0], s[1 * 33] * g[1]); o.y = pk2(s[2 * 33] * g[2], s[3 * 33] * g[3]); o.z = pk2(s[4 * 33] * g[4], s[5 * 33] * g[5]); o.w = pk2(s[6 * 33] * g[6], s[7 * 33] * g[7]);
        *(GAS v4u*)(WT + (size_t)(drow0 + n) * K + k0 + 8 * c) = o; }
    LDS_WAIT(); asm volatile("" ::: "memory");
}

__device__ __forceinline__ void build_rstd(const float* part, int pm, LAS float* tab, int tid) {
    const int r = tid >> 1, hf = tid & 1;
    const f32x4* p = (const f32x4*)(part + (size_t)(pm * 256 + r) * 32 + hf * 16);
    const f32x4 a = p[0], b = p[1], c = p[2], d = p[3];
    float s = ((a.x + a.y) + (a.z + a.w)) + ((b.x + b.y) + (b.z + b.w)) + ((c.x + c.y) + (c.z + c.w)) + ((d.x + d.y) + (d.z + d.w));
    s += __shfl_xor(s, 1);
    if (!hf) tab[r] = rsqrtf(s * (1.0f / D) + RMS_EPS);
    __syncthreads();
}

__global__ void __launch_bounds__(NWAVES * 64, 2) fwd(Args args) {
    extern __shared__ __attribute__((aligned(16))) unsigned char lds[];
    LAS unsigned char* const L = (LAS unsigned char*)lds;
    volatile LAS unsigned* const MISC = (volatile LAS unsigned*)(L + MISC_OFF);
    LAS float* const rstd_tab = (LAS float*)(L + RSTD_OFF);
    const int G = gridDim.x, bx = blockIdx.x, NGW = G * NWAVES, NGT = G * NWAVES * 64;
#define LANE_IDS() int tid = threadIdx.x; asm volatile("" : "+v"(tid)); const int lane = tid & 63, wave = __builtin_amdgcn_readfirstlane(tid >> 6); \
    const int gw = bx * NWAVES + wave; const int gt = bx * (NWAVES * 64) + tid; (void)lane; (void)gw; (void)gt
    unsigned char* const ws = args.ws;
    gu32* const ctl = (gu32*)(ws + WS_CTL);
    const float* const x = args.in[0];
    bf16* const WGU = (bf16*)(ws + WS_WGU); bf16* const WD = (bf16*)(ws + WS_WD); bf16* const WIN = (bf16*)(ws + WS_WIN); bf16* const WOUT = (bf16*)(ws + WS_WOUT);
    float* const H = (float*)(ws + WS_H); bf16* const HB = (bf16*)(ws + WS_HB); float* const PART = (float*)(ws + WS_PART);
    float* const DTRAW = (float*)(ws + WS_DTRAW); float* const DT = (float*)(ws + WS_DT);
    bf16* const ACT = (bf16*)(ws + WS_ACT); bf16* const PROJ = (bf16*)(ws + WS_PROJ); bf16* const MIXED = (bf16*)(ws + WS_MIXED);
    float* const XC = (float*)(ws + WS_XC); float* const Y = (float*)(ws + WS_Y);

    for (int u = threadIdx.x; u < (LDS_BYTES - LDSCTL_OFF) / 4; u += NWAVES * 64) ((LAS unsigned*)(L + LDSCTL_OFF))[u] = 0u;
    __syncthreads();
    const int lo = args.ph_lo, hi = args.ph_hi;
    XcdBarrier bar; bar.bar = (unsigned*)(ctl + CW_BAR); bar.x = 0; bar.st = nullptr;
    if (hi - lo > 1) bar = xcd_barrier_post((unsigned*)(ctl + CW_BAR), MISC + 8);
    int ps = 0;
#define PH_ON (ps >= lo && ps < hi)
#define PH_END do { if (PH_ON && ps + 1 < hi) xcd_barrier(bar); ++ps; } while (0)

#ifndef NO_PRO
    if (PH_ON) {
        LANE_IDS();
        LAS float* scr = (LAS float*)(L + RING_OFF + wave * 16384);
        constexpr int I_GU = (D / 64) * (NGU / 32), I_D = (FF / 64) * (D / 32), I_IN = (D / 64) * (NIN / 32), I_OUT = (D / 64) * (D / 32);
        constexpr int NITEMS = 8 * (I_GU + I_D) + 4 * (I_IN + I_OUT);
        for (int it = gw; it < NITEMS; it += NGW) {
            int r = it;
            if (r < 8 * I_GU) {
                const int f = r / I_GU; r -= f * I_GU; const int l = f >> 1, second = f & 1;
                const int kb = r / (NGU / 32), db = r % (NGU / 32), tile = db >> 3, within = db & 7;
                const float* Wsrc = (within < 4) ? args.in[second ? 17 : 2] : args.in[second ? 18 : 3];
                const int scol = tile * 128 + (within & 3) * 32 + (lane & 31);
                transpose_item(Wsrc + (size_t)l * D * FF, D, FF, args.in[second ? 16 : 1] + l * D, WGU + (size_t)f * WGU_STRIDE, db * 32, scol, kb * 64, scr, lane);
                continue;
            }
            r -= 8 * I_GU;
            if (r < 8 * I_D) {
                const int f = r / I_D; r -= f * I_D; const int l = f >> 1, second = f & 1;
                const int kb = r / (D / 32), db = r % (D / 32);
                transpose_item(args.in[second ? 19 : 4] + (size_t)l * FF * D, FF, D, nullptr, WD + (size_t)f * WD_STRIDE, db * 32, db * 32 + (lane & 31), kb * 64, scr, lane);
                continue;
            }
            r -= 8 * I_D;
            if (r < 4 * I_IN) {
                const int l = r / I_IN; r -= l * I_IN;
                const int kb = r / (NIN / 32), db = r % (NIN / 32), d0 = db * 32, dl = lane & 31;
                int scol;
                if (d0 < 3072) scol = d0 + dl;
                else if (d0 < 4608) scol = d0 + 16 + dl;
                else if (d0 == 4608) scol = (dl < 16) ? 3072 + dl : -1;
                else scol = -1;
                transpose_item(args.in[6] + (size_t)l * D * IN_W, D, IN_W, args.in[5] + l * D, WIN + (size_t)l * WIN_STRIDE, d0, scol, kb * 64, scr, lane);
                continue;
            }
            r -= 4 * I_IN;
            {
                const int l = r / I_OUT; r -= l * I_OUT;
                const int kb = r / (D / 32), db = r % (D / 32);
                transpose_item(args.in[15] + (size_t)l * D * D, D, D, nullptr, WOUT + (size_t)l * WOUT_STRIDE, db * 32, db * 32 + (lane & 31), kb * 64, scr, lane);
            }
        }
        for (int m = gw; m < M; m += NGW) {
            const GAS f32x4* xr = (const GAS f32x4*)(x + (size_t)m * D) + lane;
            GAS unsigned long long* o8 = (GAS unsigned long long*)(HB + (size_t)m * D) + lane;
            float ss = 0.f;
#pragma unroll
            for (int j = 0; j < 8; ++j) { const f32x4 v = xr[64 * j]; ss += (v.x * v.x + v.y * v.y) + (v.z * v.z + v.w * v.w);
                o8[64 * j] = (unsigned long long)pk2(v.x, v.y) | ((unsigned long long)pk2(v.z, v.w) << 32); }
            ss = wave_sum(ss);
            if (lane < 32) PART[(size_t)m * 32 + lane] = (lane == 0) ? ss : 0.f;
        }
    }
#endif
    PH_END;

    for (int i = 0; i < 8; ++i) {
        const int l = i >> 1, second = i & 1;
#ifndef NO_UP
        if (PH_ON) {
            LANE_IDS();
            pg8::StaticOrder S; S.init(M, NGU, G, bx); pg8::Unit u0; S.next(0, u0);
            build_rstd(PART, u0.pm, rstd_tab, tid);
            pg8::Gemm g{HB, WGU + (size_t)i * WGU_STRIDE, M, NGU, D};
            pg8::EpiSwiGLU E{ACT, FF, rstd_tab};
            pg8::gemm_phase<pg8::EpiSwiGLU, pg8::StaticOrder, true, true>(L + RING_OFF, g, S, E);
        }
#endif
        PH_END;
#ifndef NO_DOWN
        if (PH_ON) {
            pg8::StaticOrder S; S.init(M, D, G, bx);
            pg8::Gemm g{ACT, WD + (size_t)i * WD_STRIDE, M, D, FF};
            pg8::EpiResid E{(i == 0) ? x : (const float*)H, H, HB, PART, 0.5f};
            pg8::gemm_phase<pg8::EpiResid, pg8::StaticOrder, true, true>(L + RING_OFF, g, S, E);
        }
#endif
        PH_END;
        if (second) continue;
#ifndef NO_WIN
        if (PH_ON) {
            LANE_IDS();
            pg8::StaticOrder S; S.init(M, NIN, G, bx); pg8::Unit u0; S.next(0, u0);
            build_rstd(PART, u0.pm, rstd_tab, tid);
            pg8::Gemm g{HB, WIN + (size_t)l * WIN_STRIDE, M, NIN, D};
            pg8::EpiProj E{PROJ, DTRAW, rstd_tab};
            pg8::gemm_phase<pg8::EpiProj, pg8::StaticOrder, true, true>(L + RING_OFF, g, S, E);
        }
#endif
        PH_END;
#ifndef NO_M1
        if (PH_ON) {
            LANE_IDS();
            {
                const float* pw = args.in[7] + (size_t)l * 4 * 128 * 128; const float* pscale = args.in[8] + l * 512;
                LAS float* dl = (LAS float*)(L + RING_OFF);
                for (int u = bx; u < M / 16; u += G) {
                    const int r0 = u * 16, t0 = r0 % SEQ;
                    { const int c = tid, w = 2 << (c >> 7);
#pragma unroll 4
                      for (int r = 0; r < 16; ++r) { const int t = t0 + r; const int cnt = (t + 1 < w) ? t + 1 : w; float s = 0.f;
                          for (int j = 0; j < cnt; ++j) s += bf2f(PROJ[(size_t)(r0 + r - j) * PROJ_LD + P_POOL + c]);
                          dl[r * 512 + c] = s / (float)cnt - bf2f(PROJ[(size_t)(r0 + r) * PROJ_LD + P_POOL + c]); } }
                    __syncthreads();
                    { const int d = tid, gi = d >> 7, dd = d & 127; float acc[16];
#pragma unroll
                      for (int r = 0; r < 16; ++r) acc[r] = 0.f;
                      for (int c = 0; c < 128; ++c) { const float wv = pw[(size_t)(gi * 128 + c) * 128 + dd];
#pragma unroll
                          for (int r = 0; r < 16; ++r) acc[r] += dl[r * 512 + gi * 128 + c] * wv; }
                      const float sc = pscale[d];
#pragma unroll
                      for (int r = 0; r < 16; ++r) MIXED[(size_t)(r0 + r) * D + d] = (bf16)f2bf(acc[r] * sc); }
                    __syncthreads();
                }
            }
            for (int idx = gw; idx < M * 8; idx += NGW) {
                const int row = idx >> 3, hh = idx & 7, b = row / SEQ, t = row % SEQ;
                const float q = bf2f(PROJ[(size_t)row * PROJ_LD + P_Q + hh * 64 + lane]) * 0.125f;
                float carry = 0.f, o = 0.f;
                for (int s0 = t - 1; s0 >= 0; s0 -= 8) {
                    float kk[8], vv[8];
#pragma unroll
                    for (int j = 0; j < 8; ++j) { const int s = (s0 - j >= 0) ? s0 - j : 0; const bf16* kr = PROJ + (size_t)(b * SEQ + s) * PROJ_LD + hh * 64 + lane; kk[j] = bf2f(kr[P_K]); vv[j] = bf2f(kr[P_V]); }
#pragma unroll
                    for (int j = 0; j < 8; ++j) { const float z = wave_sum(q * kk[j]);
                        if (s0 - j >= 0) { carry += softplus_f(z); o += __expf(z - carry) * vv[j]; } }
                    if (carry >= 88.f) break;
                }
                MIXED[(size_t)row * D + 1536 + hh * 64 + lane] = (bf16)f2bf(o);
            }
            {
                const float* cw = args.in[9] + (size_t)l * 4 * 1536; const float* cb = args.in[10] + l * 1536;
                for (int idx = gt; idx < M * 1536; idx += NGT) {
                    const int row = idx / 1536, ch = idx % 1536, t = row % SEQ;
                    float a = cb[ch];
#pragma unroll
                    for (int k = 0; k < 4; ++k) { const int tt = t - 3 + k; if (tt >= 0) a += cw[k * 1536 + ch] * bf2f(PROJ[(size_t)(row - 3 + k) * PROJ_LD + P_XBC + ch]); }
                    XC[idx] = silu_f(a);
                }
                const float* dtb = args.in[11] + l * 16;
                for (int idx = gt; idx < M * 16; idx += NGT) DT[idx] = softplus_f(DTRAW[idx] + dtb[idx & 15]);
            }
        }
        PH_END;
#endif
#ifndef NO_M2
        if (PH_ON) {
            LANE_IDS();
            if (bx < 16) {
                const int id = bx * 512 + tid, nq = id & 3, p = (id >> 2) & 63, h = (id >> 8) & 15, b = id >> 12, g = h >> 3;
                const float A = -__expf(args.in[12][l * 16 + h]), Dk = args.in[13][l * 16 + h];
                float st[32];
#pragma unroll
                for (int n = 0; n < 32; ++n) st[n] = 0.f;
                for (int t = 0; t < SEQ; ++t) {
                    const size_t row = (size_t)b * SEQ + t;
                    const float dtv = DT[row * 16 + h], dA = __expf(A * dtv), xv = XC[row * 1536 + h * 64 + p], xd = xv * dtv;
                    const f32x4* Bp = (const f32x4*)(XC + row * 1536 + 1024 + g * 128 + nq * 32); const f32x4* Cp = (const f32x4*)(XC + row * 1536 + 1280 + g * 128 + nq * 32);
                    float y = 0.f;
#pragma unroll
                    for (int n4 = 0; n4 < 8; ++n4) { const f32x4 bv = Bp[n4], cv = Cp[n4];
#pragma unroll
                        for (int e = 0; e < 4; ++e) { st[n4 * 4 + e] = st[n4 * 4 + e] * dA + xd * bv[e]; y += st[n4 * 4 + e] * cv[e]; } }
                    y += __shfl_xor(y, 1); y += __shfl_xor(y, 2);
                    if (nq == 0) Y[row * 1024 + h * 64 + p] = y + Dk * xv;
                }
            }
        }
        PH_END;
#endif
#ifndef NO_M3
        if (PH_ON) {
            LANE_IDS();
            const float* ng = args.in[14] + l * 1024;
            for (int idx = gw; idx < M * 2; idx += NGW) {
                const int row = idx >> 1, g = idx & 1;
                float v[8]; float ss = 0.f;
#pragma unroll
                for (int j = 0; j < 8; ++j) { const int c = g * 512 + lane * 8 + j; const float z = bf2f(PROJ[(size_t)row * PROJ_LD + P_Z + c]); v[j] = Y[(size_t)row * 1024 + c] * silu_f(z); ss += v[j] * v[j]; }
                ss = wave_sum(ss);
                const float rs = rsqrtf(ss * (1.0f / 512.0f) + RMS_EPS);
#pragma unroll
                for (int j = 0; j < 8; ++j) { const int c = g * 512 + lane * 8 + j; MIXED[(size_t)row * D + 512 + c] = (bf16)f2bf(v[j] * rs * ng[c]); }
            }
        }
        PH_END;
#endif
#ifndef NO_WOUT
        if (PH_ON) {
            pg8::StaticOrder S; S.init(M, D, G, bx);
            pg8::Gemm g{MIXED, WOUT + (size_t)l * WOUT_STRIDE, M, D, D};
            pg8::EpiResid E{H, H, HB, PART, 1.0f};
            pg8::gemm_phase<pg8::EpiResid, pg8::StaticOrder, true, true>(L + RING_OFF, g, S, E);
        }
#endif
        PH_END;
    }
    if (PH_ON) {
        LANE_IDS();
        const float* fg = args.in[20];
        for (int m = gw; m < M; m += NGW) {
            float s = (lane < 32) ? PART[(size_t)m * 32 + lane] : 0.f; s = wave_sum(s);
            const float rs = rsqrtf(s * (1.0f / D) + RMS_EPS);
            const GAS f32x4* hr = (const GAS f32x4*)(H + (size_t)m * D) + lane; const GAS f32x4* gr = (const GAS f32x4*)fg + lane;
            GAS f32x4* orow = (GAS f32x4*)(args.out + (size_t)m * D) + lane;
#pragma unroll
            for (int j = 0; j < 8; ++j) { const f32x4 v = hr[64 * j], gg = gr[64 * j]; orow[64 * j] = v * rs * gg; }
        }
    }
#undef PH_ON
#undef PH_END
}

constexpr int N_PHASES = 1 + 8 * 2 + 4 * 5 + 1;
#ifndef MK_PER_PHASE
#define MK_PER_PHASE 0
#endif
extern "C" void kernel_launch(void* const* d_in, const int* in_sizes, int n_in, void* d_out, int out_size, void* d_ws, size_t ws_size, hipStream_t stream) {
    static int ok = 0;
    if (ok == 0) {
        if (n_in != 21 || in_sizes[0] != M * D || out_size != M * D || ws_size < WS_END) { fprintf(stderr, "kernel_launch: unexpected shapes / workspace (%d inputs, ws %zu < %zu)\n", n_in, ws_size, (size_t)WS_END); ok = -1; return; }
        int dev = 0, cus = 0;
        if (hipGetDevice(&dev) != hipSuccess || hipDeviceGetAttribute(&cus, hipDeviceAttributeMultiprocessorCount, dev) != hipSuccess || cus < GRID) { fprintf(stderr, "kernel_launch: needs %d CUs, device has %d\n", GRID, cus); ok = -1; return; }
        if (hipFuncSetAttribute((const void*)fwd, hipFuncAttributeMaxDynamicSharedMemorySize, LDS_BYTES) != hipSuccess) { fprintf(stderr, "kernel_launch: hipFuncSetAttribute failed\n"); ok = -1; return; }
        int per_cu = 0;
        if (hipOccupancyMaxActiveBlocksPerMultiprocessor(&per_cu, (const void*)fwd, NWAVES * 64, LDS_BYTES) != hipSuccess || per_cu < 1) { fprintf(stderr, "kernel_launch: occupancy query says %d blocks per CU\n", per_cu); }
        (void)hipGetLastError();
        ok = 1;
    }
    if (ok < 0) return;
    if (hipMemsetAsync((char*)d_ws + WS_CTL, 0, CTL_ZERO_BYTES, stream) != hipSuccess) return;
    Args a{};
    for (int i = 0; i < 21; ++i) a.in[i] = (const float*)d_in[i];
    a.out = (float*)d_out; a.ws = (unsigned char*)d_ws;
#if MK_PER_PHASE
    for (int p = 0; p < N_PHASES; ++p) { a.ph_lo = p; a.ph_hi = p + 1; hipLaunchKernelGGL(fwd, dim3(GRID), dim3(NWAVES * 64), LDS_BYTES, stream, a); }
#else
    a.ph_lo = 0; a.ph_hi = N_PHASES;
    hipLaunchKernelGGL(fwd, dim3(GRID), dim3(NWAVES * 64), LDS_BYTES, stream, a);
#endif
}
```

```cpp
#include <hip/hip_runtime.h>
#include <cstdio>
#include <cstdint>
namespace pg8 {
#define PG8_LAS __attribute__((address_space(3)))
typedef unsigned short bf16_t;
typedef short bf16x8 __attribute__((ext_vector_type(8)));
typedef float f32x4 __attribute__((ext_vector_type(4)));
typedef unsigned u32x4 __attribute__((ext_vector_type(4)));
constexpr int BM = 256, BK = 64, HALF = 128, HTB = HALF * BK * 2  , STAGE_BYTES = 8 * HTB, NXCD = 8, WGM = 8;

__host__ __device__ __forceinline__ int lds_byte(int r, int c) { const int st = (r >> 4) * 2 + (c >> 5), rr = r & 15, cc = c & 31, ob = rr * 64 + cc * 2; return st * 1024 + (ob ^ (((ob >> 9) & 1) << 5)); }
__host__ __device__ __forceinline__ void stage_rc(int b, int& R, int& C) { const int st = b / 1024, sb = b % 1024, swz = sb ^ (((sb >> 9) & 1) << 5); R = (st >> 1) * 16 + swz / 64; C = (st & 1) * 32 + (swz % 64) / 2; }
__host__ __device__ __forceinline__ int perm32(int rho) { const int n = rho >> 4, i = rho & 15; return 8 * (i >> 2) + 4 * n + (i & 3); }

struct Unit { int pm, pn, wt; };
struct Gemm { const bf16_t* A; const bf16_t* Bt; int M, N, K; };

struct StaticOrder {
    int nM, nN, nwg, G, c;
    __host__ __device__ __forceinline__ void init(int M, int N, int G_, int c_) { nM = M / BM; nN = N / BM; nwg = nM * nN; G = G_; c = c_; }
    __host__ __device__ __forceinline__ bool next(int i, Unit& u) const {
        const long L = (long)i * G + c; if (L >= nwg) return false;
        int wgid = (int)L; { const int q = nwg / NXCD, r = nwg % NXCD, xcd = wgid % NXCD, off = wgid / NXCD; wgid = (xcd < r ? xcd * (q + 1) : r * (q + 1) + (xcd - r) * q) + off; }
        const int nig = WGM * nN, gid = wgid / nig, fm = gid * WGM, gsz = (nM - fm) < WGM ? (nM - fm) : WGM;
        u.pm = fm + ((wgid % nig) % gsz); u.pn = (wgid % nig) / gsz; u.wt = 0; return true;
    }
    __device__ __forceinline__ void a_ready(const Unit&) const {}
    __device__ __forceinline__ void done(const Unit&) const {}
};

__device__ __forceinline__ unsigned cvt_pk_bf16(float lo, float hi) { unsigned r; asm volatile("v_cvt_pk_bf16_f32 %0, %1, %2" : "=v"(r) : "v"(lo), "v"(hi)); return r; }
__device__ __forceinline__ float shx(float v, int lane, int k) { return __builtin_bit_cast(float, __builtin_amdgcn_ds_bpermute((lane ^ k) << 2, __builtin_bit_cast(int, v))); }
__device__ __forceinline__ float shl_(float v, int srclane) { return __builtin_bit_cast(float, __builtin_amdgcn_ds_bpermute(srclane << 2, __builtin_bit_cast(int, v))); }
__device__ __forceinline__ float fast_silu(float g) { return g * __builtin_amdgcn_rcpf(1.0f + __builtin_amdgcn_exp2f(-1.4426950408889634f * g)); }
__device__ __forceinline__ void st16(void* p, u32x4 v, int wt) {
    if (wt) asm volatile("global_store_dwordx4 %0, %1, off sc1\n\ts_nop 1" :: "v"(p), "v"(v) : "memory");
    else *(u32x4*)p = v;
}
__device__ __forceinline__ void st4(float* p, float v, int wt) {
    if (wt) asm volatile("global_store_dword %0, %1, off sc1\n\ts_nop 1" :: "v"(p), "v"(v) : "memory");
    else *p = v;
}
struct EpiSwiGLU {
    static constexpr bool PERM = true, AFTER_DRAIN = false;
    bf16_t* O; int ldc; const PG8_LAS float* rstd;
    __device__ __forceinline__ void operator()(const f32x4 (&acc)[2][2][4][2], const Unit& u, int wr, int wc, int fr_, int fq_) const {
        int fr = fr_, fq = fq_; asm volatile("" : "+v"(fr), "+v"(fq));
        const int rl0 = wr * 64 + fr;
        bf16_t* base = O + (size_t)(u.pm * BM) * ldc + u.pn * HALF + wc * 32 + 8 * fq;
#pragma unroll
        for (int ai = 0; ai < 2; ++ai)
#pragma unroll
            for (int m = 0; m < 4; ++m) {
                const int rl = rl0 + ai * HALF + m * 16; const float r = rstd[rl];
                const float rn = -1.4426950408889634f * r, r2 = r * r;
                u32x4 w;
#pragma unroll
                for (int n = 0; n < 2; ++n) {
                    const f32x4 ag = acc[ai][0][m][n], au = acc[ai][1][m][n];
                    const f32x4 t = ag * rn;
                    f32x4 d; d[0] = __builtin_amdgcn_exp2f(t[0]); d[1] = __builtin_amdgcn_exp2f(t[1]); d[2] = __builtin_amdgcn_exp2f(t[2]); d[3] = __builtin_amdgcn_exp2f(t[3]);
                    d = d + 1.0f;
                    f32x4 rc; rc[0] = __builtin_amdgcn_rcpf(d[0]); rc[1] = __builtin_amdgcn_rcpf(d[1]); rc[2] = __builtin_amdgcn_rcpf(d[2]); rc[3] = __builtin_amdgcn_rcpf(d[3]);
                    const f32x4 o_ = (ag * au) * (rc * r2);
                    if (n == 0) { w.x = cvt_pk_bf16(o_[0], o_[1]); w.y = cvt_pk_bf16(o_[2], o_[3]); } else { w.z = cvt_pk_bf16(o_[0], o_[1]); w.w = cvt_pk_bf16(o_[2], o_[3]); }
                }
                st16(base + (size_t)rl * ldc, w, u.wt);
            }
    }
};
struct EpiResid {
    static constexpr bool PERM = true, AFTER_DRAIN = false;
    bf16_t* Hb; float* part; float scale;
    __device__ __forceinline__ void operator()(const f32x4 (&acc)[2][2][4][2], const Unit& u, int wr, int wc, int fr_, int fq_) const {
        int fr = fr_, fq = fq_; asm volatile("" : "+v"(fr), "+v"(fq));
        const int row0 = u.pm * BM + wr * 64 + fr, col0 = u.pn * BM + wc * 32 + 8 * fq;
        u32x4 hq[2][4][2];
#pragma unroll
        for (int ai = 0; ai < 2; ++ai)
#pragma unroll
            for (int m = 0; m < 4; ++m)
#pragma unroll
                for (int bj = 0; bj < 2; ++bj) hq[ai][m][bj] = *(const u32x4*)(Hb + (size_t)(row0 + ai * HALF + m * 16) * 2048 + col0 + bj * HALF);
        __builtin_amdgcn_sched_barrier(0);
#pragma unroll
        for (int ai = 0; ai < 2; ++ai)
#pragma unroll
            for (int m = 0; m < 4; ++m) {
                const int row = row0 + ai * HALF + m * 16; float ss = 0.f;
#pragma unroll
                for (int bj = 0; bj < 2; ++bj) {
                    const size_t off = (size_t)row * 2048 + col0 + bj * HALF;
                    const u32x4 h_ = hq[ai][m][bj];
                    f32x4 v0, v1;
                    v0[0] = __builtin_bit_cast(float, h_.x << 16); v0[1] = __builtin_bit_cast(float, h_.x & 0xffff0000u); v0[2] = __builtin_bit_cast(float, h_.y << 16); v0[3] = __builtin_bit_cast(float, h_.y & 0xffff0000u);
                    v1[0] = __builtin_bit_cast(float, h_.z << 16); v1[1] = __builtin_bit_cast(float, h_.z & 0xffff0000u); v1[2] = __builtin_bit_cast(float, h_.w << 16); v1[3] = __builtin_bit_cast(float, h_.w & 0xffff0000u);
                    v0 = v0 + acc[ai][bj][m][0] * scale; v1 = v1 + acc[ai][bj][m][1] * scale;
                    u32x4 w; w.x = cvt_pk_bf16(v0[0], v0[1]); w.y = cvt_pk_bf16(v0[2], v0[3]); w.z = cvt_pk_bf16(v1[0], v1[1]); w.w = cvt_pk_bf16(v1[2], v1[3]);
                    st16(Hb + off, w, u.wt);
                    const float r0 = __builtin_bit_cast(float, w.x << 16), r1 = __builtin_bit_cast(float, w.x & 0xffff0000u), r2 = __builtin_bit_cast(float, w.y << 16), r3 = __builtin_bit_cast(float, w.y & 0xffff0000u);
                    const float r4 = __builtin_bit_cast(float, w.z << 16), r5 = __builtin_bit_cast(float, w.z & 0xffff0000u), r6 = __builtin_bit_cast(float, w.w << 16), r7 = __builtin_bit_cast(float, w.w & 0xffff0000u);
                    ss += (r0 * r0 + r1 * r1) + (r2 * r2 + r3 * r3) + (r4 * r4 + r5 * r5) + (r6 * r6 + r7 * r7);
                }
                { const int ln = fq * 16 + fr; ss += shx(ss, ln, 16); ss += shx(ss, ln, 32); }
                if (fq == 0) st4(part + (size_t)row * 32 + u.pn * 4 + wc, ss, u.wt);
            }
    }
};
struct EpiProj {
    static constexpr bool PERM = true, AFTER_DRAIN = false;
    bf16_t* O; float* dtraw; const PG8_LAS float* rstd;
    __device__ __forceinline__ void operator()(const f32x4 (&acc)[2][2][4][2], const Unit& u, int wr, int wc, int fr_, int fq_) const {
        int fr = fr_, fq = fq_; asm volatile("" : "+v"(fr), "+v"(fq));
        const int rl0 = wr * 64 + fr;
        {
            bf16_t* base = O + (size_t)(u.pm * BM) * 4608 + u.pn * BM + wc * 32 + 8 * fq;
#pragma unroll
            for (int ai = 0; ai < 2; ++ai)
#pragma unroll
                for (int m = 0; m < 4; ++m) {
                    const int rl = rl0 + ai * HALF + m * 16; const float r = rstd[rl];
#pragma unroll
                    for (int bj = 0; bj < 2; ++bj) {
                        const f32x4 v0 = acc[ai][bj][m][0] * r, v1 = acc[ai][bj][m][1] * r;
                        u32x4 w; w.x = cvt_pk_bf16(v0[0], v0[1]); w.y = cvt_pk_bf16(v0[2], v0[3]); w.z = cvt_pk_bf16(v1[0], v1[1]); w.w = cvt_pk_bf16(v1[2], v1[3]);
                        st16(base + (size_t)rl * 4608 + bj * HALF, w, u.wt);
                    }
                }
        }
    }
};
template <class Epi, class Sched, bool ALIGN_EPI = false, bool SP2 = false, bool RS = false>
__device__ __forceinline__ void gemm_phase(PG8_LAS unsigned char* lds, const Gemm g, const Sched& S, const Epi& E, const float* rpart = nullptr, PG8_LAS float* rtab = nullptr, float rinvd = 0.f, float reps = 0.f) {
    int tid_ = threadIdx.x; asm volatile("" : "+v"(tid_));
    const int tid = tid_, wid = __builtin_amdgcn_readfirstlane(tid >> 6), lane = tid & 63, wr = wid >> 2, wc = wid & 3, fr = lane & 15, fq = lane >> 4;
    const int K = g.K, nt = K / BK;
    unsigned voffA[2], voffB[2];
#pragma unroll
    for (int i = 0; i < 2; ++i) { int R, C; stage_rc(tid * 16 + i * 8192, R, C); const int Rb = Epi::PERM ? ((R & ~31) + perm32(R & 31)) : R;
        voffA[i] = (unsigned)(R * K + C) * 2u; voffB[i] = (unsigned)(Rb * K + C) * 2u; }
    const size_t kstep = (size_t)(BK * 2);
    const size_t hstep = (size_t)HALF * K * 2;
    const size_t tstep = 2 * hstep;
    const unsigned ldsw = (unsigned)wid * 1024u;
    const int aoff = lds_byte(wr * 64 + fr, fq * 8), boff = lds_byte(wc * 32 + fr, fq * 8);
#define PG8_SA(b, h) (((b) * 2 + (h)) * HTB)
#define PG8_SB(b, h) ((4 + (b) * 2 + (h)) * HTB)
#define PG8_STAGE(bufoff, gbase, voff) do { _Pragma("unroll") for (int _i = 0; _i < 2; ++_i) \
        __builtin_amdgcn_global_load_lds((const unsigned*)((const char*)(gbase) + (voff)[_i]), (PG8_LAS unsigned*)(lds + (bufoff) + ldsw + _i * 8192), 16, 0, 0); } while (0)
#define PG8_LDA(dst, b, h) do { _Pragma("unroll") for (int m = 0; m < 4; ++m) _Pragma("unroll") for (int k = 0; k < 2; ++k) dst[m][k] = *(const PG8_LAS bf16x8*)(lds + PG8_SA(b, h) + aoff + m * 2048 + k * 1024); } while (0)
#define PG8_LDB(dst, b, h) do { _Pragma("unroll") for (int n = 0; n < 2; ++n) _Pragma("unroll") for (int k = 0; k < 2; ++k) dst[n][k] = *(const PG8_LAS bf16x8*)(lds + PG8_SB(b, h) + boff + n * 2048 + k * 1024); } while (0)
#define PG8_MMA(ai, bj, At, Bt) do { __builtin_amdgcn_s_setprio(1); _Pragma("unroll") for (int m = 0; m < 4; ++m) _Pragma("unroll") for (int n = 0; n < 2; ++n) _Pragma("unroll") for (int k = 0; k < 2; ++k) \
        acc[ai][bj][m][n] = __builtin_amdgcn_mfma_f32_16x16x32_bf16(Bt[n][k], At[m][k], acc[ai][bj][m][n], 0, 0, 0); __builtin_amdgcn_s_setprio(0); } while (0)
#define PG8_WAIT_V(n) asm volatile("s_waitcnt vmcnt(" #n ")" ::: "memory")
#define PG8_WAIT_L(n) asm volatile("s_waitcnt lgkmcnt(" #n ")" ::: "memory")
#define PG8_BAR __builtin_amdgcn_s_barrier()
#define PG8_SCHED __builtin_amdgcn_sched_barrier(0)
    Unit cur, nxt; int ui = 0;
    if (!S.next(0, cur)) return;
    f32x4 acc[2][2][4][2];
#pragma unroll
    for (int a = 0; a < 2; ++a)
#pragma unroll
        for (int b = 0; b < 2; ++b)
#pragma unroll
            for (int m = 0; m < 4; ++m)
#pragma unroll
                for (int n = 0; n < 2; ++n) acc[a][b][m][n] = (f32x4){0.f, 0.f, 0.f, 0.f};
    bf16x8 At[4][2], B0[2][2], B1[2][2];
    const char* cA = (const char*)g.A + (size_t)cur.pm * tstep; const char* cB = (const char*)g.Bt + (size_t)cur.pn * tstep;
    S.a_ready(cur);
    f32x4 rq0 = {}, rq1 = {}, rq2 = {}, rq3 = {};
    if constexpr (RS) { const f32x4* rp_ = (const f32x4*)(rpart + (size_t)(cur.pm * 256 + (tid >> 1)) * 32 + (tid & 1) * 16); rq0 = rp_[0]; rq1 = rp_[1]; rq2 = rp_[2]; rq3 = rp_[3]; }
    if constexpr (SP2) {
        PG8_STAGE(PG8_SB(0, 0), cB, voffB); PG8_STAGE(PG8_SB(0, 1), cB + hstep, voffB); PG8_STAGE(PG8_SA(0, 0), cA, voffA); PG8_STAGE(PG8_SA(0, 1), cA + hstep, voffA);
        if (wr == 1) PG8_BAR;
        PG8_WAIT_V(2); PG8_BAR;
        PG8_STAGE(PG8_SB(1, 0), cB + kstep, voffB); PG8_STAGE(PG8_SA(1, 0), cA + kstep, voffA); PG8_STAGE(PG8_SB(1, 1), cB + hstep + kstep, voffB);
        if constexpr (RS) { float s_ = ((rq0.x + rq0.y) + (rq0.z + rq0.w)) + ((rq1.x + rq1.y) + (rq1.z + rq1.w)) + ((rq2.x + rq2.y) + (rq2.z + rq2.w)) + ((rq3.x + rq3.y) + (rq3.z + rq3.w));
            s_ += shx(s_, lane, 1); if (!(tid & 1)) rtab[tid >> 1] = rsqrtf(s_ * rinvd + reps); }
        PG8_WAIT_V(6); PG8_BAR;
    } else {
        PG8_STAGE(PG8_SB(0, 0), cB, voffB); PG8_STAGE(PG8_SA(0, 0), cA, voffA); PG8_STAGE(PG8_SB(0, 1), cB + hstep, voffB); PG8_STAGE(PG8_SA(0, 1), cA + hstep, voffA);
        if (wr == 1) PG8_BAR;
        PG8_WAIT_V(4); PG8_BAR;
        PG8_STAGE(PG8_SB(1, 0), cB + kstep, voffB); PG8_STAGE(PG8_SA(1, 0), cA + kstep, voffA); PG8_STAGE(PG8_SB(1, 1), cB + hstep + kstep, voffB);
        PG8_WAIT_V(6); PG8_BAR;
    }
    for (;;) {
        const bool has_next = S.next(ui + 1, nxt);
        const char* nA = has_next ? (const char*)g.A + (size_t)nxt.pm * tstep : cA; const char* nB = has_next ? (const char*)g.Bt + (size_t)nxt.pn * tstep : cB;
        for (int t = 0; t < nt; t += 2) {
            const bool last = (t == nt - 2);
            const char* a1 = cA + (size_t)(t + 1) * kstep;
            const char* a2 = last ? nA : cA + (size_t)(t + 2) * kstep; const char* b2 = last ? nB : cB + (size_t)(t + 2) * kstep;
            const char* a3 = a2 + kstep; const char* b3 = b2 + kstep;
            if (last && has_next) S.a_ready(nxt);
            if constexpr (SP2) {
            PG8_LDB(B0, 0, 0); PG8_LDB(B1, 0, 1); PG8_SCHED; PG8_LDA(At, 0, 0); PG8_STAGE(PG8_SA(1, 1), a1 + hstep, voffA);
            PG8_WAIT_V(8); PG8_WAIT_L(0); PG8_BAR; PG8_MMA(0, 0, At, B0); PG8_MMA(0, 1, At, B1); PG8_BAR; PG8_SCHED;
            PG8_LDA(At, 0, 1); PG8_STAGE(PG8_SB(0, 0), b2, voffB); PG8_STAGE(PG8_SB(0, 1), b2 + hstep, voffB); PG8_STAGE(PG8_SA(0, 0), a2, voffA);
            PG8_WAIT_V(8); PG8_WAIT_L(0); PG8_BAR; PG8_MMA(1, 0, At, B0); PG8_MMA(1, 1, At, B1); PG8_BAR; PG8_SCHED;
            PG8_LDB(B0, 1, 0); PG8_LDB(B1, 1, 1); PG8_SCHED; PG8_LDA(At, 1, 0); PG8_STAGE(PG8_SA(0, 1), a2 + hstep, voffA);
            PG8_WAIT_V(8); PG8_WAIT_L(0); PG8_BAR; PG8_MMA(0, 0, At, B0); PG8_MMA(0, 1, At, B1); PG8_BAR; PG8_SCHED;
            PG8_LDA(At, 1, 1); PG8_STAGE(PG8_SB(1, 0), b3, voffB); PG8_STAGE(PG8_SB(1, 1), b3 + hstep, voffB); PG8_STAGE(PG8_SA(1, 0), a3, voffA);
            PG8_WAIT_V(8); PG8_WAIT_L(0); PG8_BAR; PG8_MMA(1, 0, At, B0); PG8_MMA(1, 1, At, B1); PG8_BAR; PG8_SCHED;
            } else {
            PG8_LDB(B0, 0, 0); PG8_SCHED; PG8_LDA(At, 0, 0); PG8_STAGE(PG8_SA(1, 1), a1 + hstep, voffA);
            PG8_WAIT_L(8); PG8_BAR; PG8_WAIT_L(0); PG8_MMA(0, 0, At, B0); PG8_BAR; PG8_SCHED;
            PG8_LDB(B1, 0, 1); PG8_STAGE(PG8_SB(0, 0), b2, voffB);
            PG8_BAR; PG8_WAIT_L(0); PG8_MMA(0, 1, At, B1); PG8_BAR;
            PG8_LDA(At, 0, 1); PG8_STAGE(PG8_SA(0, 0), a2, voffA);
            PG8_BAR; PG8_WAIT_L(0); PG8_MMA(1, 0, At, B0); PG8_BAR; PG8_SCHED;
            PG8_STAGE(PG8_SB(0, 1), b2 + hstep, voffB);
            PG8_WAIT_V(6); PG8_BAR; PG8_MMA(1, 1, At, B1); PG8_BAR;
            PG8_LDB(B0, 1, 0); PG8_SCHED; PG8_LDA(At, 1, 0); PG8_STAGE(PG8_SA(0, 1), a2 + hstep, voffA);
            PG8_WAIT_L(8); PG8_BAR; PG8_WAIT_L(0); PG8_MMA(0, 0, At, B0); PG8_BAR; PG8_SCHED;
            PG8_LDB(B1, 1, 1); PG8_STAGE(PG8_SB(1, 0), b3, voffB);
            PG8_BAR; PG8_WAIT_L(0); PG8_MMA(0, 1, At, B1); PG8_BAR;
            PG8_LDA(At, 1, 1); PG8_STAGE(PG8_SA(1, 0), a3, voffA);
            PG8_BAR; PG8_WAIT_L(0); PG8_MMA(1, 0, At, B0); PG8_BAR; PG8_SCHED;
            PG8_STAGE(PG8_SB(1, 1), b3 + hstep, voffB);
            PG8_WAIT_V(6); PG8_BAR; PG8_MMA(1, 1, At, B1); PG8_BAR;
            }
        }
        if constexpr (ALIGN_EPI) { if (wr == 0) PG8_BAR; }
        cur.wt = has_next ? 0 : 1;
        if constexpr (!Epi::AFTER_DRAIN) { E(acc, cur, wr, wc, fr, fq); S.done(cur); }
        if (!has_next) break;
#pragma unroll
        for (int a = 0; a < 2; ++a)
#pragma unroll
            for (int b = 0; b < 2; ++b)
#pragma unroll
                for (int m = 0; m < 4; ++m)
#pragma unroll
                    for (int n = 0; n < 2; ++n) acc[a][b][m][n] = (f32x4){0.f, 0.f, 0.f, 0.f};
        cur = nxt; cA = nA; cB = nB; ++ui;
        if constexpr (ALIGN_EPI) { if (wr == 1) PG8_BAR; }
    }
    PG8_WAIT_V(0);
    if constexpr (!ALIGN_EPI) { if (wr == 0) PG8_BAR; }
    PG8_BAR;
    if constexpr (Epi::AFTER_DRAIN) { E.fused(acc, cur, wr, wc, fr, fq, lds, wid, lane); S.done(cur); }
#undef PG8_SA
#undef PG8_SB
#undef PG8_STAGE
#undef PG8_LDA
#undef PG8_LDB
#undef PG8_MMA
#undef PG8_WAIT_V
#undef PG8_WAIT_L
#undef PG8_BAR
#undef PG8_SCHED
}
}
#define GAS __attribute__((address_space(1)))
#define LAS __attribute__((address_space(3)))
typedef unsigned short bf16;
typedef unsigned v4u __attribute__((ext_vector_type(4)));
typedef float f32x4 __attribute__((ext_vector_type(4)));
typedef short bf16x8 __attribute__((ext_vector_type(8)));
typedef float f32x16 __attribute__((ext_vector_type(16)));
typedef GAS unsigned gu32;
typedef GAS unsigned long long gu64;
#define RLX_AGENT __ATOMIC_RELAXED, __HIP_MEMORY_SCOPE_AGENT
#define LDS_WAIT() asm volatile("s_waitcnt lgkmcnt(0)" ::: "memory")
#define VM_WAIT() asm volatile("s_waitcnt vmcnt(0)" ::: "memory")
__device__ __forceinline__ unsigned long long rt() { return __builtin_amdgcn_s_memrealtime(); }
__device__ __forceinline__ unsigned f2bf(float f) { unsigned u = __builtin_bit_cast(unsigned, f); return (u + 0x7fffu + ((u >> 16) & 1u)) >> 16; }
typedef float f32x2_t __attribute__((ext_vector_type(2))); typedef __bf16 bf16x2_t __attribute__((ext_vector_type(2)));
__device__ __forceinline__ unsigned pk2(float lo, float hi) { f32x2_t v = {lo, hi}; bf16x2_t b = __builtin_convertvector(v, bf16x2_t); return __builtin_bit_cast(unsigned, b); }

#define XB_TMO      128
#define XB_XCNT(j)  (256  + 64 * (j))
#define XB_XSUB(j)  (1280 + 64 * (j))
#define XB_XGEN(j)  (2304 + 64 * (j))
#define XB_TOP      3328
#define XB_TOPGEN   3392
#define XCD_BAR_WORDS 3456
#define XB_SPIN_CAP (1u << 18)

__device__ __forceinline__ unsigned xb_ld(unsigned* p)              { return __hip_atomic_load(p, __ATOMIC_RELAXED, __HIP_MEMORY_SCOPE_AGENT); }
__device__ __forceinline__ unsigned xb_add(unsigned* p, unsigned v) { return __hip_atomic_fetch_add(p, v, __ATOMIC_RELAXED, __HIP_MEMORY_SCOPE_AGENT); }
__device__ __forceinline__ unsigned xb_xcc_id() { return (unsigned)__builtin_amdgcn_s_getreg((3 << 11) | 20) & 0xFu; }
#define XB_SPIN(cond, bar) do { unsigned _sp = 0; while (cond) { __builtin_amdgcn_s_sleep(1); \
    if ((++_sp & 255u) == 0u) { if (xb_ld(&(bar)[XB_TMO])) break; if (_sp > XB_SPIN_CAP) { atomicAdd(&(bar)[XB_TMO], 1u); break; } } } } while (0)

struct XcdBarrier {
    unsigned* bar; unsigned x;
    volatile LAS unsigned* st;
};

__device__ __forceinline__ XcdBarrier xcd_barrier_post(unsigned* bar, volatile LAS unsigned* st) {
    XcdBarrier b; b.bar = bar; b.x = xb_xcc_id(); b.st = st;
    if (threadIdx.x == 0) (void)xb_add(&bar[XB_XCNT(b.x)], 1u);
    return b;
}
__device__ __forceinline__ void xcd_barrier_complete(unsigned* bar, unsigned x, unsigned& nloc, unsigned& nx) {
    const unsigned G = gridDim.x * gridDim.y * gridDim.z;
    unsigned sum, cnt, mine, sp = 0u;
    for (;;) {
        sum = 0u; cnt = 0u; mine = 0u;
#pragma unroll 1
        for (unsigned j = 0; j < 16; ++j) { const unsigned c = xb_ld(&bar[XB_XCNT(j)]); sum += c; cnt += (c > 0u) ? 1u : 0u; mine = (j == x) ? c : mine; }
        if (sum == G) break;
        __builtin_amdgcn_s_sleep(1);
        if ((++sp & 255u) == 0u) { if (xb_ld(&bar[XB_TMO])) break; if (sp > XB_SPIN_CAP) { atomicAdd(&bar[XB_TMO], 1u); break; } }
    }
    nloc = mine > 0u ? mine : 1u; nx = cnt > 0u ? cnt : 1u;
}

__device__ __forceinline__ void xcd_barrier(const XcdBarrier& b) {
    asm volatile("s_waitcnt vmcnt(0)" ::: "memory");
    __syncthreads();
    if (threadIdx.x == 0) {
        unsigned* bar = b.bar;
        __builtin_amdgcn_s_waitcnt(0);
        unsigned nloc = b.st[0], nx = b.st[1];
        if (nloc == 0u) { xcd_barrier_complete(bar, b.x, nloc, nx); b.st[0] = nloc; b.st[1] = nx; }
        const unsigned old = xb_add(&bar[XB_XSUB(b.x)], 1u);
        const unsigned gen = old / nloc;
        if (old + 1u == (gen + 1u) * nloc) {
            __builtin_amdgcn_fence(__ATOMIC_RELEASE, "agent");
            asm volatile("s_waitcnt vmcnt(0)" ::: "memory");
            const unsigned og = xb_add(&bar[XB_TOP], 1u);
            const unsigned tg = og / nx;
            if (og + 1u == (tg + 1u) * nx) xb_add(&bar[XB_TOPGEN], 1u);
            else XB_SPIN(xb_ld(&bar[XB_TOPGEN]) == tg, bar);
            __builtin_amdgcn_fence(__ATOMIC_ACQUIRE, "agent");
            xb_add(&bar[XB_XGEN(b.x)], 1u);
            asm volatile("s_waitcnt vmcnt(0)" ::: "memory");
        } else {
            XB_SPIN(xb_ld(&bar[XB_XGEN(b.x)]) == gen, bar);
            __builtin_amdgcn_fence(__ATOMIC_ACQUIRE, "agent");
            asm volatile("s_waitcnt vmcnt(0)" ::: "memory");
        }
    }
    __syncthreads();
}

#ifndef REP_PRO
#define REP_PRO 1
#endif
#ifndef REP_UP
#define REP_UP 1
#endif
#ifndef REP_WIN
#define REP_WIN 1
#endif
#ifndef REP_MIX
#define REP_MIX 1
#endif
#ifndef REP_DOWN
#define REP_DOWN 1
#endif
#ifndef REP_WOUT
#define REP_WOUT 1
#endif
#ifndef REP_ATT
#define REP_ATT 1
#endif
#ifndef REP_S1
#define REP_S1 1
#endif
#ifndef REP_S2
#define REP_S2 1
#endif
#ifndef REP_S3
#define REP_S3 1
#endif
constexpr int NWAVES = 8;
constexpr int BATCH = 2, SEQ = 8192, M = BATCH * SEQ, D = 2048, FF = 5632, NGU = 2 * FF, DEPTH = 4;
constexpr int NIN = 4864, PROJ_LD = 4608;
constexpr int P_POOL = 0, P_Z = 512, P_XBC = 1536, P_Q = 3072, P_K = 3584, P_V = 4096;
constexpr int IN_W = 4624;
constexpr float RMS_EPS = 1e-6f;
constexpr int GRID = 256;

constexpr size_t MiB = 1u << 20;
constexpr size_t WS_CTL = 0, CTL_ZERO_BYTES = 1 * MiB;
constexpr size_t WS_PWT = 1 * MiB;
constexpr size_t WS_WGU = 2 * MiB;        constexpr size_t WGU_STRIDE = (size_t)NGU * D;
constexpr size_t WS_WD = 354 * MiB;       constexpr size_t WD_STRIDE = (size_t)D * FF;
constexpr size_t WS_WIN = 530 * MiB;      constexpr size_t WIN_STRIDE = (size_t)NIN * D;
constexpr size_t WS_WOUT = 606 * MiB;     constexpr size_t WOUT_STRIDE = (size_t)D * D;
constexpr size_t WS_H = 638 * MiB, WS_HB = 766 * MiB, WS_PART = 830 * MiB, WS_DTRAW = 832 * MiB, WS_DT = 833 * MiB;
constexpr size_t WS_X = 834 * MiB;
constexpr size_t WS_ACT = WS_X;
constexpr size_t WS_PROJ = WS_X, WS_MIXED = WS_X + 144 * MiB;
constexpr size_t WS_XT = WS_X + 208 * MiB, WS_XTS = WS_X + 240 * MiB, WS_BC = WS_X + 272 * MiB, WS_BCT = WS_X + 280 * MiB, WS_CC = WS_X + 288 * MiB, WS_CS = WS_X + 296 * MiB;
constexpr size_t WS_ST = WS_X + 297 * MiB, WS_SIN = WS_X + 329 * MiB, WS_Y = WS_X + 345 * MiB;
constexpr size_t WS_END = WS_X + 409 * MiB;
static_assert(WS_WGU + 8 * WGU_STRIDE * 2 <= WS_WD && WS_WD + 8 * WD_STRIDE * 2 <= WS_WIN && WS_WIN + 4 * WIN_STRIDE * 2 <= WS_WOUT && WS_WOUT + 4 * WOUT_STRIDE * 2 <= WS_H, "ws map: weights");
static_assert(WS_H + (size_t)M * D * 4 <= WS_HB && WS_HB + (size_t)M * D * 2 <= WS_PART && WS_PART + (size_t)M * 32 * 4 <= WS_DTRAW && WS_DTRAW + (size_t)M * 16 * 4 <= WS_DT && WS_DT + (size_t)M * 16 * 4 <= WS_X, "ws map: state");
static_assert(WS_ACT + (size_t)M * FF * 2 <= WS_END && WS_PROJ + (size_t)M * PROJ_LD * 2 <= WS_MIXED && WS_MIXED + (size_t)M * D * 2 <= WS_XT && WS_Y + (size_t)M * 1024 * 4 <= WS_END, "ws map: overlay");
constexpr int CW_BAR = 4096;

constexpr int RING_OFF = 0, RING_BYTES = 131072;
constexpr int LDSCTL_OFF = RING_BYTES, MISC_OFF = LDSCTL_OFF + 320, RSTD_OFF = LDSCTL_OFF + 1024;
constexpr int LDS_BYTES = 147456;
static_assert(RSTD_OFF + 1024 <= LDS_BYTES, "LDS map");

struct Args { const float* in[21]; float* out; unsigned char* ws; int ph_lo, ph_hi; };
static_assert(sizeof(Args) == 21 * 8 + 8 + 8 + 8, "Args has no padding");

typedef unsigned u32x4 __attribute__((ext_vector_type(4)));
__device__ __forceinline__ unsigned cvtpk_s(float lo, float hi) { return pk2(lo, hi); }
__device__ __forceinline__ bf16x8 scale_frag(v4u a, f32x4 wl, f32x4 wh) {
    v4u r;
    r.x = pk2(__builtin_bit_cast(float, a.x << 16) * wl.x, __builtin_bit_cast(float, a.x & 0xffff0000u) * wl.y); r.y = pk2(__builtin_bit_cast(float, a.y << 16) * wl.z, __builtin_bit_cast(float, a.y & 0xffff0000u) * wl.w);
    r.z = pk2(__builtin_bit_cast(float, a.z << 16) * wh.x, __builtin_bit_cast(float, a.z & 0xffff0000u) * wh.y); r.w = pk2(__builtin_bit_cast(float, a.w << 16) * wh.z, __builtin_bit_cast(float, a.w & 0xffff0000u) * wh.w);
    return __builtin_bit_cast(bf16x8, r);
}
__device__ __forceinline__ float bf2f(bf16 b) { return __builtin_bit_cast(float, (unsigned)b << 16); }
__device__ __forceinline__ float wave_sum(float v, int lane) {
#pragma unroll
    for (int o = 1; o < 64; o <<= 1) v += pg8::shx(v, lane, o);
    return v;
}
__device__ __forceinline__ float softplus_f(float z) { return fmaxf(z, 0.f) + 0.6931471806f * __builtin_amdgcn_logf(1.0f + __builtin_amdgcn_exp2f(-1.4426950409f * fabsf(z))); }
__device__ __forceinline__ float silu_f(float z) { return z * __builtin_amdgcn_rcpf(1.0f + __builtin_amdgcn_exp2f(-1.4426950409f * z)); }

struct TItem { const float* W; const float* gain; bf16* WT; int K, N, drow0, scol, k0; };
__device__ __forceinline__ void titem_load(const TItem& t, int lane, f32x4 (&v)[8], f32x4& g0, f32x4& g1) {
    const int kr = lane >> 3;
#pragma unroll
    for (int i = 0; i < 8; ++i) { const f32x4 x_ = *(const f32x4*)(t.W + (size_t)(t.k0 + 8 * kr + i) * t.N + (t.scol >= 0 ? t.scol : 0));
        v[i] = x_ * ((t.scol >= 0) ? 1.0f : 0.0f); }
    g0 = (f32x4){1.f, 1.f, 1.f, 1.f}; g1 = g0;
    if (t.gain) { g0 = *(const f32x4*)(t.gain + t.k0 + 8 * kr); g1 = *(const f32x4*)(t.gain + t.k0 + 8 * kr + 4); }
}
__device__ __forceinline__ void titem_store(const TItem& t, int lane, const f32x4 (&v)[8], const f32x4& g0, const f32x4& g1) {
    const int kr = lane >> 3, c4 = lane & 7;
#pragma unroll
    for (int e = 0; e < 4; ++e) {
        v4u o; o.x = pk2(v[0][e] * g0.x, v[1][e] * g0.y); o.y = pk2(v[2][e] * g0.z, v[3][e] * g0.w); o.z = pk2(v[4][e] * g1.x, v[5][e] * g1.y); o.w = pk2(v[6][e] * g1.z, v[7][e] * g1.w);
        *(GAS v4u*)(t.WT + (size_t)(t.drow0 + 4 * c4 + e) * t.K + t.k0 + 8 * kr) = o; }
}
constexpr int TI_GU = (D / 64) * (NGU / 32), TI_D = (FF / 64) * (D / 32), TI_IN = (D / 64) * (NIN / 32), TI_OUT = (D / 64) * (D / 32);
constexpr int TI_TOTAL = 8 * (TI_GU + TI_D) + 4 * (TI_IN + TI_OUT);
__device__ __forceinline__ void titem_decode(int it, int lane, const float* const* in, bf16* WGU, bf16* WD, bf16* WIN, bf16* WOUT, TItem& t) {
    const int dl = 4 * (lane & 7);
    int r = it;
    if (r < 8 * TI_GU) {
        const int f = r / TI_GU; r -= f * TI_GU; const int l = f >> 1, second = f & 1;
        const int kb = r / (NGU / 32), db = r % (NGU / 32), tile = db >> 3, within = db & 7;
        t.W = ((within < 4) ? in[second ? 17 : 2] : in[second ? 18 : 3]) + (size_t)l * D * FF; t.gain = in[second ? 16 : 1] + l * D; t.WT = WGU + (size_t)f * WGU_STRIDE;
        t.K = D; t.N = FF; t.drow0 = db * 32; t.scol = tile * 128 + (within & 3) * 32 + dl; t.k0 = kb * 64; return;
    }
    r -= 8 * TI_GU;
    if (r < 8 * TI_D) {
        const int f = r / TI_D; r -= f * TI_D; const int l = f >> 1, second = f & 1;
        const int kb = r / (D / 32), db = r % (D / 32);
        t.W = in[second ? 19 : 4] + (size_t)l * FF * D; t.gain = nullptr; t.WT = WD + (size_t)f * WD_STRIDE; t.K = FF; t.N = D; t.drow0 = db * 32; t.scol = db * 32 + dl; t.k0 = kb * 64; return;
    }
    r -= 8 * TI_D;
    if (r < 4 * TI_IN) {
        const int l = r / TI_IN; r -= l * TI_IN;
        const int kb = r / (NIN / 32), db = r % (NIN / 32), d0 = db * 32;
        int scol;
        if (d0 < 3072) scol = d0 + dl;
        else if (d0 < 4608) scol = d0 + 16 + dl;
        else if (d0 == 4608) scol = (dl < 16) ? 3072 + dl : -1;
        else scol = -1;
        t.W = in[6] + (size_t)l * D * IN_W; t.gain = in[5] + l * D; t.WT = WIN + (size_t)l * WIN_STRIDE; t.K = D; t.N = IN_W; t.drow0 = d0; t.scol = scol; t.k0 = kb * 64; return;
    }
    r -= 4 * TI_IN;
    { const int l = r / TI_OUT; r -= l * TI_OUT; const int kb = r / (D / 32), db = r % (D / 32);
      t.W = in[15] + (size_t)l * D * D; t.gain = nullptr; t.WT = WOUT + (size_t)l * WOUT_STRIDE; t.K = D; t.N = D; t.drow0 = db * 32; t.scol = db * 32 + dl; t.k0 = kb * 64; }
}

__device__ __forceinline__ void mall_touch(const void* p, size_t bytes, int gw, int lane, int NGW) {
    const GAS u32x4* tp = (const GAS u32x4*)p;
    const size_t nv = bytes / 16, st = (size_t)NGW * 64;
    unsigned a = 0u;
    for (size_t o = (size_t)gw * 64 + lane; o < nv; o += 4 * st) {
        u32x4 v[4];
#pragma unroll
        for (int j = 0; j < 4; ++j) { const size_t q = o + j * st; v[j] = tp[q < nv ? q : o]; }
#pragma unroll
        for (int j = 0; j < 4; ++j) a |= v[j].x;
    }
    asm volatile("" :: "v"(a));
}
__device__ __forceinline__ void build_rstd(const float* part, int pm, LAS float* tab, int tid) {
    const int r = tid >> 1, hf = tid & 1;
    const f32x4* p = (const f32x4*)(part + (size_t)(pm * 256 + r) * 32 + hf * 16);
    const f32x4 a = p[0], b = p[1], c = p[2], d = p[3];
    float s = ((a.x + a.y) + (a.z + a.w)) + ((b.x + b.y) + (b.z + b.w)) + ((c.x + c.y) + (c.z + c.w)) + ((d.x + d.y) + (d.z + d.w));
    s += pg8::shx(s, tid & 63, 1);
    if (!hf) tab[r] = rsqrtf(s * (1.0f / D) + RMS_EPS);
    __syncthreads();
}

__global__ void __launch_bounds__(NWAVES * 64, 2) fwd(Args args) {
    extern __shared__ __attribute__((aligned(16))) unsigned char lds[];
    LAS unsigned char* const L = (LAS unsigned char*)lds;
    volatile LAS unsigned* const MISC = (volatile LAS unsigned*)(L + MISC_OFF);
    LAS float* const rstd_tab = (LAS float*)(L + RSTD_OFF);
    const int G = gridDim.x, bx = blockIdx.x, NGW = G * NWAVES, NGT = G * NWAVES * 64;
#define LANE_IDS() WS_BASE(); int tid = threadIdx.x; asm volatile("" : "+v"(tid)); const int lane = tid & 63, wave = __builtin_amdgcn_readfirstlane(tid >> 6); \
    const int gw = bx * NWAVES + wave; const int gt = bx * (NWAVES * 64) + tid; (void)lane; (void)gw; (void)gt
    gu32* const ctl = (gu32*)(args.ws + WS_CTL);
#define WS_BASE() __attribute__((address_space(1))) unsigned char* wsg_ = (__attribute__((address_space(1))) unsigned char*)args.ws; asm volatile("" : "+s"(wsg_)); unsigned char* wsb_ = (unsigned char*)wsg_;     \
    int bx = blockIdx.x; asm volatile("" : "+s"(bx))
#define WSP(T, off) ((T*)(wsb_ + (off)))
#define WGU WSP(bf16, WS_WGU)
#define WD WSP(bf16, WS_WD)
#define WIN WSP(bf16, WS_WIN)
#define WOUT WSP(bf16, WS_WOUT)
#define H WSP(float, WS_H)
#define HB WSP(bf16, WS_HB)
#define PART WSP(float, WS_PART)
#define DTRAW WSP(float, WS_DTRAW)
#define DT WSP(float, WS_DT)
#define ACT WSP(bf16, WS_ACT)
#define PROJ WSP(bf16, WS_PROJ)
#define MIXED WSP(bf16, WS_MIXED)
#define XT WSP(bf16, WS_XT)
#define WTG WSP(float, WS_XTS)
#define BC WSP(bf16, WS_BC)
#define BCT WSP(bf16, WS_BCT)
#define CC WSP(bf16, WS_CC)
#define PWT WSP(bf16, WS_PWT)
#define CS WSP(float, WS_CS)
#define ST WSP(float, WS_ST)
#define SIN WSP(bf16, WS_SIN)

    for (int u = threadIdx.x; u < (LDS_BYTES - LDSCTL_OFF) / 4; u += NWAVES * 64) ((LAS unsigned*)(L + LDSCTL_OFF))[u] = 0u;
    __syncthreads();
    const int lo = args.ph_lo, hi = args.ph_hi;
    XcdBarrier bar; bar.bar = (unsigned*)(ctl + CW_BAR); bar.x = 0; bar.st = nullptr;
    if (hi - lo > 1) bar = xcd_barrier_post((unsigned*)(ctl + CW_BAR), MISC + 8);
    int ps = 0;
#define PH_ON (ps >= lo && ps < hi)
#define PH_END do { if (PH_ON && ps + 1 < hi) xcd_barrier(bar); ++ps; } while (0)

#ifndef NO_PRO
    if (PH_ON) for (int rep_ = 0; rep_ < REP_PRO; ++rep_) { if (rep_) __syncthreads();
        LANE_IDS();
        for (int it = gw; it < TI_TOTAL; it += 2 * NGW) {
            TItem ta, tb; f32x4 va[8], vb[8], ga0, ga1, gb0, gb1;
            const bool two = (it + NGW < TI_TOTAL);
            titem_decode(it, lane, args.in, WGU, WD, WIN, WOUT, ta);
            titem_decode(two ? it + NGW : it, lane, args.in, WGU, WD, WIN, WOUT, tb);
            titem_load(ta, lane, va, ga0, ga1);
            titem_load(tb, lane, vb, gb0, gb1);
            titem_store(ta, lane, va, ga0, ga1);
            if (two) titem_store(tb, lane, vb, gb0, gb1);
        }
        for (int idx = gt; idx < 4 * 4 * 128 * 128; idx += NGT) { const int c = idx & 127, d = (idx >> 7) & 127, li = idx >> 14; PWT[idx] = (bf16)f2bf(args.in[7][((size_t)li * 128 + c) * 128 + d]); }
        for (int m = gw; m < M; m += NGW) {
            const GAS f32x4* xr = (const GAS f32x4*)(args.in[0] + (size_t)m * D) + lane;
            GAS unsigned long long* o8 = (GAS unsigned long long*)(HB + (size_t)m * D) + lane;
            float ss = 0.f;
            f32x4 xv[8];
#pragma unroll
            for (int j = 0; j < 8; ++j) xv[j] = xr[64 * j];
            __builtin_amdgcn_sched_barrier(0);
#pragma unroll
            for (int j = 0; j < 8; ++j) { const f32x4 v = xv[j]; const unsigned p0 = pk2(v.x, v.y), p1 = pk2(v.z, v.w);
                const float r0 = __builtin_bit_cast(float, p0 << 16), r1 = __builtin_bit_cast(float, p0 & 0xffff0000u), r2 = __builtin_bit_cast(float, p1 << 16), r3 = __builtin_bit_cast(float, p1 & 0xffff0000u);
                ss += (r0 * r0 + r1 * r1) + (r2 * r2 + r3 * r3);
                o8[64 * j] = (unsigned long long)p0 | ((unsigned long long)p1 << 32); }
            ss = wave_sum(ss, lane);
            if (lane < 32) PART[(size_t)m * 32 + lane] = (lane == 0) ? ss : 0.f;
        }
    }
#endif
    PH_END;

    for (int i = 0; i < 8; ++i) {
        const int l = i >> 1, second = i & 1;
#ifndef NO_UP
        if (PH_ON) for (int rep_ = 0; rep_ < REP_UP; ++rep_) { if (rep_) __syncthreads();
            LANE_IDS();
            pg8::StaticOrder S; S.init(M, NGU, G, bx); pg8::Unit u0; S.next(0, u0);
            pg8::Gemm g{HB, WGU + (size_t)i * WGU_STRIDE, M, NGU, D};
            pg8::EpiSwiGLU E{ACT, FF, rstd_tab};
            pg8::gemm_phase<pg8::EpiSwiGLU, pg8::StaticOrder, true, true, true>(L + RING_OFF, g, S, E, PART, rstd_tab, 1.0f / D, RMS_EPS);
            { int t_ = threadIdx.x; asm volatile("" : "+v"(t_)); mall_touch(WD + (size_t)i * WD_STRIDE, WD_STRIDE * 2, bx * NWAVES + (t_ >> 6), t_ & 63, NGW); }
        }
#endif
        PH_END;
#ifndef NO_DOWN
        if (PH_ON) {
            WS_BASE();
            pg8::StaticOrder S; S.init(M, D, G, bx);
            pg8::Gemm g{ACT, WD + (size_t)i * WD_STRIDE, M, D, FF};
            pg8::EpiResid E{HB, PART, 0.5f / REP_DOWN};
            pg8::gemm_phase<pg8::EpiResid, pg8::StaticOrder, true, true>(L + RING_OFF, g, S, E);
            { int t_ = threadIdx.x; asm volatile("" : "+v"(t_)); const int gw_ = bx * NWAVES + (t_ >> 6), ln_ = t_ & 63;
              if (!second) mall_touch(WIN + (size_t)l * WIN_STRIDE, (size_t)PROJ_LD * D * 2, gw_, ln_, NGW);
              else if (i < 7) mall_touch(WGU + (size_t)(i + 1) * WGU_STRIDE, WGU_STRIDE * 2, gw_, ln_, NGW); }
        }
#if REP_DOWN == 2
        if (PH_ON) {
            WS_BASE();
            pg8::StaticOrder S; S.init(M, D, G, bx);
            pg8::Gemm g{ACT, WD + (size_t)i * WD_STRIDE, M, D, FF};
            pg8::EpiResid E{HB, PART, 0.5f / REP_DOWN};
            pg8::gemm_phase<pg8::EpiResid, pg8::StaticOrder, true, true>(L + RING_OFF, g, S, E);
        }
#endif
#endif
        PH_END;
        if (second) continue;
#ifndef NO_WIN
        if (PH_ON) for (int rep_ = 0; rep_ < REP_WIN; ++rep_) { if (rep_) __syncthreads();
            LANE_IDS();
            pg8::StaticOrder S; S.init(M, PROJ_LD, G, bx); pg8::Unit u0; S.next(0, u0);
            pg8::Gemm g{HB, WIN + (size_t)l * WIN_STRIDE, M, PROJ_LD, D};
            pg8::EpiProj E{PROJ, DTRAW, rstd_tab};
            pg8::gemm_phase<pg8::EpiProj, pg8::StaticOrder, true, true, true>(L + RING_OFF, g, S, E, PART, rstd_tab, 1.0f / D, RMS_EPS);
            if (bx >= 128) {
                const int u = (bx - 128) * NWAVES + wave, rw0 = u * 16, lr = lane & 15, lq = lane >> 4;
                const bf16* Ap = HB + (size_t)(rw0 + lr) * D + lq * 8;
                const bf16* Bp = WIN + (size_t)l * WIN_STRIDE + (size_t)(PROJ_LD + lr) * D + lq * 8;
                float ssq; { const f32x4* pp = (const f32x4*)(PART + (size_t)(rw0 + lr) * 32 + lq * 8); const f32x4 a = pp[0], b = pp[1]; ssq = ((a.x + a.y) + (a.z + a.w)) + ((b.x + b.y) + (b.z + b.w)); }
                ssq += pg8::shx(ssq, lane, 16); ssq += pg8::shx(ssq, lane, 32);
                const float rsr = rsqrtf(ssq * (1.0f / D) + RMS_EPS);
                f32x4 dacc = {0.f, 0.f, 0.f, 0.f};
#pragma unroll 1
                for (int ks0 = 0; ks0 < D / 32; ks0 += 16) {
                    bf16x8 af[16], bfr[16];
#pragma unroll
                    for (int j = 0; j < 16; ++j) { af[j] = *(const bf16x8*)(Ap + (ks0 + j) * 32); bfr[j] = *(const bf16x8*)(Bp + (ks0 + j) * 32); }
                    __builtin_amdgcn_sched_barrier(0);
#pragma unroll
                    for (int j = 0; j < 16; ++j) dacc = __builtin_amdgcn_mfma_f32_16x16x32_bf16(af[j], bfr[j], dacc, 0, 0, 0);
                }
#pragma unroll
                for (int r = 0; r < 4; ++r) { const int row = lq * 4 + r; DTRAW[(size_t)(rw0 + row) * 16 + lr] = dacc[r] * pg8::shl_(rsr, row); }
            }
        }
#endif
        PH_END;
#ifndef NO_M1
        if (PH_ON) for (int rep_ = 0; rep_ < REP_MIX; ++rep_) { if (rep_) __syncthreads();
            LANE_IDS();
            {
                const int r32 = lane & 31, hi = lane >> 5;
                const float* pscale = args.in[8] + l * 512;
                LAS unsigned char* pst = L + RING_OFF + wave * 12288;
                for (int u = gw; u < (M / 32) * 4; u += NGW) {
                    const int gi = u & 3, r0 = (u >> 2) * 32, w = 2 << gi;
                    const int t = (r0 % SEQ) + r32, cnt = (t + 1 < w) ? t + 1 : w; const float inv = 1.0f / (float)cnt;
                    const int seq0 = r0 - (r0 % SEQ);
                    asm volatile("s_waitcnt lgkmcnt(0)" ::: "memory");
#pragma unroll
                    for (int i = 0; i < 12; ++i) { const int row = 4 * i + (lane >> 4), slot = lane & 15, chunk = slot ^ (row & 15);
                        int grow = r0 - 15 + row; grow = grow < seq0 ? seq0 : grow; grow = grow > r0 + 31 ? r0 + 31 : grow;
                        __builtin_amdgcn_global_load_lds((const unsigned*)(PROJ + (size_t)grow * PROJ_LD + P_POOL + gi * 128 + chunk * 8), (LAS unsigned*)(pst + i * 1024), 16, 0, 0); }
                    const bf16* wt = PWT + ((size_t)(l * 4 + gi) * 128 + r32) * 128 + hi * 8;
                    bf16x8 wa0 = *(const bf16x8*)(wt), wa1 = *(const bf16x8*)(wt + 32 * 128), wa2 = *(const bf16x8*)(wt + 64 * 128), wa3 = *(const bf16x8*)(wt + 96 * 128);
                    f32x16 acc0 = {}, acc1 = {}, acc2 = {}, acc3 = {};
                    asm volatile("s_waitcnt vmcnt(0)" ::: "memory");
#define POOL_RD(rr, c) (*(const LAS v4u*)(pst + (rr) * 256 + ((((c) ^ (rr)) & 15) << 4)))
#define POOL_ADD(j) do { const int rr_ = 15 + r32 - (j); const v4u r_ = POOL_RD(rr_, c_); const bool ok = ((j) < cnt); const unsigned rx = ok ? r_.x : 0u, ry = ok ? r_.y : 0u, rz = ok ? r_.z : 0u, rw = ok ? r_.w : 0u; \
                            sum[0] += __builtin_bit_cast(float, rx << 16); sum[1] += __builtin_bit_cast(float, rx & 0xffff0000u); sum[2] += __builtin_bit_cast(float, ry << 16); sum[3] += __builtin_bit_cast(float, ry & 0xffff0000u); \
                            sum[4] += __builtin_bit_cast(float, rz << 16); sum[5] += __builtin_bit_cast(float, rz & 0xffff0000u); sum[6] += __builtin_bit_cast(float, rw << 16); sum[7] += __builtin_bit_cast(float, rw & 0xffff0000u); } while (0)
#define POOL_KSTEPS(W) _Pragma("unroll 1") for (int ks = 0; ks < 8; ++ks) { \
                        const int c_ = 2 * ks + hi; const int kn_ = (ks < 7) ? ks + 1 : 7; \
                        const bf16x8 wn0 = *(const bf16x8*)(wt + kn_ * 16), wn1 = *(const bf16x8*)(wt + 32 * 128 + kn_ * 16), wn2 = *(const bf16x8*)(wt + 64 * 128 + kn_ * 16), wn3 = *(const bf16x8*)(wt + 96 * 128 + kn_ * 16);     asm volatile("" ::: "memory");     \
                        float sum[8], self[8]; \
                        { const v4u r0_ = POOL_RD(15 + r32, c_); \
                          self[0] = __builtin_bit_cast(float, r0_.x << 16); self[1] = __builtin_bit_cast(float, r0_.x & 0xffff0000u); self[2] = __builtin_bit_cast(float, r0_.y << 16); self[3] = __builtin_bit_cast(float, r0_.y & 0xffff0000u); \
                          self[4] = __builtin_bit_cast(float, r0_.z << 16); self[5] = __builtin_bit_cast(float, r0_.z & 0xffff0000u); self[6] = __builtin_bit_cast(float, r0_.w << 16); self[7] = __builtin_bit_cast(float, r0_.w & 0xffff0000u); } \
                        _Pragma("unroll") for (int e = 0; e < 8; ++e) sum[e] = self[e]; \
                        _Pragma("unroll 4") for (int j = 1; j < W; ++j) POOL_ADD(j); \
                        u32x4 q; q.x = cvtpk_s(sum[0] * inv - self[0], sum[1] * inv - self[1]); q.y = cvtpk_s(sum[2] * inv - self[2], sum[3] * inv - self[3]); \
                        q.z = cvtpk_s(sum[4] * inv - self[4], sum[5] * inv - self[5]); q.w = cvtpk_s(sum[6] * inv - self[6], sum[7] * inv - self[7]); \
                        const bf16x8 bfr = __builtin_bit_cast(bf16x8, q); \
                        acc0 = __builtin_amdgcn_mfma_f32_32x32x16_bf16(wa0, bfr, acc0, 0, 0, 0); acc1 = __builtin_amdgcn_mfma_f32_32x32x16_bf16(wa1, bfr, acc1, 0, 0, 0); \
                        acc2 = __builtin_amdgcn_mfma_f32_32x32x16_bf16(wa2, bfr, acc2, 0, 0, 0); acc3 = __builtin_amdgcn_mfma_f32_32x32x16_bf16(wa3, bfr, acc3, 0, 0, 0); \
                        wa0 = wn0; wa1 = wn1; wa2 = wn2; wa3 = wn3; }
                    if (gi == 0) { POOL_KSTEPS(2) } else if (gi == 1) { POOL_KSTEPS(4) } else if (gi == 2) { POOL_KSTEPS(8) } else { POOL_KSTEPS(16) }
#undef POOL_KSTEPS
#undef POOL_ADD
#undef POOL_RD
                    f32x4 psc[4][4];
                    { const float* sp_ = pscale + gi * 128 + 4 * hi;
#pragma unroll
                      for (int rq = 0; rq < 4; ++rq) { psc[rq][0] = *(const f32x4*)(sp_ + 8 * rq); psc[rq][1] = *(const f32x4*)(sp_ + 32 + 8 * rq); psc[rq][2] = *(const f32x4*)(sp_ + 64 + 8 * rq); psc[rq][3] = *(const f32x4*)(sp_ + 96 + 8 * rq); } }
                    __builtin_amdgcn_sched_barrier(0);
                    typedef unsigned u32x2 __attribute__((ext_vector_type(2)));
                    asm volatile("s_waitcnt lgkmcnt(0)" ::: "memory");
#pragma unroll
                    for (int rq = 0; rq < 4; ++rq) {
                        const f32x4 s0 = psc[rq][0], s1 = psc[rq][1], s2 = psc[rq][2], s3 = psc[rq][3];
                        u32x2 o; LAS unsigned char* tp_ = pst + r32 * 272 + rq * 16 + hi * 8;
                        o.x = pk2(acc0[4 * rq] * s0.x, acc0[4 * rq + 1] * s0.y); o.y = pk2(acc0[4 * rq + 2] * s0.z, acc0[4 * rq + 3] * s0.w); *(LAS u32x2*)(tp_) = o;
                        o.x = pk2(acc1[4 * rq] * s1.x, acc1[4 * rq + 1] * s1.y); o.y = pk2(acc1[4 * rq + 2] * s1.z, acc1[4 * rq + 3] * s1.w); *(LAS u32x2*)(tp_ + 64) = o;
                        o.x = pk2(acc2[4 * rq] * s2.x, acc2[4 * rq + 1] * s2.y); o.y = pk2(acc2[4 * rq + 2] * s2.z, acc2[4 * rq + 3] * s2.w); *(LAS u32x2*)(tp_ + 128) = o;
                        o.x = pk2(acc3[4 * rq] * s3.x, acc3[4 * rq + 1] * s3.y); o.y = pk2(acc3[4 * rq + 2] * s3.z, acc3[4 * rq + 3] * s3.w); *(LAS u32x2*)(tp_ + 192) = o;
                    }
                    bf16* op = MIXED + (size_t)(r0 + (lane >> 4)) * D + gi * 128 + (lane & 15) * 8;
#pragma unroll
                    for (int j = 0; j < 8; ++j) *(u32x4*)(op + (size_t)(4 * j) * D) = *(const LAS u32x4*)(pst + ((lane >> 4) + 4 * j) * 272 + (lane & 15) * 16);
                }
            }
            {
                const int r32 = lane & 31, hi = lane >> 5;
                LAS unsigned char* vst = L + RING_OFF + wave * 12288;
                const int wkey = lane >> 3, wcc = lane & 7, woff = (wcc >> 2) * 4096 + (wcc & 3) * 16 + wkey * 64;
                typedef short v4i16_t __attribute__((ext_vector_type(4)));
                LAS v4i16_t* vrd = (LAS v4i16_t*)(vst + ((lane >> 4) & 1) * 32 + (lane & 3) * 8 + (4 * hi + ((lane & 15) >> 2)) * 64);
                for (int ra_ = 0; ra_ < REP_ATT; ++ra_) for (int u = gw; u < 2 * 8 * 256; u += NGW) {
                    const int qt = u & 255, hh = (u >> 8) & 7, b = u >> 11, q0 = qt * 32;
                    const bf16* Pb = PROJ + (size_t)b * SEQ * PROJ_LD + hh * 64;
                    bf16x8 qf[4];
#pragma unroll
                    for (int d0 = 0; d0 < 4; ++d0) { const v4u raw = *(const v4u*)(Pb + (size_t)(q0 + r32) * PROJ_LD + P_Q + d0 * 16 + hi * 8); v4u sc;
                        sc.x = pk2(__builtin_bit_cast(float, raw.x << 16) * 0.125f, __builtin_bit_cast(float, raw.x & 0xffff0000u) * 0.125f); sc.y = pk2(__builtin_bit_cast(float, raw.y << 16) * 0.125f, __builtin_bit_cast(float, raw.y & 0xffff0000u) * 0.125f);
                        sc.z = pk2(__builtin_bit_cast(float, raw.z << 16) * 0.125f, __builtin_bit_cast(float, raw.z & 0xffff0000u) * 0.125f); sc.w = pk2(__builtin_bit_cast(float, raw.w << 16) * 0.125f, __builtin_bit_cast(float, raw.w & 0xffff0000u) * 0.125f);
                        qf[d0] = __builtin_bit_cast(bf16x8, sc); }
                    float carry = 0.f; f32x16 o0 = {}, o1 = {};
                    bf16x8 kn[8];
                    v4u vn[8];
#define ATT_LOAD(kt_) do { const bf16* Kb_ = Pb + (size_t)((kt_) * 64 + r32) * PROJ_LD + P_K + hi * 8; \
        _Pragma("unroll") for (int d0 = 0; d0 < 4; ++d0) { kn[2 * d0] = *(const bf16x8*)(Kb_ + d0 * 16); kn[2 * d0 + 1] = *(const bf16x8*)(Kb_ + (size_t)32 * PROJ_LD + d0 * 16); } \
        _Pragma("unroll") for (int i_ = 0; i_ < 8; ++i_) vn[i_] = *(const v4u*)(Pb + (size_t)((kt_) * 64 + wkey + 8 * i_) * PROJ_LD + P_V + wcc * 8); } while (0)
                    ATT_LOAD(q0 >> 6);
                    for (int kt = q0 >> 6; kt >= 0; --kt) {
                        bf16x8 kc[8]; v4u vc[8];
#pragma unroll
                        for (int i = 0; i < 8; ++i) { kc[i] = kn[i]; vc[i] = vn[i]; }
                        ATT_LOAD(kt > 0 ? kt - 1 : 0);
                        asm volatile("" ::: "memory");
                        f32x16 p0 = {}, p1 = {};
#pragma unroll
                        for (int d0 = 0; d0 < 4; ++d0) { p0 = __builtin_amdgcn_mfma_f32_32x32x16_bf16(kc[2 * d0], qf[d0], p0, 0, 0, 0); p1 = __builtin_amdgcn_mfma_f32_32x32x16_bf16(kc[2 * d0 + 1], qf[d0], p1, 0, 0, 0); }
#pragma unroll
                        for (int i = 0; i < 8; ++i) *(LAS v4u*)(vst + woff + (i >> 1) * 1024 + (i & 1) * 512) = vc[i];
                        const int lim = q0 + r32 - kt * 64;
                        float sp0[16], sp1[16];
#pragma unroll
                        for (int r = 0; r < 16; ++r) { const int kl = (r & 3) + 8 * (r >> 2) + 4 * hi;
                            const float z0 = p0[r], z1 = p1[r];
                            const float s0_ = fmaxf(z0, 0.f) + 0.6931471806f * __builtin_amdgcn_logf(1.0f + __builtin_amdgcn_exp2f(-1.4426950409f * fabsf(z0)));
                            const float s1_ = fmaxf(z1, 0.f) + 0.6931471806f * __builtin_amdgcn_logf(1.0f + __builtin_amdgcn_exp2f(-1.4426950409f * fabsf(z1)));
                            sp0[r] = (kl < lim) ? s0_ : 0.f; sp1[r] = (kl + 32 < lim) ? s1_ : 0.f; }
                        float PS[9], PSp[9];
                        PS[8] = 0.f; PSp[8] = 0.f;
#pragma unroll
                        for (int idx = 7; idx >= 0; --idx) { const int rq = idx & 3; const float gsum = (idx < 4) ? (sp0[4 * rq] + sp0[4 * rq + 1]) + (sp0[4 * rq + 2] + sp0[4 * rq + 3]) : (sp1[4 * rq] + sp1[4 * rq + 1]) + (sp1[4 * rq + 2] + sp1[4 * rq + 3]);
                            PS[idx] = PS[idx + 1] + gsum; }
#pragma unroll
                        for (int idx = 0; idx < 8; ++idx) PSp[idx] = pg8::shx(PS[idx], lane, 32);
#pragma unroll
                        for (int idx = 0; idx < 8; ++idx) { const int rq = idx & 3;
                            float run = carry + PS[idx + 1] + (hi ? PSp[idx + 1] : PSp[idx]);
#pragma unroll
                            for (int e = 3; e >= 0; --e) { const int r = 4 * rq + e, kl = e + 8 * rq + 4 * hi + ((idx < 4) ? 0 : 32);
                                if (idx < 4) { run += sp0[r]; const float w = __builtin_amdgcn_exp2f(1.4426950409f * (p0[r] - run)); p0[r] = (kl < lim) ? w : 0.f; }
                                else         { run += sp1[r]; const float w = __builtin_amdgcn_exp2f(1.4426950409f * (p1[r] - run)); p1[r] = (kl < lim) ? w : 0.f; } } }
                        carry += PS[0] + PSp[0];
                        u32x4 a0, a1, a2, a3;
                        a0.x = cvtpk_s(p0[0], p0[1]); a0.y = cvtpk_s(p0[2], p0[3]); a0.z = cvtpk_s(p0[4], p0[5]); a0.w = cvtpk_s(p0[6], p0[7]);
                        a1.x = cvtpk_s(p0[8], p0[9]); a1.y = cvtpk_s(p0[10], p0[11]); a1.z = cvtpk_s(p0[12], p0[13]); a1.w = cvtpk_s(p0[14], p0[15]);
                        a2.x = cvtpk_s(p1[0], p1[1]); a2.y = cvtpk_s(p1[2], p1[3]); a2.z = cvtpk_s(p1[4], p1[5]); a2.w = cvtpk_s(p1[6], p1[7]);
                        a3.x = cvtpk_s(p1[8], p1[9]); a3.y = cvtpk_s(p1[10], p1[11]); a3.z = cvtpk_s(p1[12], p1[13]); a3.w = cvtpk_s(p1[14], p1[15]);
                        const bf16x8 pa[4] = {__builtin_bit_cast(bf16x8, a0), __builtin_bit_cast(bf16x8, a1), __builtin_bit_cast(bf16x8, a2), __builtin_bit_cast(bf16x8, a3)};
#pragma unroll
                        for (int ks = 0; ks < 4; ++ks) {
                            const v4i16_t l0 = __builtin_amdgcn_ds_read_tr16_b64_v4i16(vrd + (ks * 1024) / 8), h0 = __builtin_amdgcn_ds_read_tr16_b64_v4i16(vrd + (ks * 1024 + 512) / 8);
                            const v4i16_t l1 = __builtin_amdgcn_ds_read_tr16_b64_v4i16(vrd + (4096 + ks * 1024) / 8), h1 = __builtin_amdgcn_ds_read_tr16_b64_v4i16(vrd + (4096 + ks * 1024 + 512) / 8);
                            const bf16x8 v0 = (bf16x8){l0[0], l0[1], l0[2], l0[3], h0[0], h0[1], h0[2], h0[3]}, v1 = (bf16x8){l1[0], l1[1], l1[2], l1[3], h1[0], h1[1], h1[2], h1[3]};
                            o0 = __builtin_amdgcn_mfma_f32_32x32x16_bf16(v0, pa[ks], o0, 0, 0, 0); o1 = __builtin_amdgcn_mfma_f32_32x32x16_bf16(v1, pa[ks], o1, 0, 0, 0);
                        }
                        if (__all(carry >= 88.f)) break;
                    }
#undef ATT_LOAD
                    typedef unsigned u32x2a __attribute__((ext_vector_type(2)));
#pragma unroll
                    for (int rq = 0; rq < 4; ++rq) { u32x2a w0, w1;
                        w0.x = pk2(o0[4 * rq], o0[4 * rq + 1]); w0.y = pk2(o0[4 * rq + 2], o0[4 * rq + 3]); w1.x = pk2(o1[4 * rq], o1[4 * rq + 1]); w1.y = pk2(o1[4 * rq + 2], o1[4 * rq + 3]);
                        *(LAS u32x2a*)(vst + r32 * 144 + rq * 16 + hi * 8) = w0; *(LAS u32x2a*)(vst + r32 * 144 + 64 + rq * 16 + hi * 8) = w1; }
                    bf16* Ob = MIXED + ((size_t)b * SEQ + q0 + (lane >> 3)) * D + 1536 + hh * 64 + (lane & 7) * 8;
#pragma unroll
                    for (int j = 0; j < 4; ++j) *(u32x4*)(Ob + (size_t)(8 * j) * D) = *(const LAS u32x4*)(vst + ((lane >> 3) + 8 * j) * 144 + (lane & 7) * 16);
                    asm volatile("s_waitcnt lgkmcnt(0)" ::: "memory");
                }
            }
            asm volatile("s_waitcnt lgkmcnt(0)\n\ts_barrier" ::: "memory");
            {
                const float* cw = args.in[9] + (size_t)l * 4 * 1536; const float* cb = args.in[10] + l * 1536; const float* dtb = args.in[11] + l * 16; const float* alog = args.in[12] + l * 16;
                { const int u = bx;
                    const int qt = u & 3, bc = u >> 2, r0 = bc * 256;
                    LAS unsigned char* img0 = L + RING_OFF + 16384;
                    const int tpos0 = r0 % SEQ;
#define S0_DMA(q_) do { LAS unsigned char* ib_ = img0 + ((q_) & 1) * 52224; \
        for (int i_ = wave; i_ < 51; i_ += NWAVES) { const int o_ = i_ * 1024 + lane * 16; int row_ = o_ / 768; const int col_ = o_ - row_ * 768; row_ = row_ > 66 ? 66 : row_; \
            int rel_ = 64 * (q_) - 3 + row_; rel_ = (tpos0 + rel_ < 0) ? 0 : rel_;                   \
            __builtin_amdgcn_global_load_lds((const unsigned*)(PROJ + (size_t)(r0 + rel_) * PROJ_LD + P_XBC + qt * 384 + (col_ >> 1)), (LAS unsigned*)(ib_ + i_ * 1024), 16, 0, 0); } } while (0)
                    S0_DMA(0);
                    if (qt == 0) { const int h = tid >> 5, seg = tid & 31; const float A = -__expf(alog[h]), bias = dtb[h];
                      float dtv[8], cs[8]; float run = 0.f;
#pragma unroll
                      for (int k = 0; k < 8; ++k) dtv[k] = DTRAW[(size_t)(r0 + seg * 8 + k) * 16 + h];
                      __builtin_amdgcn_sched_barrier(0);
#pragma unroll
                      for (int k = 0; k < 8; ++k) { dtv[k] = softplus_f(dtv[k] + bias); run += A * dtv[k]; cs[k] = run; }
                      float incl = run;
#pragma unroll
                      for (int d = 1; d < 32; d <<= 1) { const float v = pg8::shl_(incl, (seg >= d) ? lane - d : lane); if (seg >= d) incl += v; }
                      const float excl = incl - run, total = pg8::shl_(incl, lane | 31);
#pragma unroll
                      for (int k = 0; k < 8; ++k) { const float c_ = excl + cs[k]; WTG[(size_t)(bc * 16 + h) * 256 + seg * 8 + k] = dtv[k] * __expf(total - c_); CS[(size_t)(r0 + seg * 8 + k) * 16 + h] = c_; DT[(size_t)(r0 + seg * 8 + k) * 16 + h] = dtv[k]; } }
                    const int rsq = tid & 7, cgl = tid >> 3;
                    const int cg = qt * 48 + cgl, ch0 = cg * 8;
                    float cwr[4][8], cbr[8];
#pragma unroll
                    for (int e = 0; e < 8; ++e) { cwr[0][e] = cw[0 * 1536 + ch0 + e]; cwr[1][e] = cw[1 * 1536 + ch0 + e]; cwr[2][e] = cw[2 * 1536 + ch0 + e]; cwr[3][e] = cw[3 * 1536 + ch0 + e]; cbr[e] = cb[ch0 + e]; }
                    asm volatile("s_waitcnt vmcnt(0)" ::: "memory");
                    __syncthreads();
                    for (int q = 0; q < 4; ++q) {
                        if (q < 3) S0_DMA(q + 1);
                        if (tid < 384) {
                        const int s0 = 64 * q + rsq * 8;
                        const int t0 = tpos0 + s0;
                        const LAS unsigned char* ip = img0 + (q & 1) * 52224 + (rsq * 8) * 768 + cgl * 16;
                        float xin[11][8];
#pragma unroll
                        for (int k = 0; k < 11; ++k) { const bool ok = (t0 - 3 + k >= 0); v4u raw = *(const LAS v4u*)(ip + k * 768);
                            raw.x = ok ? raw.x : 0u; raw.y = ok ? raw.y : 0u; raw.z = ok ? raw.z : 0u; raw.w = ok ? raw.w : 0u;
                            xin[k][0] = __builtin_bit_cast(float, raw.x << 16); xin[k][1] = __builtin_bit_cast(float, raw.x & 0xffff0000u); xin[k][2] = __builtin_bit_cast(float, raw.y << 16); xin[k][3] = __builtin_bit_cast(float, raw.y & 0xffff0000u);
                            xin[k][4] = __builtin_bit_cast(float, raw.z << 16); xin[k][5] = __builtin_bit_cast(float, raw.z & 0xffff0000u); xin[k][6] = __builtin_bit_cast(float, raw.w << 16); xin[k][7] = __builtin_bit_cast(float, raw.w & 0xffff0000u); }
                        float o[8][8];
#pragma unroll
                        for (int e = 0; e < 8; ++e) { const float w0 = cwr[0][e], w1 = cwr[1][e], w2 = cwr[2][e], w3 = cwr[3][e], bb = cbr[e];
#pragma unroll
                            for (int j = 0; j < 8; ++j) o[j][e] = silu_f(bb + w0 * xin[j][e] + w1 * xin[j + 1][e] + w2 * xin[j + 2][e] + w3 * xin[j + 3][e]); }
#define S0_SWAP(a_) do { const bool odd_ = rsq & 1; const unsigned s0_ = odd_ ? a_.x : a_.z, s1_ = odd_ ? a_.y : a_.w; \
        const unsigned r0_ = (unsigned)__builtin_amdgcn_update_dpp(0, (int)s0_, 0xB1, 0xF, 0xF, true), r1_ = (unsigned)__builtin_amdgcn_update_dpp(0, (int)s1_, 0xB1, 0xF, 0xF, true); \
        a_ = odd_ ? (v4u){r0_, r1_, a_.z, a_.w} : (v4u){a_.x, a_.y, r0_, r1_}; } while (0)
                        if (cg < 128) {
                            const int h = cg >> 3, p0 = (cg & 7) * 8;
                            const size_t base = (size_t)(bc * 16 + h) * 16384 + (size_t)((((2 * q + (rsq >> 2)) * 4 + (p0 >> 5) * 2 + ((rsq >> 1) & 1)) * 64 + (rsq & 1) * 32 + (p0 & 31)) * 8);
#pragma unroll
                            for (int e = 0; e < 8; ++e) {
                                v4u a; a.x = pk2(o[0][e], o[1][e]); a.y = pk2(o[2][e], o[3][e]); a.z = pk2(o[4][e], o[5][e]); a.w = pk2(o[6][e], o[7][e]);
                                S0_SWAP(a);
                                *(v4u*)(XT + base + (size_t)e * 8) = a; }
                        } else if (cg < 160) {
                            const int gi = (cg - 128) >> 4, n0 = ((cg - 128) & 15) * 8;
#pragma unroll
                            for (int j = 0; j < 8; ++j) { v4u a; a.x = pk2(o[j][0], o[j][1]); a.y = pk2(o[j][2], o[j][3]); a.z = pk2(o[j][4], o[j][5]); a.w = pk2(o[j][6], o[j][7]);
                                *(v4u*)(BC + (size_t)(r0 + s0 + j) * 256 + gi * 128 + n0) = a; }
                            const size_t base = (size_t)(bc * 2 + gi) * 32768 + (size_t)(((((4 * q + (rsq >> 1)) * 4 + (n0 >> 5)) * 2 + (rsq & 1)) * 32 + (n0 & 31)) * 8);
#pragma unroll
                            for (int e = 0; e < 8; ++e) { v4u a; a.x = pk2(o[0][e], o[1][e]); a.y = pk2(o[2][e], o[3][e]); a.z = pk2(o[4][e], o[5][e]); a.w = pk2(o[6][e], o[7][e]);
                                S0_SWAP(a);
                                *(v4u*)(BCT + base + (size_t)e * 8) = a; }
                        } else {
                            const int gi = (cg - 160) >> 4, n0 = ((cg - 160) & 15) * 8;
#pragma unroll
                            for (int j = 0; j < 8; ++j) { v4u a; a.x = pk2(o[j][0], o[j][1]); a.y = pk2(o[j][2], o[j][3]); a.z = pk2(o[j][4], o[j][5]); a.w = pk2(o[j][6], o[j][7]);
                                *(v4u*)(CC + (size_t)(r0 + s0 + j) * 256 + gi * 128 + n0) = a; }
                        }
                        }
                        if (q < 3) {
                            const int nst = __builtin_amdgcn_readfirstlane((tid < 384) ? ((cg >= 128 && cg < 160) ? 16 : 8) : 0);
                            if (nst == 16) asm volatile("s_waitcnt vmcnt(16)" ::: "memory"); else if (nst == 8) asm volatile("s_waitcnt vmcnt(8)" ::: "memory"); else asm volatile("s_waitcnt vmcnt(0)" ::: "memory");
                        }
                        __syncthreads();
                    }
#undef S0_DMA
#undef S0_SWAP
                }
            }
        }
        PH_END;
#endif
#ifndef NO_M2
        if (PH_ON) for (int rep_ = 0; rep_ < REP_S1; ++rep_) { if (rep_) __syncthreads();
            LANE_IDS();
            const int r32 = lane & 31, hi = lane >> 5;
            for (int u = gw; u < 2 * 32 * 16 * 2; u += NGW) {
                const int nh = u & 1, h = (u >> 1) & 15, bc = u >> 5, g = h >> 3;
                const bf16* Ab = XT + (size_t)(bc * 16 + h) * 16384 + lane * 8;
                const float* Wb = WTG + (size_t)(bc * 16 + h) * 256 + hi * 4;
                const bf16* Bb = BCT + (size_t)(bc * 2 + g) * 32768 + (size_t)(nh * 2 * 64 * 8) + lane * 8;
                f32x16 acc00 = {}, acc01 = {}, acc10 = {}, acc11 = {};
#pragma unroll 1
                for (int kb = 0; kb < 16; kb += 4) {
                    f32x4 wl[4], wh[4]; v4u ar0[4], ar1[4]; bf16x8 b0[4], b1[4];
#pragma unroll
                    for (int j = 0; j < 4; ++j) { const int ks = kb + j;
                        wl[j] = *(const f32x4*)(Wb + ks * 16); wh[j] = *(const f32x4*)(Wb + ks * 16 + 8);
                        const bf16* ap_ = Ab + (((ks >> 1) * 4 + (ks & 1)) * 64) * 8;
                        ar0[j] = *(const v4u*)(ap_); ar1[j] = *(const v4u*)(ap_ + 2 * 64 * 8);
                        b0[j] = *(const bf16x8*)(Bb + (ks * 4) * 64 * 8); b1[j] = *(const bf16x8*)(Bb + (ks * 4 + 1) * 64 * 8); }
                    __builtin_amdgcn_sched_barrier(0);
#pragma unroll
                    for (int j = 0; j < 4; ++j) {
                        const bf16x8 a0 = scale_frag(ar0[j], wl[j], wh[j]), a1 = scale_frag(ar1[j], wl[j], wh[j]);
                        acc00 = __builtin_amdgcn_mfma_f32_32x32x16_bf16(a0, b0[j], acc00, 0, 0, 0); acc01 = __builtin_amdgcn_mfma_f32_32x32x16_bf16(a0, b1[j], acc01, 0, 0, 0);
                        acc10 = __builtin_amdgcn_mfma_f32_32x32x16_bf16(a1, b0[j], acc10, 0, 0, 0); acc11 = __builtin_amdgcn_mfma_f32_32x32x16_bf16(a1, b1[j], acc11, 0, 0, 0);
                    }
                }
                float* Sb = ST + (size_t)(bc * 16 + h) * 8192 + nh * 64 + r32;
#pragma unroll
                for (int r = 0; r < 16; ++r) { const int p = (r & 3) + 8 * (r >> 2) + 4 * hi;
                    Sb[(size_t)p * 128] = acc00[r]; Sb[(size_t)p * 128 + 32] = acc01[r]; Sb[(size_t)(p + 32) * 128] = acc10[r]; Sb[(size_t)(p + 32) * 128 + 32] = acc11[r]; }
            }
        }
        PH_END;
        if (PH_ON) for (int rep_ = 0; rep_ < REP_S2; ++rep_) { if (rep_) __syncthreads();
            LANE_IDS();
            for (int id = gt; id < 2 * 16 * 64 * 64; id += NGT) {
                const int n = ((id >> 6) & 7) * 16 + ((id >> 5) & 1) * 8 + (id & 3) * 2, p = ((id >> 9) & 7) * 8 + ((id >> 2) & 7), h = (id >> 12) & 15, b = id >> 16;
                const int so = ((((p >> 5) * 8 + (n >> 4)) * 2 + ((n >> 3) & 1)) * 32 + (p & 31)) * 8 + (n & 7);
                float c0 = 0.f, c1 = 0.f;
#pragma unroll 1
                for (int cb = 0; cb < 32; cb += 16) {
                    float2 st[16]; float dl[16];
#pragma unroll
                    for (int j = 0; j < 16; ++j) { const int c = cb + j; st[j] = *(const float2*)(ST + (size_t)((b * 32 + c) * 16 + h) * 8192 + p * 128 + n); dl[j] = CS[(size_t)(b * SEQ + c * 256 + 255) * 16 + h]; }
                    __builtin_amdgcn_sched_barrier(0);
#pragma unroll
                    for (int j = 0; j < 16; ++j) { const int c = cb + j;
                        *(unsigned*)(SIN + (size_t)((b * 32 + c) * 16 + h) * 8192 + so) = pk2(c0, c1);
                        const float dec = __expf(dl[j]);
                        c0 = c0 * dec + st[j].x; c1 = c1 * dec + st[j].y; }
                }
            }
        }
        PH_END;
        if (PH_ON) for (int rep_ = 0; rep_ < REP_S3; ++rep_) { if (rep_) __syncthreads();
            LANE_IDS();
            const int r32 = lane & 31, hi = lane >> 5;
            LAS unsigned char* CBl = L + RING_OFF;
            LAS unsigned char* Cl = L + RING_OFF + 73728;
            LAS float* wcs = (LAS float*)(L + RING_OFF + 108544) + wave * 512;
            LAS float* ssb = (LAS float*)(L + RING_OFF + 124928);
            unsigned char* hpark = WSP(unsigned char, WS_Y) + ((size_t)bx * 8 + wave) * 8192;
            LAS float* ssb2 = (LAS float*)(L + RSTD_OFF + 8192);
            LAS float* wG = (LAS float*)(L + RSTD_OFF) + wave * 256;
            static_assert(RSTD_OFF + 8 * 1024 + 4096 <= LDS_BYTES && 108544 + 16384 <= 124928 && 124928 + 4096 <= RING_BYTES && 73728 + 128 * 272 <= 108544 && 18 * 4096 <= 73728 && 256 * 272 <= 73728, "S3 LDS map");
            const float* ng = args.in[14] + l * 1024;
            typedef unsigned u32x2 __attribute__((ext_vector_type(2)));
            if (bx < 256) { const int u = bx;
                const int parity = u & 1, g = (u >> 1) & 1, bc = u >> 2, h = g * 8 + wave, r0 = bc * 256;
                const float Dk = args.in[13][l * 16 + h];
                const int jt0 = parity, jt1 = 3 - parity, jt2 = 4 + parity, jt3 = 7 - parity;
                const int of1 = jt0 + 1, of2 = of1 + jt1 + 1, of3 = of2 + jt2 + 1;
                {
                    const bf16* bsrc = BC + (size_t)(r0 + (tid >> 4)) * 256 + g * 128 + (tid & 15) * 8;
                    LAS unsigned char* bdst = CBl + (tid >> 4) * 272 + (tid & 15) * 16;
                    v4u tb[8], tc[4]; float c_[4], d_[4], ce_[4];
#pragma unroll
                    for (int i = 0; i < 8; ++i) tb[i] = *(const v4u*)(bsrc + (size_t)i * 32 * 256);
#pragma unroll
                    for (int i = 0; i < 4; ++i) { const int jt_ = 4 * (i >> 1) + ((i & 1) ? 3 - parity : parity);
                        tc[i] = *(const v4u*)(CC + (size_t)(r0 + 32 * jt_ + (tid >> 4)) * 256 + g * 128 + (tid & 15) * 8); }
#pragma unroll
                    for (int i = 0; i < 4; ++i) { const int s_ = lane + 64 * i; c_[i] = CS[(size_t)(r0 + s_) * 16 + h]; d_[i] = DT[(size_t)(r0 + s_) * 16 + h]; ce_[i] = CS[(size_t)(r0 + (s_ | 31)) * 16 + h]; }
#pragma unroll
                    for (int i = 0; i < 8; ++i) *(LAS v4u*)(bdst + i * 32 * 272) = tb[i];
#pragma unroll
                    for (int i = 0; i < 4; ++i) *(LAS v4u*)(Cl + (32 * i + (tid >> 4)) * 272 + (tid & 15) * 16) = tc[i];
#pragma unroll
                    for (int i = 0; i < 4; ++i) { const int s_ = lane + 64 * i; wcs[s_] = c_[i]; wcs[256 + s_] = d_[i]; wG[s_] = __expf(ce_[i] - c_[i]) * d_[i]; }
                }
                const bf16* XTh = XT + (size_t)(bc * 16 + h) * 16384 + lane * 8;
                const bf16* SINh = SIN + (size_t)(bc * 16 + h) * 8192 + lane * 8;
                bf16x8 sa[8];
#define SLOAD(base_) do { _Pragma("unroll") for (int ks = 0; ks < 8; ++ks) sa[ks] = *(const GAS bf16x8*)((base_) + ks * 512); } while (0)
                SLOAD((const GAS bf16*)SINh);
                __syncthreads();
                {
                    f32x16 cb0 = {}, cb1 = {}, cb2 = {};
#define S3_CB(dst, t_) do { const int t__ = (t_); if (t__ < 18) { const int k__ = (t__ >= of1) + (t__ >= of2) + (t__ >= of3); const int i__ = t__ - (k__ == 0 ? 0 : k__ == 1 ? of1 : k__ == 2 ? of2 : of3); \
        const LAS unsigned char* bp_ = CBl + (32 * i__ + r32) * 272 + hi * 16; const LAS unsigned char* cp_ = Cl + (32 * k__ + r32) * 272 + hi * 16; \
        _Pragma("unroll") for (int ks = 0; ks < 8; ++ks) dst = __builtin_amdgcn_mfma_f32_32x32x16_bf16(*(const LAS bf16x8*)(bp_ + ks * 32), *(const LAS bf16x8*)(cp_ + ks * 32), dst, 0, 0, 0); } } while (0)
                    S3_CB(cb0, wave); S3_CB(cb1, wave + 8); S3_CB(cb2, wave + 16);
#undef S3_CB
                    __syncthreads();
#define S3_CBW(src, t_) do { const int t__ = (t_); if (t__ < 18) { LAS unsigned char* wp_ = CBl + t__ * 4096 + lane * 16; \
        *(LAS f32x4*)(wp_) = (f32x4){src[0], src[1], src[2], src[3]}; *(LAS f32x4*)(wp_ + 1024) = (f32x4){src[4], src[5], src[6], src[7]}; \
        *(LAS f32x4*)(wp_ + 2048) = (f32x4){src[8], src[9], src[10], src[11]}; *(LAS f32x4*)(wp_ + 3072) = (f32x4){src[12], src[13], src[14], src[15]}; } } while (0)
                    S3_CBW(cb0, wave); S3_CBW(cb1, wave + 8); S3_CBW(cb2, wave + 16);
#undef S3_CBW
                }
#define XLOAD(dst, i_, pt_) do { const GAS bf16* xb_ = XTp + (i_) * 2048; dst[0] = *(const GAS u32x4*)(xb_); dst[1] = *(const GAS u32x4*)(xb_ + 512); } while (0)
#define ZLOAD(jt_, pt_) do { const bf16* zp = PROJ + ((size_t)r0 + 32 * (jt_) + r32) * PROJ_LD + P_Z + h * 64 + (pt_) * 32 + 4 * hi; \
        _Pragma("unroll") for (int rq = 0; rq < 4; ++rq) zr[rq] = *(const u32x2*)(zp + 8 * rq); } while (0)
#pragma unroll
                for (int pt = 0; pt < 2; ++pt) {
                    int lane_ = lane; asm volatile("" : "+v"(lane_));
                    const int r32 = lane_ & 31, hi = lane_ >> 5, lane = lane_;
                    u32x4 xc[2], xn[2];
                    const GAS bf16* XTp = (const GAS bf16*)(XTh + pt * 1024); asm volatile("" : "+v"(XTp));
                    const GAS bf16* SINp = (const GAS bf16*)(SINh + 4096); asm volatile("" : "+v"(SINp));
                    XLOAD(xc, 0, pt);
                    asm volatile("" ::: "memory");
                    f32x16 o[4];
#pragma unroll
                    for (int k = 0; k < 4; ++k) {
                        const LAS unsigned char* cfp = Cl + (k * 32 + r32) * 272 + hi * 16;
                        f32x16 a0 = {};
#pragma unroll
                        for (int ks = 0; ks < 8; ++ks) a0 = __builtin_amdgcn_mfma_f32_32x32x16_bf16(sa[ks], *(const LAS bf16x8*)(cfp + ks * 32), a0, 0, 0, 0);
                        const float e = __expf(wcs[32 * ((k == 0) ? jt0 : (k == 1) ? jt1 : (k == 2) ? jt2 : jt3) + r32]);
#pragma unroll
                        for (int r = 0; r < 16; ++r) a0[r] *= e;
                        o[k] = a0;
                    }
                    if (pt == 0) __syncthreads();
                    u32x2 zr[4];
#pragma unroll
                    for (int i = 0; i < 8; ++i) {
                        const int kd = i >> 1, jtd = (kd == 0) ? jt0 : (kd == 1) ? jt1 : (kd == 2) ? jt2 : jt3;
                        if (i < 7 || jt3 == 7) {
                            if ((i & 1) == 0) { ZLOAD(jtd, pt); }
                            if (i < 7) { XLOAD(xn, i + 1, pt); }
                            if (i == 6 && pt == 0) { SLOAD(SINp); }
                            asm volatile("" ::: "memory");
                            const float cse = wcs[32 * i + 31];
#pragma unroll
                            for (int k = 0; k < 4; ++k) if (k >= kd) {
                                const bool dk_ = (k == kd);
                                const int jt = (k == 0) ? jt0 : (k == 1) ? jt1 : (k == 2) ? jt2 : jt3, ofk = (k == 0) ? 0 : (k == 1) ? of1 : (k == 2) ? of2 : of3;
                                if (!dk_ || i <= jt) {
                                    f32x16 mt; const float csl_ = wcs[32 * jt + r32];
                                    { const LAS unsigned char* rp_ = CBl + (ofk + i) * 4096 + lane * 16;
                                      const f32x4 m0 = *(const LAS f32x4*)(rp_), m1 = *(const LAS f32x4*)(rp_ + 1024), m2 = *(const LAS f32x4*)(rp_ + 2048), m3 = *(const LAS f32x4*)(rp_ + 3072);
                                      mt[0] = m0.x; mt[1] = m0.y; mt[2] = m0.z; mt[3] = m0.w; mt[4] = m1.x; mt[5] = m1.y; mt[6] = m1.z; mt[7] = m1.w;
                                      mt[8] = m2.x; mt[9] = m2.y; mt[10] = m2.z; mt[11] = m2.w; mt[12] = m3.x; mt[13] = m3.y; mt[14] = m3.z; mt[15] = m3.w; }
                                    if (!dk_ || i < jt) {
                                        const float El = __expf(csl_ - cse);
#pragma unroll
                                        for (int r = 0; r < 16; ++r) mt[r] *= El * wG[32 * i + (r & 3) + 8 * (r >> 2) + 4 * hi];
                                    } else {
                                        const int l_loc = 32 * jt + r32;
#pragma unroll
                                        for (int r = 0; r < 16; ++r) { const int s_loc = 32 * i + (r & 3) + 8 * (r >> 2) + 4 * hi;
                                            const float f = __expf(csl_ - wcs[s_loc]) * wcs[256 + s_loc];
                                            float v = mt[r] * f;
                                            v = (s_loc > l_loc) ? 0.f : v; v += (s_loc == l_loc) ? Dk : 0.f;
                                            mt[r] = v; }
                                    }
                                    u32x4 q0, q1;
                                    q0.x = cvtpk_s(mt[0], mt[1]); q0.y = cvtpk_s(mt[2], mt[3]); q0.z = cvtpk_s(mt[4], mt[5]); q0.w = cvtpk_s(mt[6], mt[7]);
                                    q1.x = cvtpk_s(mt[8], mt[9]); q1.y = cvtpk_s(mt[10], mt[11]); q1.z = cvtpk_s(mt[12], mt[13]); q1.w = cvtpk_s(mt[14], mt[15]);
                                    o[k] = __builtin_amdgcn_mfma_f32_32x32x16_bf16(__builtin_bit_cast(bf16x8, xc[0]), __builtin_bit_cast(bf16x8, q0), o[k], 0, 0, 0);
                                    o[k] = __builtin_amdgcn_mfma_f32_32x32x16_bf16(__builtin_bit_cast(bf16x8, xc[1]), __builtin_bit_cast(bf16x8, q1), o[k], 0, 0, 0);
                                }
                            }
                            if (i == jtd) {
                                float ss = 0.f;
#pragma unroll
                                for (int rq = 0; rq < 4; ++rq) {
                                    const u32x2 z0 = zr[rq];
                                    const float za[4] = {__builtin_bit_cast(float, z0.x << 16), __builtin_bit_cast(float, z0.x & 0xffff0000u), __builtin_bit_cast(float, z0.y << 16), __builtin_bit_cast(float, z0.y & 0xffff0000u)};
#pragma unroll
                                    for (int e = 0; e < 4; ++e) { o[kd][4 * rq + e] *= silu_f(za[e]); ss += o[kd][4 * rq + e] * o[kd][4 * rq + e]; }
                                }
                                ss += pg8::shx(ss, lane, 32);
                                if (hi == 0) (pt == 0 ? ssb : ssb2)[kd * 256 + wave * 32 + r32] = ss;
                                if (pt == 0) {
                                    u32x4 h0, h1;
                                    h0.x = pk2(o[kd][0], o[kd][1]); h0.y = pk2(o[kd][2], o[kd][3]); h0.z = pk2(o[kd][4], o[kd][5]); h0.w = pk2(o[kd][6], o[kd][7]);
                                    h1.x = pk2(o[kd][8], o[kd][9]); h1.y = pk2(o[kd][10], o[kd][11]); h1.z = pk2(o[kd][12], o[kd][13]); h1.w = pk2(o[kd][14], o[kd][15]);
                                    *(u32x4*)(hpark + kd * 2048 + lane * 16) = h0; *(u32x4*)(hpark + kd * 2048 + 1024 + lane * 16) = h1; }
                            }
                            xc[0] = xn[0]; xc[1] = xn[1];
                        }
                    }
                    if (pt == 1) {
                        const float* ngp = ng + h * 64 + 4 * hi;
                        f32x4 gq0[4], gq1[4];
#pragma unroll
                        for (int rq = 0; rq < 4; ++rq) { gq0[rq] = *(const f32x4*)(ngp + 8 * rq); gq1[rq] = *(const f32x4*)(ngp + 32 + 8 * rq); }
                        u32x4 hv[4][2];
#pragma unroll
                        for (int k = 0; k < 4; ++k) { hv[k][0] = *(const u32x4*)(hpark + k * 2048 + lane * 16); hv[k][1] = *(const u32x4*)(hpark + k * 2048 + 1024 + lane * 16); }
                        __syncthreads();
                        LAS unsigned char* tb_ = CBl + wave * 4608;
#pragma unroll
                        for (int k = 0; k < 4; ++k) {
                            const int jt = (k == 0) ? jt0 : (k == 1) ? jt1 : (k == 2) ? jt2 : jt3;
                            float tot = 0.f;
#pragma unroll
                            for (int w = 0; w < 8; ++w) tot += ssb[k * 256 + w * 32 + r32] + ssb2[k * 256 + w * 32 + r32];
                            const float rs = rsqrtf(tot * (1.0f / 512.0f) + RMS_EPS);
#pragma unroll
                            for (int rq = 0; rq < 4; ++rq) {
                                const f32x4 g0 = gq0[rq], g1 = gq1[rq];
                                u32x2 w0, w1;
                                const u32x4 hq = hv[k][rq >> 1]; const unsigned ha = (rq & 1) ? hq.z : hq.x, hb = (rq & 1) ? hq.w : hq.y;
                                w0.x = pk2(__builtin_bit_cast(float, ha << 16) * rs * g0.x, __builtin_bit_cast(float, ha & 0xffff0000u) * rs * g0.y); w0.y = pk2(__builtin_bit_cast(float, hb << 16) * rs * g0.z, __builtin_bit_cast(float, hb & 0xffff0000u) * rs * g0.w);
                                w1.x = pk2(o[k][4 * rq] * rs * g1.x, o[k][4 * rq + 1] * rs * g1.y); w1.y = pk2(o[k][4 * rq + 2] * rs * g1.z, o[k][4 * rq + 3] * rs * g1.w);
                                *(LAS u32x2*)(tb_ + r32 * 144 + rq * 16 + hi * 8) = w0; *(LAS u32x2*)(tb_ + r32 * 144 + 64 + rq * 16 + hi * 8) = w1;
                            }
                            bf16* op = MIXED + ((size_t)r0 + 32 * jt + (lane >> 3)) * D + 512 + h * 64 + (lane & 7) * 8;
#pragma unroll
                            for (int j = 0; j < 4; ++j) *(u32x4*)(op + (size_t)(8 * j) * D) = *(const LAS u32x4*)(tb_ + ((lane >> 3) + 8 * j) * 144 + (lane & 7) * 16);
                        }
                    }
                }
#undef XLOAD
#undef ZLOAD
#undef SLOAD
                __syncthreads();
            }
            mall_touch(WOUT + (size_t)l * WOUT_STRIDE, WOUT_STRIDE * 2, gw, lane, NGW);
        }
        PH_END;
#endif
#ifndef NO_WOUT
        if (PH_ON) {
            WS_BASE();
            pg8::StaticOrder S; S.init(M, D, G, bx);
            pg8::Gemm g{MIXED, WOUT + (size_t)l * WOUT_STRIDE, M, D, D};
            pg8::EpiResid E{HB, PART, 1.0f / REP_WOUT};
            pg8::gemm_phase<pg8::EpiResid, pg8::StaticOrder, true, true>(L + RING_OFF, g, S, E);
            { int t_ = threadIdx.x; asm volatile("" : "+v"(t_)); mall_touch(WGU + (size_t)(i + 1) * WGU_STRIDE, WGU_STRIDE * 2, bx * NWAVES + (t_ >> 6), t_ & 63, NGW); }
        }
#if REP_WOUT == 2
        if (PH_ON) {
            WS_BASE();
            pg8::StaticOrder S; S.init(M, D, G, bx);
            pg8::Gemm g{MIXED, WOUT + (size_t)l * WOUT_STRIDE, M, D, D};
            pg8::EpiResid E{HB, PART, 1.0f / REP_WOUT};
            pg8::gemm_phase<pg8::EpiResid, pg8::StaticOrder, true, true>(L + RING_OFF, g, S, E);
        }
#endif
#endif
        PH_END;
    }
    if (PH_ON) {
        LANE_IDS();
        const float* fg = args.in[20];
        f32x4 gg[8];
#pragma unroll
        for (int j = 0; j < 8; ++j) gg[j] = ((const GAS f32x4*)fg + lane)[64 * j];
        static_assert(M % (4 * GRID * NWAVES) == 0, "final norm: four rows per trip");
        for (int m0 = gw; m0 < M; m0 += 4 * NGW) {
            float ps[4]; unsigned long long q[4][8];
#pragma unroll
            for (int r = 0; r < 4; ++r) { const int m = m0 + r * NGW; ps[r] = (lane < 32) ? PART[(size_t)m * 32 + lane] : 0.f;
                const GAS unsigned long long* hr = (const GAS unsigned long long*)(HB + (size_t)m * D) + lane;
#pragma unroll
                for (int j = 0; j < 8; ++j) q[r][j] = hr[64 * j]; }
#pragma unroll
            for (int r = 0; r < 4; ++r) { const int m = m0 + r * NGW;
                const float rs = rsqrtf(wave_sum(ps[r], lane) * (1.0f / D) + RMS_EPS);
                GAS f32x4* orow = (GAS f32x4*)(args.out + (size_t)m * D) + lane;
#pragma unroll
                for (int j = 0; j < 8; ++j) { const unsigned lo_ = (unsigned)q[r][j], hi_ = (unsigned)(q[r][j] >> 32);
                    f32x4 v; v.x = __builtin_bit_cast(float, lo_ << 16); v.y = __builtin_bit_cast(float, lo_ & 0xffff0000u); v.z = __builtin_bit_cast(float, hi_ << 16); v.w = __builtin_bit_cast(float, hi_ & 0xffff0000u);
                    orow[64 * j] = v * rs * gg[j]; }
            }
        }
    }
#undef PH_ON
#undef PH_END
}

constexpr int N_PHASES = 1 + 8 * 2 + 4 * 6 + 1;
#ifndef MK_PER_PHASE
#define MK_PER_PHASE 0
#endif
extern "C" void kernel_launch(void* const* d_in, const int* in_sizes, int n_in, void* d_out, int out_size, void* d_ws, size_t ws_size, hipStream_t stream) {
    static int ok = 0;
    if (ok == 0) {
        if (n_in != 21 || in_sizes[0] != M * D || out_size != M * D || ws_size < WS_END) { fprintf(stderr, "kernel_launch: unexpected shapes / workspace (%d inputs, ws %zu < %zu)\n", n_in, ws_size, (size_t)WS_END); ok = -1; return; }
        int dev = 0, cus = 0;
        if (hipGetDevice(&dev) != hipSuccess || hipDeviceGetAttribute(&cus, hipDeviceAttributeMultiprocessorCount, dev) != hipSuccess || cus < GRID) { fprintf(stderr, "kernel_launch: needs %d CUs, device has %d\n", GRID, cus); ok = -1; return; }
        if (hipFuncSetAttribute((const void*)fwd, hipFuncAttributeMaxDynamicSharedMemorySize, LDS_BYTES) != hipSuccess) { fprintf(stderr, "kernel_launch: hipFuncSetAttribute failed\n"); ok = -1; return; }
        int per_cu = 0;
        if (hipOccupancyMaxActiveBlocksPerMultiprocessor(&per_cu, (const void*)fwd, NWAVES * 64, LDS_BYTES) != hipSuccess || per_cu < 1) { fprintf(stderr, "kernel_launch: occupancy query says %d blocks per CU\n", per_cu); }
        (void)hipGetLastError();
        ok = 1;
    }
    if (ok < 0) return;
    if (hipMemsetAsync((char*)d_ws + WS_CTL, 0, CTL_ZERO_BYTES, stream) != hipSuccess) return;
    Args a{};
    for (int i = 0; i < 21; ++i) a.in[i] = (const float*)d_in[i];
    a.out = (float*)d_out; a.ws = (unsigned char*)d_ws;
#if MK_PER_PHASE
    for (int p = 0; p < N_PHASES; ++p) { a.ph_lo = p; a.ph_hi = p + 1; hipLaunchKernelGGL(fwd, dim3(GRID), dim3(NWAVES * 64), LDS_BYTES, stream, a); }
#else
    a.ph_lo = 0; a.ph_hi = N_PHASES;
    hipLaunchKernelGGL(fwd, dim3(GRID), dim3(NWAVES * 64), LDS_BYTES, stream, a);
#endif
}
```

```cpp
#include <hip/hip_runtime.h>
#include <cstdio>
#include <cstdint>
namespace pg8 {
#define PG8_LAS __attribute__((address_space(3)))
typedef unsigned short bf16_t;
typedef short bf16x8 __attribute__((ext_vector_type(8)));
typedef float f32x4 __attribute__((ext_vector_type(4)));
typedef unsigned u32x4 __attribute__((ext_vector_type(4)));
constexpr int BM = 256, BK = 64, HALF = 128, HTB = HALF * BK * 2  , STAGE_BYTES = 8 * HTB, NXCD = 8, WGM = 8;

__host__ __device__ __forceinline__ int lds_byte(int r, int c) { const int st = (r >> 4) * 2 + (c >> 5), rr = r & 15, cc = c & 31, ob = rr * 64 + cc * 2; return st * 1024 + (ob ^ (((ob >> 9) & 1) << 5)); }
__host__ __device__ __forceinline__ void stage_rc(int b, int& R, int& C) { const int st = b / 1024, sb = b % 1024, swz = sb ^ (((sb >> 9) & 1) << 5); R = (st >> 1) * 16 + swz / 64; C = (st & 1) * 32 + (swz % 64) / 2; }
__host__ __device__ __forceinline__ int perm32(int rho) { const int n = rho >> 4, i = rho & 15; return 8 * (i >> 2) + 4 * n + (i & 3); }

struct Unit { int pm, pn; };
struct Gemm { const bf16_t* A; const bf16_t* Bt; int M, N, K; };

struct StaticOrder {
    int nM, nN, nwg, G, c;
    __host__ __device__ __forceinline__ void init(int M, int N, int G_, int c_) { nM = M / BM; nN = N / BM; nwg = nM * nN; G = G_; c = c_; }
    __host__ __device__ __forceinline__ bool next(int i, Unit& u) const {
        const long L = (long)i * G + c; if (L >= nwg) return false;
        int wgid = (int)L; { const int q = nwg / NXCD, r = nwg % NXCD, xcd = wgid % NXCD, off = wgid / NXCD; wgid = (xcd < r ? xcd * (q + 1) : r * (q + 1) + (xcd - r) * q) + off; }
        const int nig = WGM * nN, gid = wgid / nig, fm = gid * WGM, gsz = (nM - fm) < WGM ? (nM - fm) : WGM;
        u.pm = fm + ((wgid % nig) % gsz); u.pn = (wgid % nig) / gsz; return true;
    }
    __device__ __forceinline__ void a_ready(const Unit&) const {}
    __device__ __forceinline__ void done(const Unit&) const {}
};

__device__ __forceinline__ unsigned cvt_pk_bf16(float lo, float hi) { unsigned r; asm volatile("v_cvt_pk_bf16_f32 %0, %1, %2" : "=v"(r) : "v"(lo), "v"(hi)); return r; }
__device__ __forceinline__ float shx(float v, int lane, int k) { return __builtin_bit_cast(float, __builtin_amdgcn_ds_bpermute((lane ^ k) << 2, __builtin_bit_cast(int, v))); }
__device__ __forceinline__ float shl_(float v, int srclane) { return __builtin_bit_cast(float, __builtin_amdgcn_ds_bpermute(srclane << 2, __builtin_bit_cast(int, v))); }
__device__ __forceinline__ float fast_silu(float g) { return g * __builtin_amdgcn_rcpf(1.0f + __builtin_amdgcn_exp2f(-1.4426950408889634f * g)); }
struct EpiSwiGLU {
    static constexpr bool PERM = true, AFTER_DRAIN = false;
    bf16_t* O; int ldc; const PG8_LAS float* rstd;
    __device__ __forceinline__ void operator()(const f32x4 (&acc)[2][2][4][2], const Unit& u, int wr, int wc, int fr_, int fq_) const {
        int fr = fr_, fq = fq_; asm volatile("" : "+v"(fr), "+v"(fq));
        const int rl0 = wr * 64 + fr;
        bf16_t* base = O + (size_t)(u.pm * BM) * ldc + u.pn * HALF + wc * 32 + 8 * fq;
#pragma unroll
        for (int ai = 0; ai < 2; ++ai)
#pragma unroll
            for (int m = 0; m < 4; ++m) {
                const int rl = rl0 + ai * HALF + m * 16; const float r = rstd[rl];
                const float rn = -1.4426950408889634f * r, r2 = r * r;
                u32x4 w;
#pragma unroll
                for (int n = 0; n < 2; ++n) {
                    const f32x4 ag = acc[ai][0][m][n], au = acc[ai][1][m][n];
                    const f32x4 t = ag * rn;
                    f32x4 d; d[0] = __builtin_amdgcn_exp2f(t[0]); d[1] = __builtin_amdgcn_exp2f(t[1]); d[2] = __builtin_amdgcn_exp2f(t[2]); d[3] = __builtin_amdgcn_exp2f(t[3]);
                    d = d + 1.0f;
                    f32x4 rc; rc[0] = __builtin_amdgcn_rcpf(d[0]); rc[1] = __builtin_amdgcn_rcpf(d[1]); rc[2] = __builtin_amdgcn_rcpf(d[2]); rc[3] = __builtin_amdgcn_rcpf(d[3]);
                    const f32x4 o_ = (ag * au) * (rc * r2);
                    if (n == 0) { w.x = cvt_pk_bf16(o_[0], o_[1]); w.y = cvt_pk_bf16(o_[2], o_[3]); } else { w.z = cvt_pk_bf16(o_[0], o_[1]); w.w = cvt_pk_bf16(o_[2], o_[3]); }
                }
                *(u32x4*)(base + (size_t)rl * ldc) = w;
            }
    }
};
struct EpiResid {
    static constexpr bool PERM = true, AFTER_DRAIN = false;
    bf16_t* Hb; float* part; float scale;
    __device__ __forceinline__ void operator()(const f32x4 (&acc)[2][2][4][2], const Unit& u, int wr, int wc, int fr_, int fq_) const {
        int fr = fr_, fq = fq_; asm volatile("" : "+v"(fr), "+v"(fq));
        const int row0 = u.pm * BM + wr * 64 + fr, col0 = u.pn * BM + wc * 32 + 8 * fq;
        u32x4 hq[2][4][2];
#pragma unroll
        for (int ai = 0; ai < 2; ++ai)
#pragma unroll
            for (int m = 0; m < 4; ++m)
#pragma unroll
                for (int bj = 0; bj < 2; ++bj) hq[ai][m][bj] = *(const u32x4*)(Hb + (size_t)(row0 + ai * HALF + m * 16) * 2048 + col0 + bj * HALF);
        __builtin_amdgcn_sched_barrier(0);
#pragma unroll
        for (int ai = 0; ai < 2; ++ai)
#pragma unroll
            for (int m = 0; m < 4; ++m) {
                const int row = row0 + ai * HALF + m * 16; float ss = 0.f;
#pragma unroll
                for (int bj = 0; bj < 2; ++bj) {
                    const size_t off = (size_t)row * 2048 + col0 + bj * HALF;
                    const u32x4 h_ = hq[ai][m][bj];
                    f32x4 v0, v1;
                    v0[0] = __builtin_bit_cast(float, h_.x << 16); v0[1] = __builtin_bit_cast(float, h_.x & 0xffff0000u); v0[2] = __builtin_bit_cast(float, h_.y << 16); v0[3] = __builtin_bit_cast(float, h_.y & 0xffff0000u);
                    v1[0] = __builtin_bit_cast(float, h_.z << 16); v1[1] = __builtin_bit_cast(float, h_.z & 0xffff0000u); v1[2] = __builtin_bit_cast(float, h_.w << 16); v1[3] = __builtin_bit_cast(float, h_.w & 0xffff0000u);
                    v0 = v0 + acc[ai][bj][m][0] * scale; v1 = v1 + acc[ai][bj][m][1] * scale;
                    u32x4 w; w.x = cvt_pk_bf16(v0[0], v0[1]); w.y = cvt_pk_bf16(v0[2], v0[3]); w.z = cvt_pk_bf16(v1[0], v1[1]); w.w = cvt_pk_bf16(v1[2], v1[3]);
                    *(u32x4*)(Hb + off) = w;
                    const float r0 = __builtin_bit_cast(float, w.x << 16), r1 = __builtin_bit_cast(float, w.x & 0xffff0000u), r2 = __builtin_bit_cast(float, w.y << 16), r3 = __builtin_bit_cast(float, w.y & 0xffff0000u);
                    const float r4 = __builtin_bit_cast(float, w.z << 16), r5 = __builtin_bit_cast(float, w.z & 0xffff0000u), r6 = __builtin_bit_cast(float, w.w << 16), r7 = __builtin_bit_cast(float, w.w & 0xffff0000u);
                    ss += (r0 * r0 + r1 * r1) + (r2 * r2 + r3 * r3) + (r4 * r4 + r5 * r5) + (r6 * r6 + r7 * r7);
                }
                { const int ln = fq * 16 + fr; ss += shx(ss, ln, 16); ss += shx(ss, ln, 32); }
                if (fq == 0) part[(size_t)row * 32 + u.pn * 4 + wc] = ss;
            }
    }
};
struct EpiProj {
    static constexpr bool PERM = true, AFTER_DRAIN = false;
    bf16_t* O; float* dtraw; const PG8_LAS float* rstd;
    __device__ __forceinline__ void operator()(const f32x4 (&acc)[2][2][4][2], const Unit& u, int wr, int wc, int fr_, int fq_) const {
        int fr = fr_, fq = fq_; asm volatile("" : "+v"(fr), "+v"(fq));
        const int rl0 = wr * 64 + fr;
        {
            bf16_t* base = O + (size_t)(u.pm * BM) * 4608 + u.pn * BM + wc * 32 + 8 * fq;
#pragma unroll
            for (int ai = 0; ai < 2; ++ai)
#pragma unroll
                for (int m = 0; m < 4; ++m) {
                    const int rl = rl0 + ai * HALF + m * 16; const float r = rstd[rl];
#pragma unroll
                    for (int bj = 0; bj < 2; ++bj) {
                        const f32x4 v0 = acc[ai][bj][m][0] * r, v1 = acc[ai][bj][m][1] * r;
                        u32x4 w; w.x = cvt_pk_bf16(v0[0], v0[1]); w.y = cvt_pk_bf16(v0[2], v0[3]); w.z = cvt_pk_bf16(v1[0], v1[1]); w.w = cvt_pk_bf16(v1[2], v1[3]);
                        *(u32x4*)(base + (size_t)rl * 4608 + bj * HALF) = w;
                    }
                }
        }
    }
};
template <class Epi, class Sched, bool ALIGN_EPI = false, bool SP2 = false, bool RS = false>
__device__ __forceinline__ void gemm_phase(PG8_LAS unsigned char* lds, const Gemm g, const Sched& S, const Epi& E, const float* rpart = nullptr, PG8_LAS float* rtab = nullptr, float rinvd = 0.f, float reps = 0.f) {
    int tid_ = threadIdx.x; asm volatile("" : "+v"(tid_));
    const int tid = tid_, wid = __builtin_amdgcn_readfirstlane(tid >> 6), lane = tid & 63, wr = wid >> 2, wc = wid & 3, fr = lane & 15, fq = lane >> 4;
    const int K = g.K, nt = K / BK;
    unsigned voffA[2], voffB[2];
#pragma unroll
    for (int i = 0; i < 2; ++i) { int R, C; stage_rc(tid * 16 + i * 8192, R, C); const int Rb = Epi::PERM ? ((R & ~31) + perm32(R & 31)) : R;
        voffA[i] = (unsigned)(R * K + C) * 2u; voffB[i] = (unsigned)(Rb * K + C) * 2u; }
    const size_t kstep = (size_t)(BK * 2);
    const size_t hstep = (size_t)HALF * K * 2;
    const size_t tstep = 2 * hstep;
    const unsigned ldsw = (unsigned)wid * 1024u;
    const int aoff = lds_byte(wr * 64 + fr, fq * 8), boff = lds_byte(wc * 32 + fr, fq * 8);
#define PG8_SA(b, h) (((b) * 2 + (h)) * HTB)
#define PG8_SB(b, h) ((4 + (b) * 2 + (h)) * HTB)
#define PG8_STAGE(bufoff, gbase, voff) do { _Pragma("unroll") for (int _i = 0; _i < 2; ++_i) \
        __builtin_amdgcn_global_load_lds((const unsigned*)((const char*)(gbase) + (voff)[_i]), (PG8_LAS unsigned*)(lds + (bufoff) + ldsw + _i * 8192), 16, 0, 0); } while (0)
#define PG8_LDA(dst, b, h) do { _Pragma("unroll") for (int m = 0; m < 4; ++m) _Pragma("unroll") for (int k = 0; k < 2; ++k) dst[m][k] = *(const PG8_LAS bf16x8*)(lds + PG8_SA(b, h) + aoff + m * 2048 + k * 1024); } while (0)
#define PG8_LDB(dst, b, h) do { _Pragma("unroll") for (int n = 0; n < 2; ++n) _Pragma("unroll") for (int k = 0; k < 2; ++k) dst[n][k] = *(const PG8_LAS bf16x8*)(lds + PG8_SB(b, h) + boff + n * 2048 + k * 1024); } while (0)
#define PG8_MMA(ai, bj, At, Bt) do { __builtin_amdgcn_s_setprio(1); _Pragma("unroll") for (int m = 0; m < 4; ++m) _Pragma("unroll") for (int n = 0; n < 2; ++n) _Pragma("unroll") for (int k = 0; k < 2; ++k) \
        acc[ai][bj][m][n] = __builtin_amdgcn_mfma_f32_16x16x32_bf16(Bt[n][k], At[m][k], acc[ai][bj][m][n], 0, 0, 0); __builtin_amdgcn_s_setprio(0); } while (0)
#define PG8_WAIT_V(n) asm volatile("s_waitcnt vmcnt(" #n ")" ::: "memory")
#define PG8_WAIT_L(n) asm volatile("s_waitcnt lgkmcnt(" #n ")" ::: "memory")
#define PG8_BAR __builtin_amdgcn_s_barrier()
#define PG8_SCHED __builtin_amdgcn_sched_barrier(0)
    Unit cur, nxt; int ui = 0;
    if (!S.next(0, cur)) return;
    f32x4 acc[2][2][4][2];
#pragma unroll
    for (int a = 0; a < 2; ++a)
#pragma unroll
        for (int b = 0; b < 2; ++b)
#pragma unroll
            for (int m = 0; m < 4; ++m)
#pragma unroll
                for (int n = 0; n < 2; ++n) acc[a][b][m][n] = (f32x4){0.f, 0.f, 0.f, 0.f};
    bf16x8 At[4][2], B0[2][2], B1[2][2];
    const char* cA = (const char*)g.A + (size_t)cur.pm * tstep; const char* cB = (const char*)g.Bt + (size_t)cur.pn * tstep;
    S.a_ready(cur);
    f32x4 rq0 = {}, rq1 = {}, rq2 = {}, rq3 = {};
    if constexpr (RS) { const f32x4* rp_ = (const f32x4*)(rpart + (size_t)(cur.pm * 256 + (tid >> 1)) * 32 + (tid & 1) * 16); rq0 = rp_[0]; rq1 = rp_[1]; rq2 = rp_[2]; rq3 = rp_[3]; }
    if constexpr (SP2) {
        PG8_STAGE(PG8_SB(0, 0), cB, voffB); PG8_STAGE(PG8_SB(0, 1), cB + hstep, voffB); PG8_STAGE(PG8_SA(0, 0), cA, voffA); PG8_STAGE(PG8_SA(0, 1), cA + hstep, voffA);
        if (wr == 1) PG8_BAR;
        PG8_WAIT_V(2); PG8_BAR;
        PG8_STAGE(PG8_SB(1, 0), cB + kstep, voffB); PG8_STAGE(PG8_SA(1, 0), cA + kstep, voffA); PG8_STAGE(PG8_SB(1, 1), cB + hstep + kstep, voffB);
        if constexpr (RS) { float s_ = ((rq0.x + rq0.y) + (rq0.z + rq0.w)) + ((rq1.x + rq1.y) + (rq1.z + rq1.w)) + ((rq2.x + rq2.y) + (rq2.z + rq2.w)) + ((rq3.x + rq3.y) + (rq3.z + rq3.w));
            s_ += shx(s_, lane, 1); if (!(tid & 1)) rtab[tid >> 1] = rsqrtf(s_ * rinvd + reps); }
        PG8_WAIT_V(6); PG8_BAR;
    } else {
        PG8_STAGE(PG8_SB(0, 0), cB, voffB); PG8_STAGE(PG8_SA(0, 0), cA, voffA); PG8_STAGE(PG8_SB(0, 1), cB + hstep, voffB); PG8_STAGE(PG8_SA(0, 1), cA + hstep, voffA);
        if (wr == 1) PG8_BAR;
        PG8_WAIT_V(4); PG8_BAR;
        PG8_STAGE(PG8_SB(1, 0), cB + kstep, voffB); PG8_STAGE(PG8_SA(1, 0), cA + kstep, voffA); PG8_STAGE(PG8_SB(1, 1), cB + hstep + kstep, voffB);
        PG8_WAIT_V(6); PG8_BAR;
    }
    for (;;) {
        const bool has_next = S.next(ui + 1, nxt);
        const char* nA = has_next ? (const char*)g.A + (size_t)nxt.pm * tstep : cA; const char* nB = has_next ? (const char*)g.Bt + (size_t)nxt.pn * tstep : cB;
        for (int t = 0; t < nt; t += 2) {
            const bool last = (t == nt - 2);
            const char* a1 = cA + (size_t)(t + 1) * kstep;
            const char* a2 = last ? nA : cA + (size_t)(t + 2) * kstep; const char* b2 = last ? nB : cB + (size_t)(t + 2) * kstep;
            const char* a3 = a2 + kstep; const char* b3 = b2 + kstep;
            if (last && has_next) S.a_ready(nxt);
            if constexpr (SP2) {
            PG8_LDB(B0, 0, 0); PG8_LDB(B1, 0, 1); PG8_SCHED; PG8_LDA(At, 0, 0); PG8_STAGE(PG8_SA(1, 1), a1 + hstep, voffA);
            PG8_WAIT_V(8); PG8_WAIT_L(0); PG8_BAR; PG8_MMA(0, 0, At, B0); PG8_MMA(0, 1, At, B1); PG8_BAR; PG8_SCHED;
            PG8_LDA(At, 0, 1); PG8_STAGE(PG8_SB(0, 0), b2, voffB); PG8_STAGE(PG8_SB(0, 1), b2 + hstep, voffB); PG8_STAGE(PG8_SA(0, 0), a2, voffA);
            PG8_WAIT_V(8); PG8_WAIT_L(0); PG8_BAR; PG8_MMA(1, 0, At, B0); PG8_MMA(1, 1, At, B1); PG8_BAR; PG8_SCHED;
            PG8_LDB(B0, 1, 0); PG8_LDB(B1, 1, 1); PG8_SCHED; PG8_LDA(At, 1, 0); PG8_STAGE(PG8_SA(0, 1), a2 + hstep, voffA);
            PG8_WAIT_V(8); PG8_WAIT_L(0); PG8_BAR; PG8_MMA(0, 0, At, B0); PG8_MMA(0, 1, At, B1); PG8_BAR; PG8_SCHED;
            PG8_LDA(At, 1, 1); PG8_STAGE(PG8_SB(1, 0), b3, voffB); PG8_STAGE(PG8_SB(1, 1), b3 + hstep, voffB); PG8_STAGE(PG8_SA(1, 0), a3, voffA);
            PG8_WAIT_V(8); PG8_WAIT_L(0); PG8_BAR; PG8_MMA(1, 0, At, B0); PG8_MMA(1, 1, At, B1); PG8_BAR; PG8_SCHED;
            } else {
            PG8_LDB(B0, 0, 0); PG8_SCHED; PG8_LDA(At, 0, 0); PG8_STAGE(PG8_SA(1, 1), a1 + hstep, voffA);
            PG8_WAIT_L(8); PG8_BAR; PG8_WAIT_L(0); PG8_MMA(0, 0, At, B0); PG8_BAR; PG8_SCHED;
            PG8_LDB(B1, 0, 1); PG8_STAGE(PG8_SB(0, 0), b2, voffB);
            PG8_BAR; PG8_WAIT_L(0); PG8_MMA(0, 1, At, B1); PG8_BAR;
            PG8_LDA(At, 0, 1); PG8_STAGE(PG8_SA(0, 0), a2, voffA);
            PG8_BAR; PG8_WAIT_L(0); PG8_MMA(1, 0, At, B0); PG8_BAR; PG8_SCHED;
            PG8_STAGE(PG8_SB(0, 1), b2 + hstep, voffB);
            PG8_WAIT_V(6); PG8_BAR; PG8_MMA(1, 1, At, B1); PG8_BAR;
            PG8_LDB(B0, 1, 0); PG8_SCHED; PG8_LDA(At, 1, 0); PG8_STAGE(PG8_SA(0, 1), a2 + hstep, voffA);
            PG8_WAIT_L(8); PG8_BAR; PG8_WAIT_L(0); PG8_MMA(0, 0, At, B0); PG8_BAR; PG8_SCHED;
            PG8_LDB(B1, 1, 1); PG8_STAGE(PG8_SB(1, 0), b3, voffB);
            PG8_BAR; PG8_WAIT_L(0); PG8_MMA(0, 1, At, B1); PG8_BAR;
            PG8_LDA(At, 1, 1); PG8_STAGE(PG8_SA(1, 0), a3, voffA);
            PG8_BAR; PG8_WAIT_L(0); PG8_MMA(1, 0, At, B0); PG8_BAR; PG8_SCHED;
            PG8_STAGE(PG8_SB(1, 1), b3 + hstep, voffB);
            PG8_WAIT_V(6); PG8_BAR; PG8_MMA(1, 1, At, B1); PG8_BAR;
            }
        }
        if constexpr (ALIGN_EPI) { if (wr == 0) PG8_BAR; }
        if constexpr (!Epi::AFTER_DRAIN) { E(acc, cur, wr, wc, fr, fq); S.done(cur); }
        if (!has_next) break;
#pragma unroll
        for (int a = 0; a < 2; ++a)
#pragma unroll
            for (int b = 0; b < 2; ++b)
#pragma unroll
                for (int m = 0; m < 4; ++m)
#pragma unroll
                    for (int n = 0; n < 2; ++n) acc[a][b][m][n] = (f32x4){0.f, 0.f, 0.f, 0.f};
        cur = nxt; cA = nA; cB = nB; ++ui;
        if constexpr (ALIGN_EPI) { if (wr == 1) PG8_BAR; }
    }
    PG8_WAIT_V(0);
    if constexpr (!ALIGN_EPI) { if (wr == 0) PG8_BAR; }
    PG8_BAR;
    if constexpr (Epi::AFTER_DRAIN) { E.fused(acc, cur, wr, wc, fr, fq, lds, wid, lane); S.done(cur); }
#undef PG8_SA
#undef PG8_SB
#undef PG8_STAGE
#undef PG8_LDA
#undef PG8_LDB
#undef PG8_MMA
#undef PG8_WAIT_V
#undef PG8_WAIT_L
#undef PG8_BAR
#undef PG8_SCHED
}
}
#define GAS __attribute__((address_space(1)))
#define LAS __attribute__((address_space(3)))
typedef unsigned short bf16;
typedef unsigned v4u __attribute__((ext_vector_type(4)));
typedef float f32x4 __attribute__((ext_vector_type(4)));
typedef short bf16x8 __attribute__((ext_vector_type(8)));
typedef float f32x16 __attribute__((ext_vector_type(16)));
typedef GAS unsigned gu32;
typedef GAS unsigned long long gu64;
#define RLX_AGENT __ATOMIC_RELAXED, __HIP_MEMORY_SCOPE_AGENT
#define LDS_WAIT() asm volatile("s_waitcnt lgkmcnt(0)" ::: "memory")
#define VM_WAIT() asm volatile("s_waitcnt vmcnt(0)" ::: "memory")
__device__ __forceinline__ unsigned long long rt() { return __builtin_amdgcn_s_memrealtime(); }
__device__ __forceinline__ unsigned f2bf(float f) { unsigned u = __builtin_bit_cast(unsigned, f); return (u + 0x7fffu + ((u >> 16) & 1u)) >> 16; }
typedef float f32x2_t __attribute__((ext_vector_type(2))); typedef __bf16 bf16x2_t __attribute__((ext_vector_type(2)));
__device__ __forceinline__ unsigned pk2(float lo, float hi) { f32x2_t v = {lo, hi}; bf16x2_t b = __builtin_convertvector(v, bf16x2_t); return __builtin_bit_cast(unsigned, b); }

#define XB_TMO      128
#define XB_XCNT(j)  (256  + 64 * (j))
#define XB_XSUB(j)  (1280 + 64 * (j))
#define XB_XGEN(j)  (2304 + 64 * (j))
#define XB_TOP      3328
#define XB_TOPGEN   3392
#define XCD_BAR_WORDS 3456
#define XB_SPIN_CAP (1u << 18)

__device__ __forceinline__ unsigned xb_ld(unsigned* p)              { return __hip_atomic_load(p, __ATOMIC_RELAXED, __HIP_MEMORY_SCOPE_AGENT); }
__device__ __forceinline__ unsigned xb_add(unsigned* p, unsigned v) { return __hip_atomic_fetch_add(p, v, __ATOMIC_RELAXED, __HIP_MEMORY_SCOPE_AGENT); }
__device__ __forceinline__ unsigned xb_xcc_id() { return (unsigned)__builtin_amdgcn_s_getreg((3 << 11) | 20) & 0xFu; }
#define XB_SPIN(cond, bar) do { unsigned _sp = 0; while (cond) { __builtin_amdgcn_s_sleep(1); \
    if ((++_sp & 255u) == 0u) { if (xb_ld(&(bar)[XB_TMO])) break; if (_sp > XB_SPIN_CAP) { atomicAdd(&(bar)[XB_TMO], 1u); break; } } } } while (0)

struct XcdBarrier {
    unsigned* bar; unsigned x;
    volatile LAS unsigned* st;
};

__device__ __forceinline__ XcdBarrier xcd_barrier_post(unsigned* bar, volatile LAS unsigned* st) {
    XcdBarrier b; b.bar = bar; b.x = xb_xcc_id(); b.st = st;
    if (threadIdx.x == 0) (void)xb_add(&bar[XB_XCNT(b.x)], 1u);
    return b;
}
__device__ __forceinline__ void xcd_barrier_complete(unsigned* bar, unsigned x, unsigned& nloc, unsigned& nx) {
    const unsigned G = gridDim.x * gridDim.y * gridDim.z;
    unsigned sum, cnt, mine, sp = 0u;
    for (;;) {
        sum = 0u; cnt = 0u; mine = 0u;
#pragma unroll 1
        for (unsigned j = 0; j < 16; ++j) { const unsigned c = xb_ld(&bar[XB_XCNT(j)]); sum += c; cnt += (c > 0u) ? 1u : 0u; mine = (j == x) ? c : mine; }
        if (sum == G) break;
        __builtin_amdgcn_s_sleep(1);
        if ((++sp & 255u) == 0u) { if (xb_ld(&bar[XB_TMO])) break; if (sp > XB_SPIN_CAP) { atomicAdd(&bar[XB_TMO], 1u); break; } }
    }
    nloc = mine > 0u ? mine : 1u; nx = cnt > 0u ? cnt : 1u;
}

__device__ __forceinline__ void xcd_barrier(const XcdBarrier& b) {
    asm volatile("s_waitcnt vmcnt(0)" ::: "memory");
    __syncthreads();
    if (threadIdx.x == 0) {
        unsigned* bar = b.bar;
        __builtin_amdgcn_s_waitcnt(0);
        unsigned nloc = b.st[0], nx = b.st[1];
        if (nloc == 0u) { xcd_barrier_complete(bar, b.x, nloc, nx); b.st[0] = nloc; b.st[1] = nx; }
        const unsigned old = xb_add(&bar[XB_XSUB(b.x)], 1u);
        const unsigned gen = old / nloc;
        if (old + 1u == (gen + 1u) * nloc) {
            __builtin_amdgcn_fence(__ATOMIC_RELEASE, "agent");
            asm volatile("s_waitcnt vmcnt(0)" ::: "memory");
            const unsigned og = xb_add(&bar[XB_TOP], 1u);
            const unsigned tg = og / nx;
            if (og + 1u == (tg + 1u) * nx) xb_add(&bar[XB_TOPGEN], 1u);
            else XB_SPIN(xb_ld(&bar[XB_TOPGEN]) == tg, bar);
            __builtin_amdgcn_fence(__ATOMIC_ACQUIRE, "agent");
            xb_add(&bar[XB_XGEN(b.x)], 1u);
            asm volatile("s_waitcnt vmcnt(0)" ::: "memory");
        } else {
            XB_SPIN(xb_ld(&bar[XB_XGEN(b.x)]) == gen, bar);
            __builtin_amdgcn_fence(__ATOMIC_ACQUIRE, "agent");
            asm volatile("s_waitcnt vmcnt(0)" ::: "memory");
        }
    }
    __syncthreads();
}

__device__ __forceinline__ void quad_barrier(unsigned* cnt, volatile LAS unsigned* nloc, unsigned* bar) {
    asm volatile("s_waitcnt vmcnt(0)" ::: "memory");
    __syncthreads();
    if (threadIdx.x == 0) {
        __builtin_amdgcn_s_waitcnt(0);
        const unsigned k = nloc[0] + 1u; nloc[0] = k;
        __builtin_amdgcn_fence(__ATOMIC_RELEASE, "agent");
        asm volatile("s_waitcnt vmcnt(0)" ::: "memory");
        (void)xb_add(cnt, 1u);
        XB_SPIN(xb_ld(cnt) < 4u * k, bar);
        __builtin_amdgcn_fence(__ATOMIC_ACQUIRE, "agent");
        asm volatile("s_waitcnt vmcnt(0)" ::: "memory");
    }
    __syncthreads();
}

#ifndef REP_PRO
#define REP_PRO 1
#endif
#ifndef REP_UP
#define REP_UP 1
#endif
#ifndef REP_WIN
#define REP_WIN 1
#endif
#ifndef REP_MIX
#define REP_MIX 1
#endif
#ifndef REP_DOWN
#define REP_DOWN 1
#endif
#ifndef REP_WOUT
#define REP_WOUT 1
#endif
#ifndef REP_ATT
#define REP_ATT 1
#endif
#ifndef REP_S1
#define REP_S1 1
#endif
#ifndef REP_S2
#define REP_S2 1
#endif
#ifndef REP_S3
#define REP_S3 1
#endif
constexpr int NWAVES = 8;
constexpr int BATCH = 2, SEQ = 8192, M = BATCH * SEQ, D = 2048, FF = 5632, NGU = 2 * FF, DEPTH = 4;
constexpr int NIN = 4864, PROJ_LD = 4608;
constexpr int P_POOL = 0, P_Z = 512, P_XBC = 1536, P_Q = 3072, P_K = 3584, P_V = 4096;
constexpr int IN_W = 4624;
constexpr float RMS_EPS = 1e-6f;
constexpr int GRID = 256;

constexpr size_t MiB = 1u << 20;
constexpr size_t WS_CTL = 0, CTL_ZERO_BYTES = 1 * MiB;
constexpr size_t WS_PWT = 1 * MiB;
constexpr size_t WS_WGU = 2 * MiB;        constexpr size_t WGU_STRIDE = (size_t)NGU * D;
constexpr size_t WS_WD = 354 * MiB;       constexpr size_t WD_STRIDE = (size_t)D * FF;
constexpr size_t WS_WIN = 530 * MiB;      constexpr size_t WIN_STRIDE = (size_t)NIN * D;
constexpr size_t WS_WOUT = 606 * MiB;     constexpr size_t WOUT_STRIDE = (size_t)D * D;
constexpr size_t WS_H = 638 * MiB, WS_HB = 766 * MiB, WS_PART = 830 * MiB, WS_DTRAW = 832 * MiB, WS_DT = 833 * MiB;
constexpr size_t WS_X = 834 * MiB;
constexpr size_t WS_ACT = WS_X;
constexpr size_t WS_PROJ = WS_X, WS_MIXED = WS_X + 144 * MiB;
constexpr size_t WS_XT = WS_X + 208 * MiB, WS_XTS = WS_X + 240 * MiB, WS_BC = WS_X + 272 * MiB, WS_BCT = WS_X + 280 * MiB, WS_CC = WS_X + 288 * MiB, WS_CS = WS_X + 296 * MiB;
constexpr size_t WS_ST = WS_X + 297 * MiB, WS_SIN = WS_X + 329 * MiB, WS_Y = WS_X + 345 * MiB;
constexpr size_t WS_END = WS_X + 409 * MiB;
static_assert(WS_WGU + 8 * WGU_STRIDE * 2 <= WS_WD && WS_WD + 8 * WD_STRIDE * 2 <= WS_WIN && WS_WIN + 4 * WIN_STRIDE * 2 <= WS_WOUT && WS_WOUT + 4 * WOUT_STRIDE * 2 <= WS_H, "ws map: weights");
static_assert(WS_H + (size_t)M * D * 4 <= WS_HB && WS_HB + (size_t)M * D * 2 <= WS_PART && WS_PART + (size_t)M * 32 * 4 <= WS_DTRAW && WS_DTRAW + (size_t)M * 16 * 4 <= WS_DT && WS_DT + (size_t)M * 16 * 4 <= WS_X, "ws map: state");
static_assert(WS_ACT + (size_t)M * FF * 2 <= WS_END && WS_PROJ + (size_t)M * PROJ_LD * 2 <= WS_MIXED && WS_MIXED + (size_t)M * D * 2 <= WS_XT && WS_Y + (size_t)M * 1024 * 4 <= WS_END, "ws map: overlay");
constexpr int CW_QUAD = 8192;
constexpr int CW_BAR = 4096;

constexpr int RING_OFF = 0, RING_BYTES = 131072;
constexpr int LDSCTL_OFF = RING_BYTES, MISC_OFF = LDSCTL_OFF + 320, RSTD_OFF = LDSCTL_OFF + 1024;
constexpr int LDS_BYTES = 147456;
static_assert(RSTD_OFF + 1024 <= LDS_BYTES, "LDS map");

struct Args { const float* in[21]; float* out; unsigned char* ws; int ph_lo, ph_hi; };
static_assert(sizeof(Args) == 21 * 8 + 8 + 8 + 8, "Args has no padding");

typedef unsigned u32x4 __attribute__((ext_vector_type(4)));
__device__ __forceinline__ unsigned cvtpk_s(float lo, float hi) { return pk2(lo, hi); }
__device__ __forceinline__ bf16x8 scale_frag(v4u a, f32x4 wl, f32x4 wh) {
    v4u r;
    r.x = pk2(__builtin_bit_cast(float, a.x << 16) * wl.x, __builtin_bit_cast(float, a.x & 0xffff0000u) * wl.y); r.y = pk2(__builtin_bit_cast(float, a.y << 16) * wl.z, __builtin_bit_cast(float, a.y & 0xffff0000u) * wl.w);
    r.z = pk2(__builtin_bit_cast(float, a.z << 16) * wh.x, __builtin_bit_cast(float, a.z & 0xffff0000u) * wh.y); r.w = pk2(__builtin_bit_cast(float, a.w << 16) * wh.z, __builtin_bit_cast(float, a.w & 0xffff0000u) * wh.w);
    return __builtin_bit_cast(bf16x8, r);
}
__device__ __forceinline__ float bf2f(bf16 b) { return __builtin_bit_cast(float, (unsigned)b << 16); }
__device__ __forceinline__ float wave_sum(float v, int lane) {
#pragma unroll
    for (int o = 1; o < 64; o <<= 1) v += pg8::shx(v, lane, o);
    return v;
}
__device__ __forceinline__ float softplus_f(float z) { return fmaxf(z, 0.f) + 0.6931471806f * __builtin_amdgcn_logf(1.0f + __builtin_amdgcn_exp2f(-1.4426950409f * fabsf(z))); }
__device__ __forceinline__ float silu_f(float z) { return z * __builtin_amdgcn_rcpf(1.0f + __builtin_amdgcn_exp2f(-1.4426950409f * z)); }

struct TItem { const float* W; const float* gain; bf16* WT; int K, N, drow0, scol, k0; };
__device__ __forceinline__ void titem_load(const TItem& t, int lane, f32x4 (&v)[8], f32x4& g0, f32x4& g1) {
    const int kr = lane >> 3;
#pragma unroll
    for (int i = 0; i < 8; ++i) { const f32x4 x_ = *(const f32x4*)(t.W + (size_t)(t.k0 + 8 * kr + i) * t.N + (t.scol >= 0 ? t.scol : 0));
        v[i] = x_ * ((t.scol >= 0) ? 1.0f : 0.0f); }
    g0 = (f32x4){1.f, 1.f, 1.f, 1.f}; g1 = g0;
    if (t.gain) { g0 = *(const f32x4*)(t.gain + t.k0 + 8 * kr); g1 = *(const f32x4*)(t.gain + t.k0 + 8 * kr + 4); }
}
__device__ __forceinline__ void titem_store(const TItem& t, int lane, const f32x4 (&v)[8], const f32x4& g0, const f32x4& g1) {
    const int kr = lane >> 3, c4 = lane & 7;
#pragma unroll
    for (int e = 0; e < 4; ++e) {
        v4u o; o.x = pk2(v[0][e] * g0.x, v[1][e] * g0.y); o.y = pk2(v[2][e] * g0.z, v[3][e] * g0.w); o.z = pk2(v[4][e] * g1.x, v[5][e] * g1.y); o.w = pk2(v[6][e] * g1.z, v[7][e] * g1.w);
        *(GAS v4u*)(t.WT + (size_t)(t.drow0 + 4 * c4 + e) * t.K + t.k0 + 8 * kr) = o; }
}
constexpr int TI_GU = (D / 64) * (NGU / 32), TI_D = (FF / 64) * (D / 32), TI_IN = (D / 64) * (NIN / 32), TI_OUT = (D / 64) * (D / 32);
constexpr int TI_TOTAL = 8 * (TI_GU + TI_D) + 4 * (TI_IN + TI_OUT);
__device__ __forceinline__ void titem_decode(int it, int lane, const float* const* in, bf16* WGU, bf16* WD, bf16* WIN, bf16* WOUT, TItem& t) {
    const int dl = 4 * (lane & 7);
    int r = it;
    if (r < 8 * TI_GU) {
        const int f = r / TI_GU; r -= f * TI_GU; const int l = f >> 1, second = f & 1;
        const int kb = r / (NGU / 32), db = r % (NGU / 32), tile = db >> 3, within = db & 7;
        t.W = ((within < 4) ? in[second ? 17 : 2] : in[second ? 18 : 3]) + (size_t)l * D * FF; t.gain = in[second ? 16 : 1] + l * D; t.WT = WGU + (size_t)f * WGU_STRIDE;
        t.K = D; t.N = FF; t.drow0 = db * 32; t.scol = tile * 128 + (within & 3) * 32 + dl; t.k0 = kb * 64; return;
    }
    r -= 8 * TI_GU;
    if (r < 8 * TI_D) {
        const int f = r / TI_D; r -= f * TI_D; const int l = f >> 1, second = f & 1;
        const int kb = r / (D / 32), db = r % (D / 32);
        t.W = in[second ? 19 : 4] + (size_t)l * FF * D; t.gain = nullptr; t.WT = WD + (size_t)f * WD_STRIDE; t.K = FF; t.N = D; t.drow0 = db * 32; t.scol = db * 32 + dl; t.k0 = kb * 64; return;
    }
    r -= 8 * TI_D;
    if (r < 4 * TI_IN) {
        const int l = r / TI_IN; r -= l * TI_IN;
        const int kb = r / (NIN / 32), db = r % (NIN / 32), d0 = db * 32;
        int scol;
        if (d0 < 3072) scol = d0 + dl;
        else if (d0 < 4608) scol = d0 + 16 + dl;
        else if (d0 == 4608) scol = (dl < 16) ? 3072 + dl : -1;
        else scol = -1;
        t.W = in[6] + (size_t)l * D * IN_W; t.gain = in[5] + l * D; t.WT = WIN + (size_t)l * WIN_STRIDE; t.K = D; t.N = IN_W; t.drow0 = d0; t.scol = scol; t.k0 = kb * 64; return;
    }
    r -= 4 * TI_IN;
    { const int l = r / TI_OUT; r -= l * TI_OUT; const int kb = r / (D / 32), db = r % (D / 32);
      t.W = in[15] + (size_t)l * D * D; t.gain = nullptr; t.WT = WOUT + (size_t)l * WOUT_STRIDE; t.K = D; t.N = D; t.drow0 = db * 32; t.scol = db * 32 + dl; t.k0 = kb * 64; }
}

__device__ __forceinline__ void mall_touch(const void* p, size_t bytes, int gw, int lane, int NGW) {
    const GAS u32x4* tp = (const GAS u32x4*)p;
    const size_t nv = bytes / 16, st = (size_t)NGW * 64;
    unsigned a = 0u;
    for (size_t o = (size_t)gw * 64 + lane; o < nv; o += 4 * st) {
        u32x4 v[4];
#pragma unroll
        for (int j = 0; j < 4; ++j) { const size_t q = o + j * st; v[j] = tp[q < nv ? q : o]; }
#pragma unroll
        for (int j = 0; j < 4; ++j) a |= v[j].x;
    }
    asm volatile("" :: "v"(a));
}
__device__ __forceinline__ void build_rstd(const float* part, int pm, LAS float* tab, int tid) {
    const int r = tid >> 1, hf = tid & 1;
    const f32x4* p = (const f32x4*)(part + (size_t)(pm * 256 + r) * 32 + hf * 16);
    const f32x4 a = p[0], b = p[1], c = p[2], d = p[3];
    float s = ((a.x + a.y) + (a.z + a.w)) + ((b.x + b.y) + (b.z + b.w)) + ((c.x + c.y) + (c.z + c.w)) + ((d.x + d.y) + (d.z + d.w));
    s += pg8::shx(s, tid & 63, 1);
    if (!hf) tab[r] = rsqrtf(s * (1.0f / D) + RMS_EPS);
    __syncthreads();
}

__global__ void __launch_bounds__(NWAVES * 64, 2) fwd(Args args) {
    extern __shared__ __attribute__((aligned(16))) unsigned char lds[];
    LAS unsigned char* const L = (LAS unsigned char*)lds;
    volatile LAS unsigned* const MISC = (volatile LAS unsigned*)(L + MISC_OFF);
    LAS float* const rstd_tab = (LAS float*)(L + RSTD_OFF);
    const int G = gridDim.x, bx = blockIdx.x, NGW = G * NWAVES, NGT = G * NWAVES * 64;
#define LANE_IDS() WS_BASE(); int tid = threadIdx.x; asm volatile("" : "+v"(tid)); const int lane = tid & 63, wave = __builtin_amdgcn_readfirstlane(tid >> 6); \
    const int gw = bx * NWAVES + wave; const int gt = bx * (NWAVES * 64) + tid; (void)lane; (void)gw; (void)gt
    gu32* const ctl = (gu32*)(args.ws + WS_CTL);
#define WS_BASE() __attribute__((address_space(1))) unsigned char* wsg_ = (__attribute__((address_space(1))) unsigned char*)args.ws; asm volatile("" : "+s"(wsg_)); unsigned char* wsb_ = (unsigned char*)wsg_;     \
    int bx = blockIdx.x; asm volatile("" : "+s"(bx))
#define WSP(T, off) ((T*)(wsb_ + (off)))
#define WGU WSP(bf16, WS_WGU)
#define WD WSP(bf16, WS_WD)
#define WIN WSP(bf16, WS_WIN)
#define WOUT WSP(bf16, WS_WOUT)
#define H WSP(float, WS_H)
#define HB WSP(bf16, WS_HB)
#define PART WSP(float, WS_PART)
#define DTRAW WSP(float, WS_DTRAW)
#define DT WSP(float, WS_DT)
#define ACT WSP(bf16, WS_ACT)
#define PROJ WSP(bf16, WS_PROJ)
#define MIXED WSP(bf16, WS_MIXED)
#define XT WSP(bf16, WS_XT)
#define WTG WSP(float, WS_XTS)
#define BC WSP(bf16, WS_BC)
#define BCT WSP(bf16, WS_BCT)
#define CC WSP(bf16, WS_CC)
#define PWT WSP(bf16, WS_PWT)
#define CS WSP(float, WS_CS)
#define ST WSP(float, WS_ST)
#define SIN WSP(bf16, WS_SIN)

    for (int u = threadIdx.x; u < (LDS_BYTES - LDSCTL_OFF) / 4; u += NWAVES * 64) ((LAS unsigned*)(L + LDSCTL_OFF))[u] = 0u;
    __syncthreads();
    const int lo = args.ph_lo, hi = args.ph_hi;
    XcdBarrier bar; bar.bar = (unsigned*)(ctl + CW_BAR); bar.x = 0; bar.st = nullptr;
    if (hi - lo > 1) bar = xcd_barrier_post((unsigned*)(ctl + CW_BAR), MISC + 8);
    int ps = 0;
#define PH_ON (ps >= lo && ps < hi)
#define PH_END do { if (PH_ON && ps + 1 < hi) xcd_barrier(bar); ++ps; } while (0)
    static_assert(GRID == 256, "chunk barrier: four workgroups per chunk");
#define PH_END_QUAD do { if (PH_ON && ps + 1 < hi) quad_barrier((unsigned*)(ctl + CW_QUAD + (blockIdx.x >> 2) * 64), MISC + 10, (unsigned*)(ctl + CW_BAR)); ++ps; } while (0)

#ifndef NO_PRO
    if (PH_ON) for (int rep_ = 0; rep_ < REP_PRO; ++rep_) { if (rep_) __syncthreads();
        LANE_IDS();
        for (int it = gw; it < TI_TOTAL; it += 2 * NGW) {
            TItem ta, tb; f32x4 va[8], vb[8], ga0, ga1, gb0, gb1;
            const bool two = (it + NGW < TI_TOTAL);
            titem_decode(it, lane, args.in, WGU, WD, WIN, WOUT, ta);
            titem_decode(two ? it + NGW : it, lane, args.in, WGU, WD, WIN, WOUT, tb);
            titem_load(ta, lane, va, ga0, ga1);
            titem_load(tb, lane, vb, gb0, gb1);
            titem_store(ta, lane, va, ga0, ga1);
            if (two) titem_store(tb, lane, vb, gb0, gb1);
        }
        for (int idx = gt; idx < 4 * 4 * 128 * 128; idx += NGT) { const int c = idx & 127, d = (idx >> 7) & 127, li = idx >> 14; PWT[idx] = (bf16)f2bf(args.in[7][((size_t)li * 128 + c) * 128 + d]); }
        for (int m = gw; m < M; m += NGW) {
            const GAS f32x4* xr = (const GAS f32x4*)(args.in[0] + (size_t)m * D) + lane;
            GAS unsigned long long* o8 = (GAS unsigned long long*)(HB + (size_t)m * D) + lane;
            float ss = 0.f;
            f32x4 xv[8];
#pragma unroll
            for (int j = 0; j < 8; ++j) xv[j] = xr[64 * j];
            __builtin_amdgcn_sched_barrier(0);
#pragma unroll
            for (int j = 0; j < 8; ++j) { const f32x4 v = xv[j]; const unsigned p0 = pk2(v.x, v.y), p1 = pk2(v.z, v.w);
                const float r0 = __builtin_bit_cast(float, p0 << 16), r1 = __builtin_bit_cast(float, p0 & 0xffff0000u), r2 = __builtin_bit_cast(float, p1 << 16), r3 = __builtin_bit_cast(float, p1 & 0xffff0000u);
                ss += (r0 * r0 + r1 * r1) + (r2 * r2 + r3 * r3);
                o8[64 * j] = (unsigned long long)p0 | ((unsigned long long)p1 << 32); }
            ss = wave_sum(ss, lane);
            if (lane < 32) PART[(size_t)m * 32 + lane] = (lane == 0) ? ss : 0.f;
        }
    }
#endif
    PH_END;

    for (int i = 0; i < 8; ++i) {
        const int l = i >> 1, second = i & 1;
#ifndef NO_UP
        if (PH_ON) for (int rep_ = 0; rep_ < REP_UP; ++rep_) { if (rep_) __syncthreads();
            LANE_IDS();
            pg8::StaticOrder S; S.init(M, NGU, G, bx); pg8::Unit u0; S.next(0, u0);
            pg8::Gemm g{HB, WGU + (size_t)i * WGU_STRIDE, M, NGU, D};
            pg8::EpiSwiGLU E{ACT, FF, rstd_tab};
            pg8::gemm_phase<pg8::EpiSwiGLU, pg8::StaticOrder, true, true, true>(L + RING_OFF, g, S, E, PART, rstd_tab, 1.0f / D, RMS_EPS);
            { int t_ = threadIdx.x; asm volatile("" : "+v"(t_)); mall_touch(WD + (size_t)i * WD_STRIDE, WD_STRIDE * 2, bx * NWAVES + (t_ >> 6), t_ & 63, NGW); }
        }
#endif
        PH_END;
#ifndef NO_DOWN
        if (PH_ON) {
            WS_BASE();
            pg8::StaticOrder S; S.init(M, D, G, bx);
            pg8::Gemm g{ACT, WD + (size_t)i * WD_STRIDE, M, D, FF};
            pg8::EpiResid E{HB, PART, 0.5f / REP_DOWN};
            pg8::gemm_phase<pg8::EpiResid, pg8::StaticOrder, true, true>(L + RING_OFF, g, S, E);
            { int t_ = threadIdx.x; asm volatile("" : "+v"(t_)); const int gw_ = bx * NWAVES + (t_ >> 6), ln_ = t_ & 63;
              if (!second) mall_touch(WIN + (size_t)l * WIN_STRIDE, (size_t)PROJ_LD * D * 2, gw_, ln_, NGW);
              else if (i < 7) mall_touch(WGU + (size_t)(i + 1) * WGU_STRIDE, WGU_STRIDE * 2, gw_, ln_, NGW); }
        }
#if REP_DOWN == 2
        if (PH_ON) {
            WS_BASE();
            pg8::StaticOrder S; S.init(M, D, G, bx);
            pg8::Gemm g{ACT, WD + (size_t)i * WD_STRIDE, M, D, FF};
            pg8::EpiResid E{HB, PART, 0.5f / REP_DOWN};
            pg8::gemm_phase<pg8::EpiResid, pg8::StaticOrder, true, true>(L + RING_OFF, g, S, E);
        }
#endif
#endif
        PH_END;
        if (second) continue;
#ifndef NO_WIN
        if (PH_ON) for (int rep_ = 0; rep_ < REP_WIN; ++rep_) { if (rep_) __syncthreads();
            LANE_IDS();
            pg8::StaticOrder S; S.init(M, PROJ_LD, G, bx); pg8::Unit u0; S.next(0, u0);
            pg8::Gemm g{HB, WIN + (size_t)l * WIN_STRIDE, M, PROJ_LD, D};
            pg8::EpiProj E{PROJ, DTRAW, rstd_tab};
            pg8::gemm_phase<pg8::EpiProj, pg8::StaticOrder, true, true, true>(L + RING_OFF, g, S, E, PART, rstd_tab, 1.0f / D, RMS_EPS);
            if (bx >= 128) {
                const int u = (bx - 128) * NWAVES + wave, rw0 = u * 16, lr = lane & 15, lq = lane >> 4;
                const bf16* Ap = HB + (size_t)(rw0 + lr) * D + lq * 8;
                const bf16* Bp = WIN + (size_t)l * WIN_STRIDE + (size_t)(PROJ_LD + lr) * D + lq * 8;
                float ssq; { const f32x4* pp = (const f32x4*)(PART + (size_t)(rw0 + lr) * 32 + lq * 8); const f32x4 a = pp[0], b = pp[1]; ssq = ((a.x + a.y) + (a.z + a.w)) + ((b.x + b.y) + (b.z + b.w)); }
                ssq += pg8::shx(ssq, lane, 16); ssq += pg8::shx(ssq, lane, 32);
                const float rsr = rsqrtf(ssq * (1.0f / D) + RMS_EPS);
                f32x4 dacc = {0.f, 0.f, 0.f, 0.f};
#pragma unroll 1
                for (int ks0 = 0; ks0 < D / 32; ks0 += 16) {
                    bf16x8 af[16], bfr[16];
#pragma unroll
                    for (int j = 0; j < 16; ++j) { af[j] = *(const bf16x8*)(Ap + (ks0 + j) * 32); bfr[j] = *(const bf16x8*)(Bp + (ks0 + j) * 32); }
                    __builtin_amdgcn_sched_barrier(0);
#pragma unroll
                    for (int j = 0; j < 16; ++j) dacc = __builtin_amdgcn_mfma_f32_16x16x32_bf16(af[j], bfr[j], dacc, 0, 0, 0);
                }
#pragma unroll
                for (int r = 0; r < 4; ++r) { const int row = lq * 4 + r; DTRAW[(size_t)(rw0 + row) * 16 + lr] = dacc[r] * pg8::shl_(rsr, row); }
            }
        }
#endif
        PH_END;
#ifndef NO_M1
        if (PH_ON) for (int rep_ = 0; rep_ < REP_MIX; ++rep_) { if (rep_) __syncthreads();
            LANE_IDS();
            {
                const int r32 = lane & 31, hi = lane >> 5;
                const float* pscale = args.in[8] + l * 512;
                LAS unsigned char* pst = L + RING_OFF + wave * 12288;
                for (int u = gw; u < (M / 32) * 4; u += NGW) {
                    const int gi = u & 3, r0 = (u >> 2) * 32, w = 2 << gi;
                    const int t = (r0 % SEQ) + r32, cnt = (t + 1 < w) ? t + 1 : w; const float inv = 1.0f / (float)cnt;
                    const int seq0 = r0 - (r0 % SEQ);
                    asm volatile("s_waitcnt lgkmcnt(0)" ::: "memory");
#pragma unroll
                    for (int i = 0; i < 12; ++i) { const int row = 4 * i + (lane >> 4), slot = lane & 15, chunk = slot ^ (row & 15);
                        int grow = r0 - 15 + row; grow = grow < seq0 ? seq0 : grow; grow = grow > r0 + 31 ? r0 + 31 : grow;
                        __builtin_amdgcn_global_load_lds((const unsigned*)(PROJ + (size_t)grow * PROJ_LD + P_POOL + gi * 128 + chunk * 8), (LAS unsigned*)(pst + i * 1024), 16, 0, 0); }
                    const bf16* wt = PWT + ((size_t)(l * 4 + gi) * 128 + r32) * 128 + hi * 8;
                    bf16x8 wa0 = *(const bf16x8*)(wt), wa1 = *(const bf16x8*)(wt + 32 * 128), wa2 = *(const bf16x8*)(wt + 64 * 128), wa3 = *(const bf16x8*)(wt + 96 * 128);
                    f32x16 acc0 = {}, acc1 = {}, acc2 = {}, acc3 = {};
                    asm volatile("s_waitcnt vmcnt(0)" ::: "memory");
#define POOL_RD(rr, c) (*(const LAS v4u*)(pst + (rr) * 256 + ((((c) ^ (rr)) & 15) << 4)))
#define POOL_ADD(j) do { const int rr_ = 15 + r32 - (j); const v4u r_ = POOL_RD(rr_, c_); const bool ok = ((j) < cnt); const unsigned rx = ok ? r_.x : 0u, ry = ok ? r_.y : 0u, rz = ok ? r_.z : 0u, rw = ok ? r_.w : 0u; \
                            sum[0] += __builtin_bit_cast(float, rx << 16); sum[1] += __builtin_bit_cast(float, rx & 0xffff0000u); sum[2] += __builtin_bit_cast(float, ry << 16); sum[3] += __builtin_bit_cast(float, ry & 0xffff0000u); \
                            sum[4] += __builtin_bit_cast(float, rz << 16); sum[5] += __builtin_bit_cast(float, rz & 0xffff0000u); sum[6] += __builtin_bit_cast(float, rw << 16); sum[7] += __builtin_bit_cast(float, rw & 0xffff0000u); } while (0)
#define POOL_KSTEPS(W) _Pragma("unroll 1") for (int ks = 0; ks < 8; ++ks) { \
                        const int c_ = 2 * ks + hi; const int kn_ = (ks < 7) ? ks + 1 : 7; \
                        const bf16x8 wn0 = *(const bf16x8*)(wt + kn_ * 16), wn1 = *(const bf16x8*)(wt + 32 * 128 + kn_ * 16), wn2 = *(const bf16x8*)(wt + 64 * 128 + kn_ * 16), wn3 = *(const bf16x8*)(wt + 96 * 128 + kn_ * 16);     asm volatile("" ::: "memory");     \
                        float sum[8], self[8]; \
                        { const v4u r0_ = POOL_RD(15 + r32, c_); \
                          self[0] = __builtin_bit_cast(float, r0_.x << 16); self[1] = __builtin_bit_cast(float, r0_.x & 0xffff0000u); self[2] = __builtin_bit_cast(float, r0_.y << 16); self[3] = __builtin_bit_cast(float, r0_.y & 0xffff0000u); \
                          self[4] = __builtin_bit_cast(float, r0_.z << 16); self[5] = __builtin_bit_cast(float, r0_.z & 0xffff0000u); self[6] = __builtin_bit_cast(float, r0_.w << 16); self[7] = __builtin_bit_cast(float, r0_.w & 0xffff0000u); } \
                        _Pragma("unroll") for (int e = 0; e < 8; ++e) sum[e] = self[e]; \
                        _Pragma("unroll 4") for (int j = 1; j < W; ++j) POOL_ADD(j); \
                        u32x4 q; q.x = cvtpk_s(sum[0] * inv - self[0], sum[1] * inv - self[1]); q.y = cvtpk_s(sum[2] * inv - self[2], sum[3] * inv - self[3]); \
                        q.z = cvtpk_s(sum[4] * inv - self[4], sum[5] * inv - self[5]); q.w = cvtpk_s(sum[6] * inv - self[6], sum[7] * inv - self[7]); \
                        const bf16x8 bfr = __builtin_bit_cast(bf16x8, q); \
                        acc0 = __builtin_amdgcn_mfma_f32_32x32x16_bf16(wa0, bfr, acc0, 0, 0, 0); acc1 = __builtin_amdgcn_mfma_f32_32x32x16_bf16(wa1, bfr, acc1, 0, 0, 0); \
                        acc2 = __builtin_amdgcn_mfma_f32_32x32x16_bf16(wa2, bfr, acc2, 0, 0, 0); acc3 = __builtin_amdgcn_mfma_f32_32x32x16_bf16(wa3, bfr, acc3, 0, 0, 0); \
                        wa0 = wn0; wa1 = wn1; wa2 = wn2; wa3 = wn3; }
                    if (gi == 0) { POOL_KSTEPS(2) } else if (gi == 1) { POOL_KSTEPS(4) } else if (gi == 2) { POOL_KSTEPS(8) } else { POOL_KSTEPS(16) }
#undef POOL_KSTEPS
#undef POOL_ADD
#undef POOL_RD
                    f32x4 psc[4][4];
                    { const float* sp_ = pscale + gi * 128 + 4 * hi;
#pragma unroll
                      for (int rq = 0; rq < 4; ++rq) { psc[rq][0] = *(const f32x4*)(sp_ + 8 * rq); psc[rq][1] = *(const f32x4*)(sp_ + 32 + 8 * rq); psc[rq][2] = *(const f32x4*)(sp_ + 64 + 8 * rq); psc[rq][3] = *(const f32x4*)(sp_ + 96 + 8 * rq); } }
                    __builtin_amdgcn_sched_barrier(0);
                    typedef unsigned u32x2 __attribute__((ext_vector_type(2)));
                    asm volatile("s_waitcnt lgkmcnt(0)" ::: "memory");
#pragma unroll
                    for (int rq = 0; rq < 4; ++rq) {
                        const f32x4 s0 = psc[rq][0], s1 = psc[rq][1], s2 = psc[rq][2], s3 = psc[rq][3];
                        u32x2 o; LAS unsigned char* tp_ = pst + r32 * 272 + rq * 16 + hi * 8;
                        o.x = pk2(acc0[4 * rq] * s0.x, acc0[4 * rq + 1] * s0.y); o.y = pk2(acc0[4 * rq + 2] * s0.z, acc0[4 * rq + 3] * s0.w); *(LAS u32x2*)(tp_) = o;
                        o.x = pk2(acc1[4 * rq] * s1.x, acc1[4 * rq + 1] * s1.y); o.y = pk2(acc1[4 * rq + 2] * s1.z, acc1[4 * rq + 3] * s1.w); *(LAS u32x2*)(tp_ + 64) = o;
                        o.x = pk2(acc2[4 * rq] * s2.x, acc2[4 * rq + 1] * s2.y); o.y = pk2(acc2[4 * rq + 2] * s2.z, acc2[4 * rq + 3] * s2.w); *(LAS u32x2*)(tp_ + 128) = o;
                        o.x = pk2(acc3[4 * rq] * s3.x, acc3[4 * rq + 1] * s3.y); o.y = pk2(acc3[4 * rq + 2] * s3.z, acc3[4 * rq + 3] * s3.w); *(LAS u32x2*)(tp_ + 192) = o;
                    }
                    bf16* op = MIXED + (size_t)(r0 + (lane >> 4)) * D + gi * 128 + (lane & 15) * 8;
#pragma unroll
                    for (int j = 0; j < 8; ++j) *(u32x4*)(op + (size_t)(4 * j) * D) = *(const LAS u32x4*)(pst + ((lane >> 4) + 4 * j) * 272 + (lane & 15) * 16);
                }
            }
            {
                const int r32 = lane & 31, hi = lane >> 5;
                LAS unsigned char* vst = L + RING_OFF + wave * 12288;
                const int wkey = lane >> 3, wcc = lane & 7, woff = (wcc >> 2) * 4096 + (wcc & 3) * 16 + wkey * 64;
                typedef short v4i16_t __attribute__((ext_vector_type(4)));
                LAS v4i16_t* vrd = (LAS v4i16_t*)(vst + ((lane >> 4) & 1) * 32 + (lane & 3) * 8 + (4 * hi + ((lane & 15) >> 2)) * 64);
                for (int ra_ = 0; ra_ < REP_ATT; ++ra_) for (int u = gw; u < 2 * 8 * 256; u += NGW) {
                    const int qt = u & 255, hh = (u >> 8) & 7, b = u >> 11, q0 = qt * 32;
                    const bf16* Pb = PROJ + (size_t)b * SEQ * PROJ_LD + hh * 64;
                    bf16x8 qf[4];
#pragma unroll
                    for (int d0 = 0; d0 < 4; ++d0) { const v4u raw = *(const v4u*)(Pb + (size_t)(q0 + r32) * PROJ_LD + P_Q + d0 * 16 + hi * 8); v4u sc;
                        sc.x = pk2(__builtin_bit_cast(float, raw.x << 16) * 0.125f, __builtin_bit_cast(float, raw.x & 0xffff0000u) * 0.125f); sc.y = pk2(__builtin_bit_cast(float, raw.y << 16) * 0.125f, __builtin_bit_cast(float, raw.y & 0xffff0000u) * 0.125f);
                        sc.z = pk2(__builtin_bit_cast(float, raw.z << 16) * 0.125f, __builtin_bit_cast(float, raw.z & 0xffff0000u) * 0.125f); sc.w = pk2(__builtin_bit_cast(float, raw.w << 16) * 0.125f, __builtin_bit_cast(float, raw.w & 0xffff0000u) * 0.125f);
                        qf[d0] = __builtin_bit_cast(bf16x8, sc); }
                    float carry = 0.f; f32x16 o0 = {}, o1 = {};
                    bf16x8 kn[8];
                    v4u vn[8];
#define ATT_LOAD(kt_) do { const bf16* Kb_ = Pb + (size_t)((kt_) * 64 + r32) * PROJ_LD + P_K + hi * 8; \
        _Pragma("unroll") for (int d0 = 0; d0 < 4; ++d0) { kn[2 * d0] = *(const bf16x8*)(Kb_ + d0 * 16); kn[2 * d0 + 1] = *(const bf16x8*)(Kb_ + (size_t)32 * PROJ_LD + d0 * 16); } \
        _Pragma("unroll") for (int i_ = 0; i_ < 8; ++i_) vn[i_] = *(const v4u*)(Pb + (size_t)((kt_) * 64 + wkey + 8 * i_) * PROJ_LD + P_V + wcc * 8); } while (0)
                    ATT_LOAD(q0 >> 6);
                    for (int kt = q0 >> 6; kt >= 0; --kt) {
                        bf16x8 kc[8]; v4u vc[8];
#pragma unroll
                        for (int i = 0; i < 8; ++i) { kc[i] = kn[i]; vc[i] = vn[i]; }
                        ATT_LOAD(kt > 0 ? kt - 1 : 0);
                        asm volatile("" ::: "memory");
                        f32x16 p0 = {}, p1 = {};
#pragma unroll
                        for (int d0 = 0; d0 < 4; ++d0) { p0 = __builtin_amdgcn_mfma_f32_32x32x16_bf16(kc[2 * d0], qf[d0], p0, 0, 0, 0); p1 = __builtin_amdgcn_mfma_f32_32x32x16_bf16(kc[2 * d0 + 1], qf[d0], p1, 0, 0, 0); }
#pragma unroll
                        for (int i = 0; i < 8; ++i) *(LAS v4u*)(vst + woff + (i >> 1) * 1024 + (i & 1) * 512) = vc[i];
                        const int lim = q0 + r32 - kt * 64;
                        float sp0[16], sp1[16];
#pragma unroll
                        for (int r = 0; r < 16; ++r) { const int kl = (r & 3) + 8 * (r >> 2) + 4 * hi;
                            const float z0 = p0[r], z1 = p1[r];
                            const float s0_ = fmaxf(z0, 0.f) + 0.6931471806f * __builtin_amdgcn_logf(1.0f + __builtin_amdgcn_exp2f(-1.4426950409f * fabsf(z0)));
                            const float s1_ = fmaxf(z1, 0.f) + 0.6931471806f * __builtin_amdgcn_logf(1.0f + __builtin_amdgcn_exp2f(-1.4426950409f * fabsf(z1)));
                            sp0[r] = (kl < lim) ? s0_ : 0.f; sp1[r] = (kl + 32 < lim) ? s1_ : 0.f; }
                        float PS[9], PSp[9];
                        PS[8] = 0.f; PSp[8] = 0.f;
#pragma unroll
                        for (int idx = 7; idx >= 0; --idx) { const int rq = idx & 3; const float gsum = (idx < 4) ? (sp0[4 * rq] + sp0[4 * rq + 1]) + (sp0[4 * rq + 2] + sp0[4 * rq + 3]) : (sp1[4 * rq] + sp1[4 * rq + 1]) + (sp1[4 * rq + 2] + sp1[4 * rq + 3]);
                            PS[idx] = PS[idx + 1] + gsum; }
#pragma unroll
                        for (int idx = 0; idx < 8; ++idx) PSp[idx] = pg8::shx(PS[idx], lane, 32);
#pragma unroll
                        for (int idx = 0; idx < 8; ++idx) { const int rq = idx & 3;
                            float run = carry + PS[idx + 1] + (hi ? PSp[idx + 1] : PSp[idx]);
#pragma unroll
                            for (int e = 3; e >= 0; --e) { const int r = 4 * rq + e, kl = e + 8 * rq + 4 * hi + ((idx < 4) ? 0 : 32);
                                if (idx < 4) { run += sp0[r]; const float w = __builtin_amdgcn_exp2f(1.4426950409f * (p0[r] - run)); p0[r] = (kl < lim) ? w : 0.f; }
                                else         { run += sp1[r]; const float w = __builtin_amdgcn_exp2f(1.4426950409f * (p1[r] - run)); p1[r] = (kl < lim) ? w : 0.f; } } }
                        carry += PS[0] + PSp[0];
                        u32x4 a0, a1, a2, a3;
                        a0.x = cvtpk_s(p0[0], p0[1]); a0.y = cvtpk_s(p0[2], p0[3]); a0.z = cvtpk_s(p0[4], p0[5]); a0.w = cvtpk_s(p0[6], p0[7]);
                        a1.x = cvtpk_s(p0[8], p0[9]); a1.y = cvtpk_s(p0[10], p0[11]); a1.z = cvtpk_s(p0[12], p0[13]); a1.w = cvtpk_s(p0[14], p0[15]);
                        a2.x = cvtpk_s(p1[0], p1[1]); a2.y = cvtpk_s(p1[2], p1[3]); a2.z = cvtpk_s(p1[4], p1[5]); a2.w = cvtpk_s(p1[6], p1[7]);
                        a3.x = cvtpk_s(p1[8], p1[9]); a3.y = cvtpk_s(p1[10], p1[11]); a3.z = cvtpk_s(p1[12], p1[13]); a3.w = cvtpk_s(p1[14], p1[15]);
                        const bf16x8 pa[4] = {__builtin_bit_cast(bf16x8, a0), __builtin_bit_cast(bf16x8, a1), __builtin_bit_cast(bf16x8, a2), __builtin_bit_cast(bf16x8, a3)};
#pragma unroll
                        for (int ks = 0; ks < 4; ++ks) {
                            const v4i16_t l0 = __builtin_amdgcn_ds_read_tr16_b64_v4i16(vrd + (ks * 1024) / 8), h0 = __builtin_amdgcn_ds_read_tr16_b64_v4i16(vrd + (ks * 1024 + 512) / 8);
                            const v4i16_t l1 = __builtin_amdgcn_ds_read_tr16_b64_v4i16(vrd + (4096 + ks * 1024) / 8), h1 = __builtin_amdgcn_ds_read_tr16_b64_v4i16(vrd + (4096 + ks * 1024 + 512) / 8);
                            const bf16x8 v0 = (bf16x8){l0[0], l0[1], l0[2], l0[3], h0[0], h0[1], h0[2], h0[3]}, v1 = (bf16x8){l1[0], l1[1], l1[2], l1[3], h1[0], h1[1], h1[2], h1[3]};
                            o0 = __builtin_amdgcn_mfma_f32_32x32x16_bf16(v0, pa[ks], o0, 0, 0, 0); o1 = __builtin_amdgcn_mfma_f32_32x32x16_bf16(v1, pa[ks], o1, 0, 0, 0);
                        }
                        if (__all(carry >= 88.f)) break;
                    }
#undef ATT_LOAD
                    typedef unsigned u32x2a __attribute__((ext_vector_type(2)));
#pragma unroll
                    for (int rq = 0; rq < 4; ++rq) { u32x2a w0, w1;
                        w0.x = pk2(o0[4 * rq], o0[4 * rq + 1]); w0.y = pk2(o0[4 * rq + 2], o0[4 * rq + 3]); w1.x = pk2(o1[4 * rq], o1[4 * rq + 1]); w1.y = pk2(o1[4 * rq + 2], o1[4 * rq + 3]);
                        *(LAS u32x2a*)(vst + r32 * 144 + rq * 16 + hi * 8) = w0; *(LAS u32x2a*)(vst + r32 * 144 + 64 + rq * 16 + hi * 8) = w1; }
                    bf16* Ob = MIXED + ((size_t)b * SEQ + q0 + (lane >> 3)) * D + 1536 + hh * 64 + (lane & 7) * 8;
#pragma unroll
                    for (int j = 0; j < 4; ++j) *(u32x4*)(Ob + (size_t)(8 * j) * D) = *(const LAS u32x4*)(vst + ((lane >> 3) + 8 * j) * 144 + (lane & 7) * 16);
                    asm volatile("s_waitcnt lgkmcnt(0)" ::: "memory");
                }
            }
            asm volatile("s_waitcnt lgkmcnt(0)\n\ts_barrier" ::: "memory");
            {
                const float* cw = args.in[9] + (size_t)l * 4 * 1536; const float* cb = args.in[10] + l * 1536; const float* dtb = args.in[11] + l * 16; const float* alog = args.in[12] + l * 16;
                { const int u = bx;
                    const int qt = u & 3, bc = u >> 2, r0 = bc * 256;
                    LAS unsigned char* img0 = L + RING_OFF + 16384;
                    const int tpos0 = r0 % SEQ;
#define S0_DMA(q_) do { LAS unsigned char* ib_ = img0 + ((q_) & 1) * 52224; \
        for (int i_ = wave; i_ < 51; i_ += NWAVES) { const int o_ = i_ * 1024 + lane * 16; int row_ = o_ / 768; const int col_ = o_ - row_ * 768; row_ = row_ > 66 ? 66 : row_; \
            int rel_ = 64 * (q_) - 3 + row_; rel_ = (tpos0 + rel_ < 0) ? 0 : rel_;                   \
            __builtin_amdgcn_global_load_lds((const unsigned*)(PROJ + (size_t)(r0 + rel_) * PROJ_LD + P_XBC + qt * 384 + (col_ >> 1)), (LAS unsigned*)(ib_ + i_ * 1024), 16, 0, 0); } } while (0)
                    S0_DMA(0);
                    if (qt == 0) { const int h = tid >> 5, seg = tid & 31; const float A = -__expf(alog[h]), bias = dtb[h];
                      float dtv[8], cs[8]; float run = 0.f;
#pragma unroll
                      for (int k = 0; k < 8; ++k) dtv[k] = DTRAW[(size_t)(r0 + seg * 8 + k) * 16 + h];
                      __builtin_amdgcn_sched_barrier(0);
#pragma unroll
                      for (int k = 0; k < 8; ++k) { dtv[k] = softplus_f(dtv[k] + bias); run += A * dtv[k]; cs[k] = run; }
                      float incl = run;
#pragma unroll
                      for (int d = 1; d < 32; d <<= 1) { const float v = pg8::shl_(incl, (seg >= d) ? lane - d : lane); if (seg >= d) incl += v; }
                      const float excl = incl - run, total = pg8::shl_(incl, lane | 31);
#pragma unroll
                      for (int k = 0; k < 8; ++k) { const float c_ = excl + cs[k]; WTG[(size_t)(bc * 16 + h) * 256 + seg * 8 + k] = dtv[k] * __expf(total - c_); CS[(size_t)(r0 + seg * 8 + k) * 16 + h] = c_; DT[(size_t)(r0 + seg * 8 + k) * 16 + h] = dtv[k]; } }
                    const int rsq = tid & 7, cgl = tid >> 3;
                    const int cg = qt * 48 + cgl, ch0 = cg * 8;
                    float cwr[4][8], cbr[8];
#pragma unroll
                    for (int e = 0; e < 8; ++e) { cwr[0][e] = cw[0 * 1536 + ch0 + e]; cwr[1][e] = cw[1 * 1536 + ch0 + e]; cwr[2][e] = cw[2 * 1536 + ch0 + e]; cwr[3][e] = cw[3 * 1536 + ch0 + e]; cbr[e] = cb[ch0 + e]; }
                    asm volatile("s_waitcnt vmcnt(0)" ::: "memory");
                    __syncthreads();
                    for (int q = 0; q < 4; ++q) {
                        if (q < 3) S0_DMA(q + 1);
                        if (tid < 384) {
                        const int s0 = 64 * q + rsq * 8;
                        const int t0 = tpos0 + s0;
                        const LAS unsigned char* ip = img0 + (q & 1) * 52224 + (rsq * 8) * 768 + cgl * 16;
                        float xin[11][8];
#pragma unroll
                        for (int k = 0; k < 11; ++k) { const bool ok = (t0 - 3 + k >= 0); v4u raw = *(const LAS v4u*)(ip + k * 768);
                            raw.x = ok ? raw.x : 0u; raw.y = ok ? raw.y : 0u; raw.z = ok ? raw.z : 0u; raw.w = ok ? raw.w : 0u;
                            xin[k][0] = __builtin_bit_cast(float, raw.x << 16); xin[k][1] = __builtin_bit_cast(float, raw.x & 0xffff0000u); xin[k][2] = __builtin_bit_cast(float, raw.y << 16); xin[k][3] = __builtin_bit_cast(float, raw.y & 0xffff0000u);
                            xin[k][4] = __builtin_bit_cast(float, raw.z << 16); xin[k][5] = __builtin_bit_cast(float, raw.z & 0xffff0000u); xin[k][6] = __builtin_bit_cast(float, raw.w << 16); xin[k][7] = __builtin_bit_cast(float, raw.w & 0xffff0000u); }
                        float o[8][8];
#pragma unroll
                        for (int e = 0; e < 8; ++e) { const float w0 = cwr[0][e], w1 = cwr[1][e], w2 = cwr[2][e], w3 = cwr[3][e], bb = cbr[e];
#pragma unroll
                            for (int j = 0; j < 8; ++j) o[j][e] = silu_f(bb + w0 * xin[j][e] + w1 * xin[j + 1][e] + w2 * xin[j + 2][e] + w3 * xin[j + 3][e]); }
#define S0_SWAP(a_) do { const bool odd_ = rsq & 1; const unsigned s0_ = odd_ ? a_.x : a_.z, s1_ = odd_ ? a_.y : a_.w; \
        const unsigned r0_ = (unsigned)__builtin_amdgcn_update_dpp(0, (int)s0_, 0xB1, 0xF, 0xF, true), r1_ = (unsigned)__builtin_amdgcn_update_dpp(0, (int)s1_, 0xB1, 0xF, 0xF, true); \
        a_ = odd_ ? (v4u){r0_, r1_, a_.z, a_.w} : (v4u){a_.x, a_.y, r0_, r1_}; } while (0)
                        if (cg < 128) {
                            const int h = cg >> 3, p0 = (cg & 7) * 8;
                            const size_t base = (size_t)(bc * 16 + h) * 16384 + (size_t)((((2 * q + (rsq >> 2)) * 4 + (p0 >> 5) * 2 + ((rsq >> 1) & 1)) * 64 + (rsq & 1) * 32 + (p0 & 31)) * 8);
#pragma unroll
                            for (int e = 0; e < 8; ++e) {
                                v4u a; a.x = pk2(o[0][e], o[1][e]); a.y = pk2(o[2][e], o[3][e]); a.z = pk2(o[4][e], o[5][e]); a.w = pk2(o[6][e], o[7][e]);
                                S0_SWAP(a);
                                *(v4u*)(XT + base + (size_t)e * 8) = a; }
                        } else if (cg < 160) {
                            const int gi = (cg - 128) >> 4, n0 = ((cg - 128) & 15) * 8;
#pragma unroll
                            for (int j = 0; j < 8; ++j) { v4u a; a.x = pk2(o[j][0], o[j][1]); a.y = pk2(o[j][2], o[j][3]); a.z = pk2(o[j][4], o[j][5]); a.w = pk2(o[j][6], o[j][7]);
                                *(v4u*)(BC + (size_t)(r0 + s0 + j) * 256 + gi * 128 + n0) = a; }
                            const size_t base = (size_t)(bc * 2 + gi) * 32768 + (size_t)(((((4 * q + (rsq >> 1)) * 4 + (n0 >> 5)) * 2 + (rsq & 1)) * 32 + (n0 & 31)) * 8);
#pragma unroll
                            for (int e = 0; e < 8; ++e) { v4u a; a.x = pk2(o[0][e], o[1][e]); a.y = pk2(o[2][e], o[3][e]); a.z = pk2(o[4][e], o[5][e]); a.w = pk2(o[6][e], o[7][e]);
                                S0_SWAP(a);
                                *(v4u*)(BCT + base + (size_t)e * 8) = a; }
                        } else {
                            const int gi = (cg - 160) >> 4, n0 = ((cg - 160) & 15) * 8;
#pragma unroll
                            for (int j = 0; j < 8; ++j) { v4u a; a.x = pk2(o[j][0], o[j][1]); a.y = pk2(o[j][2], o[j][3]); a.z = pk2(o[j][4], o[j][5]); a.w = pk2(o[j][6], o[j][7]);
                                *(v4u*)(CC + (size_t)(r0 + s0 + j) * 256 + gi * 128 + n0) = a; }
                        }
                        }
                        if (q < 3) {
                            const int nst = __builtin_amdgcn_readfirstlane((tid < 384) ? ((cg >= 128 && cg < 160) ? 16 : 8) : 0);
                            if (nst == 16) asm volatile("s_waitcnt vmcnt(16)" ::: "memory"); else if (nst == 8) asm volatile("s_waitcnt vmcnt(8)" ::: "memory"); else asm volatile("s_waitcnt vmcnt(0)" ::: "memory");
                        }
                        __syncthreads();
                    }
#undef S0_DMA
#undef S0_SWAP
                }
            }
        }
        PH_END_QUAD;
#endif
#ifndef NO_M2
        if (PH_ON) for (int rep_ = 0; rep_ < REP_S1; ++rep_) { if (rep_) __syncthreads();
            LANE_IDS();
            const int r32 = lane & 31, hi = lane >> 5;
            for (int u = gw; u < 2 * 32 * 16 * 2; u += NGW) {
                const int nh = u & 1, h = (u >> 1) & 15, bc = u >> 5, g = h >> 3;
                const bf16* Ab = XT + (size_t)(bc * 16 + h) * 16384 + lane * 8;
                const float* Wb = WTG + (size_t)(bc * 16 + h) * 256 + hi * 4;
                const bf16* Bb = BCT + (size_t)(bc * 2 + g) * 32768 + (size_t)(nh * 2 * 64 * 8) + lane * 8;
                f32x16 acc00 = {}, acc01 = {}, acc10 = {}, acc11 = {};
#pragma unroll 1
                for (int kb = 0; kb < 16; kb += 4) {
                    f32x4 wl[4], wh[4]; v4u ar0[4], ar1[4]; bf16x8 b0[4], b1[4];
#pragma unroll
                    for (int j = 0; j < 4; ++j) { const int ks = kb + j;
                        wl[j] = *(const f32x4*)(Wb + ks * 16); wh[j] = *(const f32x4*)(Wb + ks * 16 + 8);
                        const bf16* ap_ = Ab + (((ks >> 1) * 4 + (ks & 1)) * 64) * 8;
                        ar0[j] = *(const v4u*)(ap_); ar1[j] = *(const v4u*)(ap_ + 2 * 64 * 8);
                        b0[j] = *(const bf16x8*)(Bb + (ks * 4) * 64 * 8); b1[j] = *(const bf16x8*)(Bb + (ks * 4 + 1) * 64 * 8); }
                    __builtin_amdgcn_sched_barrier(0);
#pragma unroll
                    for (int j = 0; j < 4; ++j) {
                        const bf16x8 a0 = scale_frag(ar0[j], wl[j], wh[j]), a1 = scale_frag(ar1[j], wl[j], wh[j]);
                        acc00 = __builtin_amdgcn_mfma_f32_32x32x16_bf16(a0, b0[j], acc00, 0, 0, 0); acc01 = __builtin_amdgcn_mfma_f32_32x32x16_bf16(a0, b1[j], acc01, 0, 0, 0);
                        acc10 = __builtin_amdgcn_mfma_f32_32x32x16_bf16(a1, b0[j], acc10, 0, 0, 0); acc11 = __builtin_amdgcn_mfma_f32_32x32x16_bf16(a1, b1[j], acc11, 0, 0, 0);
                    }
                }
                float* Sb = ST + (size_t)(bc * 16 + h) * 8192 + nh * 64 + r32;
#pragma unroll
                for (int r = 0; r < 16; ++r) { const int p = (r & 3) + 8 * (r >> 2) + 4 * hi;
                    Sb[(size_t)p * 128] = acc00[r]; Sb[(size_t)p * 128 + 32] = acc01[r]; Sb[(size_t)(p + 32) * 128] = acc10[r]; Sb[(size_t)(p + 32) * 128 + 32] = acc11[r]; }
            }
        }
        PH_END;
        if (PH_ON) for (int rep_ = 0; rep_ < REP_S2; ++rep_) { if (rep_) __syncthreads();
            LANE_IDS();
            for (int id = gt; id < 2 * 16 * 64 * 64; id += NGT) {
                const int n = ((id >> 6) & 7) * 16 + ((id >> 5) & 1) * 8 + (id & 3) * 2, p = ((id >> 9) & 7) * 8 + ((id >> 2) & 7), h = (id >> 12) & 15, b = id >> 16;
                const int so = ((((p >> 5) * 8 + (n >> 4)) * 2 + ((n >> 3) & 1)) * 32 + (p & 31)) * 8 + (n & 7);
                float c0 = 0.f, c1 = 0.f;
#pragma unroll 1
                for (int cb = 0; cb < 32; cb += 16) {
                    float2 st[16]; float dl[16];
#pragma unroll
                    for (int j = 0; j < 16; ++j) { const int c = cb + j; st[j] = *(const float2*)(ST + (size_t)((b * 32 + c) * 16 + h) * 8192 + p * 128 + n); dl[j] = CS[(size_t)(b * SEQ + c * 256 + 255) * 16 + h]; }
                    __builtin_amdgcn_sched_barrier(0);
#pragma unroll
                    for (int j = 0; j < 16; ++j) { const int c = cb + j;
                        *(unsigned*)(SIN + (size_t)((b * 32 + c) * 16 + h) * 8192 + so) = pk2(c0, c1);
                        const float dec = __expf(dl[j]);
                        c0 = c0 * dec + st[j].x; c1 = c1 * dec + st[j].y; }
                }
            }
        }
        PH_END;
        if (PH_ON) for (int rep_ = 0; rep_ < REP_S3; ++rep_) { if (rep_) __syncthreads();
            LANE_IDS();
            const int r32 = lane & 31, hi = lane >> 5;
            LAS unsigned char* CBl = L + RING_OFF;
            LAS unsigned char* Cl = L + RING_OFF + 73728;
            LAS float* wcs = (LAS float*)(L + RING_OFF + 108544) + wave * 512;
            LAS float* ssb = (LAS float*)(L + RING_OFF + 124928);
            unsigned char* hpark = WSP(unsigned char, WS_Y) + ((size_t)bx * 8 + wave) * 8192;
            LAS float* ssb2 = (LAS float*)(L + RSTD_OFF + 8192);
            LAS float* wG = (LAS float*)(L + RSTD_OFF) + wave * 256;
            static_assert(RSTD_OFF + 8 * 1024 + 4096 <= LDS_BYTES && 108544 + 16384 <= 124928 && 124928 + 4096 <= RING_BYTES && 73728 + 128 * 272 <= 108544 && 18 * 4096 <= 73728 && 256 * 272 <= 73728, "S3 LDS map");
            const float* ng = args.in[14] + l * 1024;
            typedef unsigned u32x2 __attribute__((ext_vector_type(2)));
            if (bx < 256) { const int u = bx;
                const int parity = u & 1, g = (u >> 1) & 1, bc = u >> 2, h = g * 8 + wave, r0 = bc * 256;
                const float Dk = args.in[13][l * 16 + h];
                const int jt0 = parity, jt1 = 3 - parity, jt2 = 4 + parity, jt3 = 7 - parity;
                const int of1 = jt0 + 1, of2 = of1 + jt1 + 1, of3 = of2 + jt2 + 1;
                {
                    const bf16* bsrc = BC + (size_t)(r0 + (tid >> 4)) * 256 + g * 128 + (tid & 15) * 8;
                    LAS unsigned char* bdst = CBl + (tid >> 4) * 272 + (tid & 15) * 16;
                    v4u tb[8], tc[4]; float c_[4], d_[4], ce_[4];
#pragma unroll
                    for (int i = 0; i < 8; ++i) tb[i] = *(const v4u*)(bsrc + (size_t)i * 32 * 256);
#pragma unroll
                    for (int i = 0; i < 4; ++i) { const int jt_ = 4 * (i >> 1) + ((i & 1) ? 3 - parity : parity);
                        tc[i] = *(const v4u*)(CC + (size_t)(r0 + 32 * jt_ + (tid >> 4)) * 256 + g * 128 + (tid & 15) * 8); }
#pragma unroll
                    for (int i = 0; i < 4; ++i) { const int s_ = lane + 64 * i; c_[i] = CS[(size_t)(r0 + s_) * 16 + h]; d_[i] = DT[(size_t)(r0 + s_) * 16 + h]; ce_[i] = CS[(size_t)(r0 + (s_ | 31)) * 16 + h]; }
#pragma unroll
                    for (int i = 0; i < 8; ++i) *(LAS v4u*)(bdst + i * 32 * 272) = tb[i];
#pragma unroll
                    for (int i = 0; i < 4; ++i) *(LAS v4u*)(Cl + (32 * i + (tid >> 4)) * 272 + (tid & 15) * 16) = tc[i];
#pragma unroll
                    for (int i = 0; i < 4; ++i) { const int s_ = lane + 64 * i; wcs[s_] = c_[i]; wcs[256 + s_] = d_[i]; wG[s_] = __expf(ce_[i] - c_[i]) * d_[i]; }
                }
                const bf16* XTh = XT + (size_t)(bc * 16 + h) * 16384 + lane * 8;
                const bf16* SINh = SIN + (size_t)(bc * 16 + h) * 8192 + lane * 8;
                bf16x8 sa[8];
#define SLOAD(base_) do { _Pragma("unroll") for (int ks = 0; ks < 8; ++ks) sa[ks] = *(const GAS bf16x8*)((base_) + ks * 512); } while (0)
                SLOAD((const GAS bf16*)SINh);
                __syncthreads();
                {
                    f32x16 cb0 = {}, cb1 = {}, cb2 = {};
#define S3_CB(dst, t_) do { const int t__ = (t_); if (t__ < 18) { const int k__ = (t__ >= of1) + (t__ >= of2) + (t__ >= of3); const int i__ = t__ - (k__ == 0 ? 0 : k__ == 1 ? of1 : k__ == 2 ? of2 : of3); \
        const LAS unsigned char* bp_ = CBl + (32 * i__ + r32) * 272 + hi * 16; const LAS unsigned char* cp_ = Cl + (32 * k__ + r32) * 272 + hi * 16; \
        _Pragma("unroll") for (int ks = 0; ks < 8; ++ks) dst = __builtin_amdgcn_mfma_f32_32x32x16_bf16(*(const LAS bf16x8*)(bp_ + ks * 32), *(const LAS bf16x8*)(cp_ + ks * 32), dst, 0, 0, 0); } } while (0)
                    S3_CB(cb0, wave); S3_CB(cb1, wave + 8); S3_CB(cb2, wave + 16);
#undef S3_CB
                    __syncthreads();
#define S3_CBW(src, t_) do { const int t__ = (t_); if (t__ < 18) { LAS unsigned char* wp_ = CBl + t__ * 4096 + lane * 16; \
        *(LAS f32x4*)(wp_) = (f32x4){src[0], src[1], src[2], src[3]}; *(LAS f32x4*)(wp_ + 1024) = (f32x4){src[4], src[5], src[6], src[7]}; \
        *(LAS f32x4*)(wp_ + 2048) = (f32x4){src[8], src[9], src[10], src[11]}; *(LAS f32x4*)(wp_ + 3072) = (f32x4){src[12], src[13], src[14], src[15]}; } } while (0)
                    S3_CBW(cb0, wave); S3_CBW(cb1, wave + 8); S3_CBW(cb2, wave + 16);
#undef S3_CBW
                }
#define XLOAD(dst, i_, pt_) do { const GAS bf16* xb_ = XTp + (i_) * 2048; dst[0] = *(const GAS u32x4*)(xb_); dst[1] = *(const GAS u32x4*)(xb_ + 512); } while (0)
#define ZLOAD(jt_, pt_) do { const bf16* zp = PROJ + ((size_t)r0 + 32 * (jt_) + r32) * PROJ_LD + P_Z + h * 64 + (pt_) * 32 + 4 * hi; \
        _Pragma("unroll") for (int rq = 0; rq < 4; ++rq) zr[rq] = *(const u32x2*)(zp + 8 * rq); } while (0)
#pragma unroll
                for (int pt = 0; pt < 2; ++pt) {
                    int lane_ = lane; asm volatile("" : "+v"(lane_));
                    const int r32 = lane_ & 31, hi = lane_ >> 5, lane = lane_;
                    u32x4 xc[2], xn[2];
                    const GAS bf16* XTp = (const GAS bf16*)(XTh + pt * 1024); asm volatile("" : "+v"(XTp));
                    const GAS bf16* SINp = (const GAS bf16*)(SINh + 4096); asm volatile("" : "+v"(SINp));
                    XLOAD(xc, 0, pt);
                    asm volatile("" ::: "memory");
                    f32x16 o[4];
#pragma unroll
                    for (int k = 0; k < 4; ++k) {
                        const LAS unsigned char* cfp = Cl + (k * 32 + r32) * 272 + hi * 16;
                        f32x16 a0 = {};
#pragma unroll
                        for (int ks = 0; ks < 8; ++ks) a0 = __builtin_amdgcn_mfma_f32_32x32x16_bf16(sa[ks], *(const LAS bf16x8*)(cfp + ks * 32), a0, 0, 0, 0);
                        const float e = __expf(wcs[32 * ((k == 0) ? jt0 : (k == 1) ? jt1 : (k == 2) ? jt2 : jt3) + r32]);
#pragma unroll
                        for (int r = 0; r < 16; ++r) a0[r] *= e;
                        o[k] = a0;
                    }
                    if (pt == 0) __syncthreads();
                    u32x2 zr[4];
#pragma unroll
                    for (int i = 0; i < 8; ++i) {
                        const int kd = i >> 1, jtd = (kd == 0) ? jt0 : (kd == 1) ? jt1 : (kd == 2) ? jt2 : jt3;
                        if (i < 7 || jt3 == 7) {
                            if ((i & 1) == 0) { ZLOAD(jtd, pt); }
                            if (i < 7) { XLOAD(xn, i + 1, pt); }
                            if (i == 6 && pt == 0) { SLOAD(SINp); }
                            asm volatile("" ::: "memory");
                            const float cse = wcs[32 * i + 31];
#pragma unroll
                            for (int k = 0; k < 4; ++k) if (k >= kd) {
                                const bool dk_ = (k == kd);
                                const int jt = (k == 0) ? jt0 : (k == 1) ? jt1 : (k == 2) ? jt2 : jt3, ofk = (k == 0) ? 0 : (k == 1) ? of1 : (k == 2) ? of2 : of3;
                                if (!dk_ || i <= jt) {
                                    f32x16 mt; const float csl_ = wcs[32 * jt + r32];
                                    { const LAS unsigned char* rp_ = CBl + (ofk + i) * 4096 + lane * 16;
                                      const f32x4 m0 = *(const LAS f32x4*)(rp_), m1 = *(const LAS f32x4*)(rp_ + 1024), m2 = *(const LAS f32x4*)(rp_ + 2048), m3 = *(const LAS f32x4*)(rp_ + 3072);
                                      mt[0] = m0.x; mt[1] = m0.y; mt[2] = m0.z; mt[3] = m0.w; mt[4] = m1.x; mt[5] = m1.y; mt[6] = m1.z; mt[7] = m1.w;
                                      mt[8] = m2.x; mt[9] = m2.y; mt[10] = m2.z; mt[11] = m2.w; mt[12] = m3.x; mt[13] = m3.y; mt[14] = m3.z; mt[15] = m3.w; }
                                    if (!dk_ || i < jt) {
                                        const float El = __expf(csl_ - cse);
#pragma unroll
                                        for (int r = 0; r < 16; ++r) mt[r] *= El * wG[32 * i + (r & 3) + 8 * (r >> 2) + 4 * hi];
                                    } else {
                                        const int l_loc = 32 * jt + r32;
#pragma unroll
                                        for (int r = 0; r < 16; ++r) { const int s_loc = 32 * i + (r & 3) + 8 * (r >> 2) + 4 * hi;
                                            const float f = __expf(csl_ - wcs[s_loc]) * wcs[256 + s_loc];
                                            float v = mt[r] * f;
                                            v = (s_loc > l_loc) ? 0.f : v; v += (s_loc == l_loc) ? Dk : 0.f;
                                            mt[r] = v; }
                                    }
                                    u32x4 q0, q1;
                                    q0.x = cvtpk_s(mt[0], mt[1]); q0.y = cvtpk_s(mt[2], mt[3]); q0.z = cvtpk_s(mt[4], mt[5]); q0.w = cvtpk_s(mt[6], mt[7]);
                                    q1.x = cvtpk_s(mt[8], mt[9]); q1.y = cvtpk_s(mt[10], mt[11]); q1.z = cvtpk_s(mt[12], mt[13]); q1.w = cvtpk_s(mt[14], mt[15]);
                                    o[k] = __builtin_amdgcn_mfma_f32_32x32x16_bf16(__builtin_bit_cast(bf16x8, xc[0]), __builtin_bit_cast(bf16x8, q0), o[k], 0, 0, 0);
                                    o[k] = __builtin_amdgcn_mfma_f32_32x32x16_bf16(__builtin_bit_cast(bf16x8, xc[1]), __builtin_bit_cast(bf16x8, q1), o[k], 0, 0, 0);
                                }
                            }
                            if (i == jtd) {
                                float ss = 0.f;
#pragma unroll
                                for (int rq = 0; rq < 4; ++rq) {
                                    const u32x2 z0 = zr[rq];
                                    const float za[4] = {__builtin_bit_cast(float, z0.x << 16), __builtin_bit_cast(float, z0.x & 0xffff0000u), __builtin_bit_cast(float, z0.y << 16), __builtin_bit_cast(float, z0.y & 0xffff0000u)};
#pragma unroll
                                    for (int e = 0; e < 4; ++e) { o[kd][4 * rq + e] *= silu_f(za[e]); ss += o[kd][4 * rq + e] * o[kd][4 * rq + e]; }
                                }
                                ss += pg8::shx(ss, lane, 32);
                                if (hi == 0) (pt == 0 ? ssb : ssb2)[kd * 256 + wave * 32 + r32] = ss;
                                if (pt == 0) {
                                    u32x4 h0, h1;
                                    h0.x = pk2(o[kd][0], o[kd][1]); h0.y = pk2(o[kd][2], o[kd][3]); h0.z = pk2(o[kd][4], o[kd][5]); h0.w = pk2(o[kd][6], o[kd][7]);
                                    h1.x = pk2(o[kd][8], o[kd][9]); h1.y = pk2(o[kd][10], o[kd][11]); h1.z = pk2(o[kd][12], o[kd][13]); h1.w = pk2(o[kd][14], o[kd][15]);
                                    *(u32x4*)(hpark + kd * 2048 + lane * 16) = h0; *(u32x4*)(hpark + kd * 2048 + 1024 + lane * 16) = h1; }
                            }
                            xc[0] = xn[0]; xc[1] = xn[1];
                        }
                    }
                    if (pt == 1) {
                        const float* ngp = ng + h * 64 + 4 * hi;
                        f32x4 gq0[4], gq1[4];
#pragma unroll
                        for (int rq = 0; rq < 4; ++rq) { gq0[rq] = *(const f32x4*)(ngp + 8 * rq); gq1[rq] = *(const f32x4*)(ngp + 32 + 8 * rq); }
                        u32x4 hv[4][2];
#pragma unroll
                        for (int k = 0; k < 4; ++k) { hv[k][0] = *(const u32x4*)(hpark + k * 2048 + lane * 16); hv[k][1] = *(const u32x4*)(hpark + k * 2048 + 1024 + lane * 16); }
                        __syncthreads();
                        LAS unsigned char* tb_ = CBl + wave * 4608;
#pragma unroll
                        for (int k = 0; k < 4; ++k) {
                            const int jt = (k == 0) ? jt0 : (k == 1) ? jt1 : (k == 2) ? jt2 : jt3;
                            float tot = 0.f;
#pragma unroll
                            for (int w = 0; w < 8; ++w) tot += ssb[k * 256 + w * 32 + r32] + ssb2[k * 256 + w * 32 + r32];
                            const float rs = rsqrtf(tot * (1.0f / 512.0f) + RMS_EPS);
#pragma unroll
                            for (int rq = 0; rq < 4; ++rq) {
                                const f32x4 g0 = gq0[rq], g1 = gq1[rq];
                                u32x2 w0, w1;
                                const u32x4 hq = hv[k][rq >> 1]; const unsigned ha = (rq & 1) ? hq.z : hq.x, hb = (rq & 1) ? hq.w : hq.y;
                                w0.x = pk2(__builtin_bit_cast(float, ha << 16) * rs * g0.x, __builtin_bit_cast(float, ha & 0xffff0000u) * rs * g0.y); w0.y = pk2(__builtin_bit_cast(float, hb << 16) * rs * g0.z, __builtin_bit_cast(float, hb & 0xffff0000u) * rs * g0.w);
                                w1.x = pk2(o[k][4 * rq] * rs * g1.x, o[k][4 * rq + 1] * rs * g1.y); w1.y = pk2(o[k][4 * rq + 2] * rs * g1.z, o[k][4 * rq + 3] * rs * g1.w);
                                *(LAS u32x2*)(tb_ + r32 * 144 + rq * 16 + hi * 8) = w0; *(LAS u32x2*)(tb_ + r32 * 144 + 64 + rq * 16 + hi * 8) = w1;
                            }
                            bf16* op = MIXED + ((size_t)r0 + 32 * jt + (lane >> 3)) * D + 512 + h * 64 + (lane & 7) * 8;
#pragma unroll
                            for (int j = 0; j < 4; ++j) *(u32x4*)(op + (size_t)(8 * j) * D) = *(const LAS u32x4*)(tb_ + ((lane >> 3) + 8 * j) * 144 + (lane & 7) * 16);
                        }
                    }
                }
#undef XLOAD
#undef ZLOAD
#undef SLOAD
                __syncthreads();
            }
            mall_touch(WOUT + (size_t)l * WOUT_STRIDE, WOUT_STRIDE * 2, gw, lane, NGW);
        }
        PH_END;
#endif
#ifndef NO_WOUT
        if (PH_ON) {
            WS_BASE();
            pg8::StaticOrder S; S.init(M, D, G, bx);
            pg8::Gemm g{MIXED, WOUT + (size_t)l * WOUT_STRIDE, M, D, D};
            pg8::EpiResid E{HB, PART, 1.0f / REP_WOUT};
            pg8::gemm_phase<pg8::EpiResid, pg8::StaticOrder, true, true>(L + RING_OFF, g, S, E);
            { int t_ = threadIdx.x; asm volatile("" : "+v"(t_)); mall_touch(WGU + (size_t)(i + 1) * WGU_STRIDE, WGU_STRIDE * 2, bx * NWAVES + (t_ >> 6), t_ & 63, NGW); }
        }
#if REP_WOUT == 2
        if (PH_ON) {
            WS_BASE();
            pg8::StaticOrder S; S.init(M, D, G, bx);
            pg8::Gemm g{MIXED, WOUT + (size_t)l * WOUT_STRIDE, M, D, D};
            pg8::EpiResid E{HB, PART, 1.0f / REP_WOUT};
            pg8::gemm_phase<pg8::EpiResid, pg8::StaticOrder, true, true>(L + RING_OFF, g, S, E);
        }
#endif
#endif
        PH_END;
    }
    if (PH_ON) {
        LANE_IDS();
        const float* fg = args.in[20];
        f32x4 gg[8];
#pragma unroll
        for (int j = 0; j < 8; ++j) gg[j] = ((const GAS f32x4*)fg + lane)[64 * j];
        static_assert(M % (4 * GRID * NWAVES) == 0, "final norm: four rows per trip");
        for (int m0 = gw; m0 < M; m0 += 4 * NGW) {
            float ps[4]; unsigned long long q[4][8];
#pragma unroll
            for (int r = 0; r < 4; ++r) { const int m = m0 + r * NGW; ps[r] = (lane < 32) ? PART[(size_t)m * 32 + lane] : 0.f;
                const GAS unsigned long long* hr = (const GAS unsigned long long*)(HB + (size_t)m * D) + lane;
#pragma unroll
                for (int j = 0; j < 8; ++j) q[r][j] = hr[64 * j]; }
#pragma unroll
            for (int r = 0; r < 4; ++r) { const int m = m0 + r * NGW;
                const float rs = rsqrtf(wave_sum(ps[r], lane) * (1.0f / D) + RMS_EPS);
                GAS f32x4* orow = (GAS f32x4*)(args.out + (size_t)m * D) + lane;
#pragma unroll
                for (int j = 0; j < 8; ++j) { const unsigned lo_ = (unsigned)q[r][j], hi_ = (unsigned)(q[r][j] >> 32);
                    f32x4 v; v.x = __builtin_bit_cast(float, lo_ << 16); v.y = __builtin_bit_cast(float, lo_ & 0xffff0000u); v.z = __builtin_bit_cast(float, hi_ << 16); v.w = __builtin_bit_cast(float, hi_ & 0xffff0000u);
                    orow[64 * j] = v * rs * gg[j]; }
            }
        }
    }
#undef PH_ON
#undef PH_END
#undef PH_END_QUAD
}

constexpr int N_PHASES = 1 + 8 * 2 + 4 * 6 + 1;
#ifndef MK_PER_PHASE
#define MK_PER_PHASE 0
#endif
extern "C" void kernel_launch(void* const* d_in, const int* in_sizes, int n_in, void* d_out, int out_size, void* d_ws, size_t ws_size, hipStream_t stream) {
    static int ok = 0;
    if (ok == 0) {
        if (n_in != 21 || in_sizes[0] != M * D || out_size != M * D || ws_size < WS_END) { fprintf(stderr, "kernel_launch: unexpected shapes / workspace (%d inputs, ws %zu < %zu)\n", n_in, ws_size, (size_t)WS_END); ok = -1; return; }
        int dev = 0, cus = 0;
        if (hipGetDevice(&dev) != hipSuccess || hipDeviceGetAttribute(&cus, hipDeviceAttributeMultiprocessorCount, dev) != hipSuccess || cus < GRID) { fprintf(stderr, "kernel_launch: needs %d CUs, device has %d\n", GRID, cus); ok = -1; return; }
        if (hipFuncSetAttribute((const void*)fwd, hipFuncAttributeMaxDynamicSharedMemorySize, LDS_BYTES) != hipSuccess) { fprintf(stderr, "kernel_launch: hipFuncSetAttribute failed\n"); ok = -1; return; }
        int per_cu = 0;
        if (hipOccupancyMaxActiveBlocksPerMultiprocessor(&per_cu, (const void*)fwd, NWAVES * 64, LDS_BYTES) != hipSuccess || per_cu < 1) { fprintf(stderr, "kernel_launch: occupancy query says %d blocks per CU\n", per_cu); }
        (void)hipGetLastError();
        ok = 1;
    }
    if (ok < 0) return;
    if (hipMemsetAsync((char*)d_ws + WS_CTL, 0, CTL_ZERO_BYTES, stream) != hipSuccess) return;
    Args a{};
    for (int i = 0; i < 21; ++i) a.in[i] = (const float*)d_in[i];
    a.out = (float*)d_out; a.ws = (unsigned char*)d_ws;
#if MK_PER_PHASE
    for (int p = 0; p < N_PHASES; ++p) { a.ph_lo = p; a.ph_hi = p + 1; hipLaunchKernelGGL(fwd, dim3(GRID), dim3(NWAVES * 64), LDS_BYTES, stream, a); }
#else
    a.ph_lo = 0; a.ph_hi = N_PHASES;
    hipLaunchKernelGGL(fwd, dim3(GRID), dim3(NWAVES * 64), LDS_BYTES, stream, a);
#endif
}
```

```cpp
#include <hip/hip_runtime.h>
#include <cstdio>
#include <cstdint>
namespace pg8 {
#define PG8_LAS __attribute__((address_space(3)))
typedef unsigned short bf16_t;
typedef short bf16x8 __attribute__((ext_vector_type(8)));
typedef float f32x4 __attribute__((ext_vector_type(4)));
typedef unsigned u32x4 __attribute__((ext_vector_type(4)));
constexpr int BM = 256, BK = 64, HALF = 128, HTB = HALF * BK * 2  , STAGE_BYTES = 8 * HTB, NXCD = 8, WGM = 8;

__host__ __device__ __forceinline__ int lds_byte(int r, int c) { const int st = (r >> 4) * 2 + (c >> 5), rr = r & 15, cc = c & 31, ob = rr * 64 + cc * 2; return st * 1024 + (ob ^ (((ob >> 9) & 1) << 5)); }
__host__ __device__ __forceinline__ void stage_rc(int b, int& R, int& C) { const int st = b / 1024, sb = b % 1024, swz = sb ^ (((sb >> 9) & 1) << 5); R = (st >> 1) * 16 + swz / 64; C = (st & 1) * 32 + (swz % 64) / 2; }
__host__ __device__ __forceinline__ int perm32(int rho) { const int n = rho >> 4, i = rho & 15; return 8 * (i >> 2) + 4 * n + (i & 3); }

struct Unit { int pm, pn; };
struct Gemm { const bf16_t* A; const bf16_t* Bt; int M, N, K; };

struct StaticOrder {
    int nM, nN, nwg, G, c;
    __host__ __device__ __forceinline__ void init(int M, int N, int G_, int c_) { nM = M / BM; nN = N / BM; nwg = nM * nN; G = G_; c = c_; }
    __host__ __device__ __forceinline__ bool next(int i, Unit& u) const {
        const long L = (long)i * G + c; if (L >= nwg) return false;
        int wgid = (int)L; { const int q = nwg / NXCD, r = nwg % NXCD, xcd = wgid % NXCD, off = wgid / NXCD; wgid = (xcd < r ? xcd * (q + 1) : r * (q + 1) + (xcd - r) * q) + off; }
        const int nig = WGM * nN, gid = wgid / nig, fm = gid * WGM, gsz = (nM - fm) < WGM ? (nM - fm) : WGM;
        u.pm = fm + ((wgid % nig) % gsz); u.pn = (wgid % nig) / gsz; return true;
    }
    __device__ __forceinline__ void a_ready(const Unit&) const {}
    __device__ __forceinline__ void done(const Unit&) const {}
};

__device__ __forceinline__ unsigned cvt_pk_bf16(float lo, float hi) { unsigned r; asm volatile("v_cvt_pk_bf16_f32 %0, %1, %2" : "=v"(r) : "v"(lo), "v"(hi)); return r; }
__device__ __forceinline__ float shx(float v, int lane, int k) { return __builtin_bit_cast(float, __builtin_amdgcn_ds_bpermute((lane ^ k) << 2, __builtin_bit_cast(int, v))); }
__device__ __forceinline__ float shl_(float v, int srclane) { return __builtin_bit_cast(float, __builtin_amdgcn_ds_bpermute(srclane << 2, __builtin_bit_cast(int, v))); }
__device__ __forceinline__ float fast_silu(float g) { return g * __builtin_amdgcn_rcpf(1.0f + __builtin_amdgcn_exp2f(-1.4426950408889634f * g)); }
struct EpiSwiGLU {
    static constexpr bool PERM = true, AFTER_DRAIN = false;
    bf16_t* O; int ldc; const PG8_LAS float* rstd;
    __device__ __forceinline__ void operator()(const f32x4 (&acc)[2][2][4][2], const Unit& u, int wr, int wc, int fr_, int fq_) const {
        int fr = fr_, fq = fq_; asm volatile("" : "+v"(fr), "+v"(fq));
        const int rl0 = wr * 64 + fr;
        bf16_t* base = O + (size_t)(u.pm * BM) * ldc + u.pn * HALF + wc * 32 + 8 * fq;
#pragma unroll
        for (int ai = 0; ai < 2; ++ai)
#pragma unroll
            for (int m = 0; m < 4; ++m) {
                const int rl = rl0 + ai * HALF + m * 16; const float r = rstd[rl];
                const float rn = -1.4426950408889634f * r, r2 = r * r;
                u32x4 w;
#pragma unroll
                for (int n = 0; n < 2; ++n) {
                    const f32x4 ag = acc[ai][0][m][n], au = acc[ai][1][m][n];
                    const f32x4 t = ag * rn;
                    f32x4 d; d[0] = __builtin_amdgcn_exp2f(t[0]); d[1] = __builtin_amdgcn_exp2f(t[1]); d[2] = __builtin_amdgcn_exp2f(t[2]); d[3] = __builtin_amdgcn_exp2f(t[3]);
                    d = d + 1.0f;
                    f32x4 rc; rc[0] = __builtin_amdgcn_rcpf(d[0]); rc[1] = __builtin_amdgcn_rcpf(d[1]); rc[2] = __builtin_amdgcn_rcpf(d[2]); rc[3] = __builtin_amdgcn_rcpf(d[3]);
                    const f32x4 o_ = (ag * au) * (rc * r2);
                    if (n == 0) { w.x = cvt_pk_bf16(o_[0], o_[1]); w.y = cvt_pk_bf16(o_[2], o_[3]); } else { w.z = cvt_pk_bf16(o_[0], o_[1]); w.w = cvt_pk_bf16(o_[2], o_[3]); }
                }
                *(u32x4*)(base + (size_t)rl * ldc) = w;
            }
    }
};
struct EpiResid {
    static constexpr bool PERM = true, AFTER_DRAIN = false;
    bf16_t* Hb; float* part; float scale;
    __device__ __forceinline__ void operator()(const f32x4 (&acc)[2][2][4][2], const Unit& u, int wr, int wc, int fr_, int fq_) const {
        int fr = fr_, fq = fq_; asm volatile("" : "+v"(fr), "+v"(fq));
        const int row0 = u.pm * BM + wr * 64 + fr, col0 = u.pn * BM + wc * 32 + 8 * fq;
        u32x4 hq[2][4][2];
#pragma unroll
        for (int ai = 0; ai < 2; ++ai)
#pragma unroll
            for (int m = 0; m < 4; ++m)
#pragma unroll
                for (int bj = 0; bj < 2; ++bj) hq[ai][m][bj] = *(const u32x4*)(Hb + (size_t)(row0 + ai * HALF + m * 16) * 2048 + col0 + bj * HALF);
        __builtin_amdgcn_sched_barrier(0);
#pragma unroll
        for (int ai = 0; ai < 2; ++ai)
#pragma unroll
            for (int m = 0; m < 4; ++m) {
                const int row = row0 + ai * HALF + m * 16; float ss = 0.f;
#pragma unroll
                for (int bj = 0; bj < 2; ++bj) {
                    const size_t off = (size_t)row * 2048 + col0 + bj * HALF;
                    const u32x4 h_ = hq[ai][m][bj];
                    f32x4 v0, v1;
                    v0[0] = __builtin_bit_cast(float, h_.x << 16); v0[1] = __builtin_bit_cast(float, h_.x & 0xffff0000u); v0[2] = __builtin_bit_cast(float, h_.y << 16); v0[3] = __builtin_bit_cast(float, h_.y & 0xffff0000u);
                    v1[0] = __builtin_bit_cast(float, h_.z << 16); v1[1] = __builtin_bit_cast(float, h_.z & 0xffff0000u); v1[2] = __builtin_bit_cast(float, h_.w << 16); v1[3] = __builtin_bit_cast(float, h_.w & 0xffff0000u);
                    v0 = v0 + acc[ai][bj][m][0] * scale; v1 = v1 + acc[ai][bj][m][1] * scale;
                    u32x4 w; w.x = cvt_pk_bf16(v0[0], v0[1]); w.y = cvt_pk_bf16(v0[2], v0[3]); w.z = cvt_pk_bf16(v1[0], v1[1]); w.w = cvt_pk_bf16(v1[2], v1[3]);
                    *(u32x4*)(Hb + off) = w;
                    const float r0 = __builtin_bit_cast(float, w.x << 16), r1 = __builtin_bit_cast(float, w.x & 0xffff0000u), r2 = __builtin_bit_cast(float, w.y << 16), r3 = __builtin_bit_cast(float, w.y & 0xffff0000u);
                    const float r4 = __builtin_bit_cast(float, w.z << 16), r5 = __builtin_bit_cast(float, w.z & 0xffff0000u), r6 = __builtin_bit_cast(float, w.w << 16), r7 = __builtin_bit_cast(float, w.w & 0xffff0000u);
                    ss += (r0 * r0 + r1 * r1) + (r2 * r2 + r3 * r3) + (r4 * r4 + r5 * r5) + (r6 * r6 + r7 * r7);
                }
                { const int ln = fq * 16 + fr; ss += shx(ss, ln, 16); ss += shx(ss, ln, 32); }
                if (fq == 0) part[(size_t)row * 32 + u.pn * 4 + wc] = ss;
            }
    }
};
struct EpiProj {
    static constexpr bool PERM = true, AFTER_DRAIN = false;
    bf16_t* O; float* dtraw; const PG8_LAS float* rstd;
    __device__ __forceinline__ void operator()(const f32x4 (&acc)[2][2][4][2], const Unit& u, int wr, int wc, int fr_, int fq_) const {
        int fr = fr_, fq = fq_; asm volatile("" : "+v"(fr), "+v"(fq));
        const int rl0 = wr * 64 + fr;
        {
            bf16_t* base = O + (size_t)(u.pm * BM) * 4608 + u.pn * BM + wc * 32 + 8 * fq;
#pragma unroll
            for (int ai = 0; ai < 2; ++ai)
#pragma unroll
                for (int m = 0; m < 4; ++m) {
                    const int rl = rl0 + ai * HALF + m * 16; const float r = rstd[rl];
#pragma unroll
                    for (int bj = 0; bj < 2; ++bj) {
                        const f32x4 v0 = acc[ai][bj][m][0] * r, v1 = acc[ai][bj][m][1] * r;
                        u32x4 w; w.x = cvt_pk_bf16(v0[0], v0[1]); w.y = cvt_pk_bf16(v0[2], v0[3]); w.z = cvt_pk_bf16(v1[0], v1[1]); w.w = cvt_pk_bf16(v1[2], v1[3]);
                        *(u32x4*)(base + (size_t)rl * 4608 + bj * HALF) = w;
                    }
                }
        }
    }
};
template <class Epi, class Sched, bool ALIGN_EPI = false, bool SP2 = false, bool RS = false>
__device__ __forceinline__ void gemm_phase(PG8_LAS unsigned char* lds, const Gemm g, const Sched& S, const Epi& E, const float* rpart = nullptr, PG8_LAS float* rtab = nullptr, float rinvd = 0.f, float reps = 0.f) {
    int tid_ = threadIdx.x; asm volatile("" : "+v"(tid_));
    const int tid = tid_, wid = __builtin_amdgcn_readfirstlane(tid >> 6), lane = tid & 63, wr = wid >> 2, wc = wid & 3, fr = lane & 15, fq = lane >> 4;
    const int K = g.K, nt = K / BK;
    unsigned voffA[2], voffB[2];
#pragma unroll
    for (int i = 0; i < 2; ++i) { int R, C; stage_rc(tid * 16 + i * 8192, R, C); const int Rb = Epi::PERM ? ((R & ~31) + perm32(R & 31)) : R;
        voffA[i] = (unsigned)(R * K + C) * 2u; voffB[i] = (unsigned)(Rb * K + C) * 2u; }
    const size_t kstep = (size_t)(BK * 2);
    const size_t hstep = (size_t)HALF * K * 2;
    const size_t tstep = 2 * hstep;
    const unsigned ldsw = (unsigned)wid * 1024u;
    const int aoff = lds_byte(wr * 64 + fr, fq * 8), boff = lds_byte(wc * 32 + fr, fq * 8);
#define PG8_SA(b, h) (((b) * 2 + (h)) * HTB)
#define PG8_SB(b, h) ((4 + (b) * 2 + (h)) * HTB)
#define PG8_STAGE(bufoff, gbase, voff) do { _Pragma("unroll") for (int _i = 0; _i < 2; ++_i) \
        __builtin_amdgcn_global_load_lds((const unsigned*)((const char*)(gbase) + (voff)[_i]), (PG8_LAS unsigned*)(lds + (bufoff) + ldsw + _i * 8192), 16, 0, 0); } while (0)
#define PG8_LDA(dst, b, h) do { _Pragma("unroll") for (int m = 0; m < 4; ++m) _Pragma("unroll") for (int k = 0; k < 2; ++k) dst[m][k] = *(const PG8_LAS bf16x8*)(lds + PG8_SA(b, h) + aoff + m * 2048 + k * 1024); } while (0)
#define PG8_LDB(dst, b, h) do { _Pragma("unroll") for (int n = 0; n < 2; ++n) _Pragma("unroll") for (int k = 0; k < 2; ++k) dst[n][k] = *(const PG8_LAS bf16x8*)(lds + PG8_SB(b, h) + boff + n * 2048 + k * 1024); } while (0)
#define PG8_MMA(ai, bj, At, Bt) do { __builtin_amdgcn_s_setprio(1); _Pragma("unroll") for (int m = 0; m < 4; ++m) _Pragma("unroll") for (int n = 0; n < 2; ++n) _Pragma("unroll") for (int k = 0; k < 2; ++k) \
        acc[ai][bj][m][n] = __builtin_amdgcn_mfma_f32_16x16x32_bf16(Bt[n][k], At[m][k], acc[ai][bj][m][n], 0, 0, 0); __builtin_amdgcn_s_setprio(0); } while (0)
#define PG8_WAIT_V(n) asm volatile("s_waitcnt vmcnt(" #n ")" ::: "memory")
#define PG8_WAIT_L(n) asm volatile("s_waitcnt lgkmcnt(" #n ")" ::: "memory")
#define PG8_BAR __builtin_amdgcn_s_barrier()
#define PG8_SCHED __builtin_amdgcn_sched_barrier(0)
    Unit cur, nxt; int ui = 0;
    if (!S.next(0, cur)) return;
    f32x4 acc[2][2][4][2];
#pragma unroll
    for (int a = 0; a < 2; ++a)
#pragma unroll
        for (int b = 0; b < 2; ++b)
#pragma unroll
            for (int m = 0; m < 4; ++m)
#pragma unroll
                for (int n = 0; n < 2; ++n) acc[a][b][m][n] = (f32x4){0.f, 0.f, 0.f, 0.f};
    bf16x8 At[4][2], B0[2][2], B1[2][2];
    const char* cA = (const char*)g.A + (size_t)cur.pm * tstep; const char* cB = (const char*)g.Bt + (size_t)cur.pn * tstep;
    S.a_ready(cur);
    f32x4 rq0 = {}, rq1 = {}, rq2 = {}, rq3 = {};
    if constexpr (RS) { const f32x4* rp_ = (const f32x4*)(rpart + (size_t)(cur.pm * 256 + (tid >> 1)) * 32 + (tid & 1) * 16); rq0 = rp_[0]; rq1 = rp_[1]; rq2 = rp_[2]; rq3 = rp_[3]; }
    if constexpr (SP2) {
        PG8_STAGE(PG8_SB(0, 0), cB, voffB); PG8_STAGE(PG8_SB(0, 1), cB + hstep, voffB); PG8_STAGE(PG8_SA(0, 0), cA, voffA); PG8_STAGE(PG8_SA(0, 1), cA + hstep, voffA);
        if (wr == 1) PG8_BAR;
        PG8_WAIT_V(2); PG8_BAR;
        PG8_STAGE(PG8_SB(1, 0), cB + kstep, voffB); PG8_STAGE(PG8_SA(1, 0), cA + kstep, voffA); PG8_STAGE(PG8_SB(1, 1), cB + hstep + kstep, voffB);
        if constexpr (RS) { float s_ = ((rq0.x + rq0.y) + (rq0.z + rq0.w)) + ((rq1.x + rq1.y) + (rq1.z + rq1.w)) + ((rq2.x + rq2.y) + (rq2.z + rq2.w)) + ((rq3.x + rq3.y) + (rq3.z + rq3.w));
            s_ += shx(s_, lane, 1); if (!(tid & 1)) rtab[tid >> 1] = rsqrtf(s_ * rinvd + reps); }
        PG8_WAIT_V(6); PG8_BAR;
    } else {
        PG8_STAGE(PG8_SB(0, 0), cB, voffB); PG8_STAGE(PG8_SA(0, 0), cA, voffA); PG8_STAGE(PG8_SB(0, 1), cB + hstep, voffB); PG8_STAGE(PG8_SA(0, 1), cA + hstep, voffA);
        if (wr == 1) PG8_BAR;
        PG8_WAIT_V(4); PG8_BAR;
        PG8_STAGE(PG8_SB(1, 0), cB + kstep, voffB); PG8_STAGE(PG8_SA(1, 0), cA + kstep, voffA); PG8_STAGE(PG8_SB(1, 1), cB + hstep + kstep, voffB);
        PG8_WAIT_V(6); PG8_BAR;
    }
    for (;;) {
        const bool has_next = S.next(ui + 1, nxt);
        const char* nA = has_next ? (const char*)g.A + (size_t)nxt.pm * tstep : cA; const char* nB = has_next ? (const char*)g.Bt + (size_t)nxt.pn * tstep : cB;
        for (int t = 0; t < nt; t += 2) {
            const bool last = (t == nt - 2);
            const char* a1 = cA + (size_t)(t + 1) * kstep;
            const char* a2 = last ? nA : cA + (size_t)(t + 2) * kstep; const char* b2 = last ? nB : cB + (size_t)(t + 2) * kstep;
            const char* a3 = a2 + kstep; const char* b3 = b2 + kstep;
            if (last && has_next) S.a_ready(nxt);
            if constexpr (SP2) {
            PG8_LDB(B0, 0, 0); PG8_LDB(B1, 0, 1); PG8_SCHED; PG8_LDA(At, 0, 0); PG8_STAGE(PG8_SA(1, 1), a1 + hstep, voffA);
            PG8_WAIT_V(8); PG8_WAIT_L(0); PG8_BAR; PG8_MMA(0, 0, At, B0); PG8_MMA(0, 1, At, B1); PG8_BAR; PG8_SCHED;
            PG8_LDA(At, 0, 1); PG8_STAGE(PG8_SB(0, 0), b2, voffB); PG8_STAGE(PG8_SB(0, 1), b2 + hstep, voffB); PG8_STAGE(PG8_SA(0, 0), a2, voffA);
            PG8_WAIT_V(8); PG8_WAIT_L(0); PG8_BAR; PG8_MMA(1, 0, At, B0); PG8_MMA(1, 1, At, B1); PG8_BAR; PG8_SCHED;
            PG8_LDB(B0, 1, 0); PG8_LDB(B1, 1, 1); PG8_SCHED; PG8_LDA(At, 1, 0); PG8_STAGE(PG8_SA(0, 1), a2 + hstep, voffA);
            PG8_WAIT_V(8); PG8_WAIT_L(0); PG8_BAR; PG8_MMA(0, 0, At, B0); PG8_MMA(0, 1, At, B1); PG8_BAR; PG8_SCHED;
            PG8_LDA(At, 1, 1); PG8_STAGE(PG8_SB(1, 0), b3, voffB); PG8_STAGE(PG8_SB(1, 1), b3 + hstep, voffB); PG8_STAGE(PG8_SA(1, 0), a3, voffA);
            PG8_WAIT_V(8); PG8_WAIT_L(0); PG8_BAR; PG8_MMA(1, 0, At, B0); PG8_MMA(1, 1, At, B1); PG8_BAR; PG8_SCHED;
            } else {
            PG8_LDB(B0, 0, 0); PG8_SCHED; PG8_LDA(At, 0, 0); PG8_STAGE(PG8_SA(1, 1), a1 + hstep, voffA);
            PG8_WAIT_L(8); PG8_BAR; PG8_WAIT_L(0); PG8_MMA(0, 0, At, B0); PG8_BAR; PG8_SCHED;
            PG8_LDB(B1, 0, 1); PG8_STAGE(PG8_SB(0, 0), b2, voffB);
            PG8_BAR; PG8_WAIT_L(0); PG8_MMA(0, 1, At, B1); PG8_BAR;
            PG8_LDA(At, 0, 1); PG8_STAGE(PG8_SA(0, 0), a2, voffA);
            PG8_BAR; PG8_WAIT_L(0); PG8_MMA(1, 0, At, B0); PG8_BAR; PG8_SCHED;
            PG8_STAGE(PG8_SB(0, 1), b2 + hstep, voffB);
            PG8_WAIT_V(6); PG8_BAR; PG8_MMA(1, 1, At, B1); PG8_BAR;
            PG8_LDB(B0, 1, 0); PG8_SCHED; PG8_LDA(At, 1, 0); PG8_STAGE(PG8_SA(0, 1), a2 + hstep, voffA);
            PG8_WAIT_L(8); PG8_BAR; PG8_WAIT_L(0); PG8_MMA(0, 0, At, B0); PG8_BAR; PG8_SCHED;
            PG8_LDB(B1, 1, 1); PG8_STAGE(PG8_SB(1, 0), b3, voffB);
            PG8_BAR; PG8_WAIT_L(0); PG8_MMA(0, 1, At, B1); PG8_BAR;
            PG8_LDA(At, 1, 1); PG8_STAGE(PG8_SA(1, 0), a3, voffA);
            PG8_BAR; PG8_WAIT_L(0); PG8_MMA(1, 0, At, B0); PG8_BAR; PG8_SCHED;
            PG8_STAGE(PG8_SB(1, 1), b3 + hstep, voffB);
            PG8_WAIT_V(6); PG8_BAR; PG8_MMA(1, 1, At, B1); PG8_BAR;
            }
        }
        if constexpr (ALIGN_EPI) { if (wr == 0) PG8_BAR; }
        if constexpr (!Epi::AFTER_DRAIN) { E(acc, cur, wr, wc, fr, fq); S.done(cur); }
        if (!has_next) break;
#pragma unroll
        for (int a = 0; a < 2; ++a)
#pragma unroll
            for (int b = 0; b < 2; ++b)
#pragma unroll
                for (int m = 0; m < 4; ++m)
#pragma unroll
                    for (int n = 0; n < 2; ++n) acc[a][b][m][n] = (f32x4){0.f, 0.f, 0.f, 0.f};
        cur = nxt; cA = nA; cB = nB; ++ui;
        if constexpr (ALIGN_EPI) { if (wr == 1) PG8_BAR; }
    }
    PG8_WAIT_V(0);
    if constexpr (!ALIGN_EPI) { if (wr == 0) PG8_BAR; }
    PG8_BAR;
    if constexpr (Epi::AFTER_DRAIN) { E.fused(acc, cur, wr, wc, fr, fq, lds, wid, lane); S.done(cur); }
#undef PG8_SA
#undef PG8_SB
#undef PG8_STAGE
#undef PG8_LDA
#undef PG8_LDB
#undef PG8_MMA
#undef PG8_WAIT_V
#undef PG8_WAIT_L
#undef PG8_BAR
#undef PG8_SCHED
}
}
#define GAS __attribute__((address_space(1)))
#define LAS __attribute__((address_space(3)))
typedef unsigned short bf16;
typedef unsigned v4u __attribute__((ext_vector_type(4)));
typedef float f32x4 __attribute__((ext_vector_type(4)));
typedef short bf16x8 __attribute__((ext_vector_type(8)));
typedef float f32x16 __attribute__((ext_vector_type(16)));
typedef GAS unsigned gu32;
typedef GAS unsigned long long gu64;
#define RLX_AGENT __ATOMIC_RELAXED, __HIP_MEMORY_SCOPE_AGENT
#define LDS_WAIT() asm volatile("s_waitcnt lgkmcnt(0)" ::: "memory")
#define VM_WAIT() asm volatile("s_waitcnt vmcnt(0)" ::: "memory")
__device__ __forceinline__ unsigned long long rt() { return __builtin_amdgcn_s_memrealtime(); }
__device__ __forceinline__ unsigned f2bf(float f) { unsigned u = __builtin_bit_cast(unsigned, f); return (u + 0x7fffu + ((u >> 16) & 1u)) >> 16; }
typedef float f32x2_t __attribute__((ext_vector_type(2))); typedef __bf16 bf16x2_t __attribute__((ext_vector_type(2)));
__device__ __forceinline__ unsigned pk2(float lo, float hi) { f32x2_t v = {lo, hi}; bf16x2_t b = __builtin_convertvector(v, bf16x2_t); return __builtin_bit_cast(unsigned, b); }

#define XB_TMO      128
#define XB_XCNT(j)  (256  + 64 * (j))
#define XB_XSUB(j)  (1280 + 64 * (j))
#define XB_XGEN(j)  (2304 + 64 * (j))
#define XB_TOP      3328
#define XB_TOPGEN   3392
#define XCD_BAR_WORDS 3456
#define XB_SPIN_CAP (1u << 18)

__device__ __forceinline__ unsigned xb_ld(unsigned* p)              { return __hip_atomic_load(p, __ATOMIC_RELAXED, __HIP_MEMORY_SCOPE_AGENT); }
__device__ __forceinline__ unsigned xb_add(unsigned* p, unsigned v) { return __hip_atomic_fetch_add(p, v, __ATOMIC_RELAXED, __HIP_MEMORY_SCOPE_AGENT); }
__device__ __forceinline__ unsigned xb_xcc_id() { return (unsigned)__builtin_amdgcn_s_getreg((3 << 11) | 20) & 0xFu; }
#define XB_SPIN(cond, bar) do { unsigned _sp = 0; while (cond) { __builtin_amdgcn_s_sleep(1); \
    if ((++_sp & 255u) == 0u) { if (xb_ld(&(bar)[XB_TMO])) break; if (_sp > XB_SPIN_CAP) { atomicAdd(&(bar)[XB_TMO], 1u); break; } } } } while (0)

struct XcdBarrier {
    unsigned* bar; unsigned x;
    volatile LAS unsigned* st;
};

__device__ __forceinline__ XcdBarrier xcd_barrier_post(unsigned* bar, volatile LAS unsigned* st) {
    XcdBarrier b; b.bar = bar; b.x = xb_xcc_id(); b.st = st;
    if (threadIdx.x == 0) (void)xb_add(&bar[XB_XCNT(b.x)], 1u);
    return b;
}
__device__ __forceinline__ void xcd_barrier_complete(unsigned* bar, unsigned x, unsigned& nloc, unsigned& nx) {
    const unsigned G = gridDim.x * gridDim.y * gridDim.z;
    unsigned sum, cnt, mine, sp = 0u;
    for (;;) {
        sum = 0u; cnt = 0u; mine = 0u;
#pragma unroll 1
        for (unsigned j = 0; j < 16; ++j) { const unsigned c = xb_ld(&bar[XB_XCNT(j)]); sum += c; cnt += (c > 0u) ? 1u : 0u; mine = (j == x) ? c : mine; }
        if (sum == G) break;
        __builtin_amdgcn_s_sleep(1);
        if ((++sp & 255u) == 0u) { if (xb_ld(&bar[XB_TMO])) break; if (sp > XB_SPIN_CAP) { atomicAdd(&bar[XB_TMO], 1u); break; } }
    }
    nloc = mine > 0u ? mine : 1u; nx = cnt > 0u ? cnt : 1u;
}

__device__ __forceinline__ void xcd_barrier(const XcdBarrier& b) {
    asm volatile("s_waitcnt vmcnt(0)" ::: "memory");
    __syncthreads();
    if (threadIdx.x == 0) {
        unsigned* bar = b.bar;
        __builtin_amdgcn_s_waitcnt(0);
        unsigned nloc = b.st[0], nx = b.st[1];
        if (nloc == 0u) { xcd_barrier_complete(bar, b.x, nloc, nx); b.st[0] = nloc; b.st[1] = nx; }
        const unsigned old = xb_add(&bar[XB_XSUB(b.x)], 1u);
        const unsigned gen = old / nloc;
        if (old + 1u == (gen + 1u) * nloc) {
            __builtin_amdgcn_fence(__ATOMIC_RELEASE, "agent");
            asm volatile("s_waitcnt vmcnt(0)" ::: "memory");
            const unsigned og = xb_add(&bar[XB_TOP], 1u);
            const unsigned tg = og / nx;
            if (og + 1u == (tg + 1u) * nx) xb_add(&bar[XB_TOPGEN], 1u);
            else XB_SPIN(xb_ld(&bar[XB_TOPGEN]) == tg, bar);
            __builtin_amdgcn_fence(__ATOMIC_ACQUIRE, "agent");
            xb_add(&bar[XB_XGEN(b.x)], 1u);
            asm volatile("s_waitcnt vmcnt(0)" ::: "memory");
        } else {
            XB_SPIN(xb_ld(&bar[XB_XGEN(b.x)]) == gen, bar);
            __builtin_amdgcn_fence(__ATOMIC_ACQUIRE, "agent");
            asm volatile("s_waitcnt vmcnt(0)" ::: "memory");
        }
    }
    __syncthreads();
}

#ifndef REP_PRO
#define REP_PRO 1
#endif
#ifndef REP_UP
#define REP_UP 1
#endif
#ifndef REP_WIN
#define REP_WIN 1
#endif
#ifndef REP_MIX
#define REP_MIX 1
#endif
#ifndef REP_DOWN
#define REP_DOWN 1
#endif
#ifndef REP_WOUT
#define REP_WOUT 1
#endif
#ifndef REP_ATT
#define REP_ATT 1
#endif
#ifndef REP_S1
#define REP_S1 1
#endif
#ifndef REP_S2
#define REP_S2 1
#endif
#ifndef REP_S3
#define REP_S3 1
#endif
constexpr int NWAVES = 8;
constexpr int BATCH = 2, SEQ = 8192, M = BATCH * SEQ, D = 2048, FF = 5632, NGU = 2 * FF, DEPTH = 4;
constexpr int NIN = 4864, PROJ_LD = 4608;
constexpr int P_POOL = 0, P_Z = 512, P_XBC = 1536, P_Q = 3072, P_K = 3584, P_V = 4096;
constexpr int IN_W = 4624;
constexpr float RMS_EPS = 1e-6f;
constexpr int GRID = 256;

constexpr size_t MiB = 1u << 20;
constexpr size_t WS_CTL = 0, CTL_ZERO_BYTES = 1 * MiB;
constexpr size_t WS_PWT = 1 * MiB;
constexpr size_t WS_WGU = 2 * MiB;        constexpr size_t WGU_STRIDE = (size_t)NGU * D;
constexpr size_t WS_WD = 354 * MiB;       constexpr size_t WD_STRIDE = (size_t)D * FF;
constexpr size_t WS_WIN = 530 * MiB;      constexpr size_t WIN_STRIDE = (size_t)NIN * D;
constexpr size_t WS_WOUT = 606 * MiB;     constexpr size_t WOUT_STRIDE = (size_t)D * D;
constexpr size_t WS_H = 638 * MiB, WS_HB = 766 * MiB, WS_PART = 830 * MiB, WS_DTRAW = 832 * MiB, WS_DT = 833 * MiB;
constexpr size_t WS_X = 834 * MiB;
constexpr size_t WS_ACT = WS_X;
constexpr size_t WS_PROJ = WS_X, WS_MIXED = WS_X + 144 * MiB;
constexpr size_t WS_XT = WS_X + 208 * MiB, WS_XTS = WS_X + 240 * MiB, WS_BC = WS_X + 272 * MiB, WS_BCT = WS_X + 280 * MiB, WS_CC = WS_X + 288 * MiB, WS_CS = WS_X + 296 * MiB;
constexpr size_t WS_ST = WS_X + 297 * MiB, WS_SIN = WS_X + 329 * MiB, WS_Y = WS_X + 345 * MiB;
constexpr size_t WS_END = WS_X + 409 * MiB;
static_assert(WS_WGU + 8 * WGU_STRIDE * 2 <= WS_WD && WS_WD + 8 * WD_STRIDE * 2 <= WS_WIN && WS_WIN + 4 * WIN_STRIDE * 2 <= WS_WOUT && WS_WOUT + 4 * WOUT_STRIDE * 2 <= WS_H, "ws map: weights");
static_assert(WS_H + (size_t)M * D * 4 <= WS_HB && WS_HB + (size_t)M * D * 2 <= WS_PART && WS_PART + (size_t)M * 32 * 4 <= WS_DTRAW && WS_DTRAW + (size_t)M * 16 * 4 <= WS_DT && WS_DT + (size_t)M * 16 * 4 <= WS_X, "ws map: state");
static_assert(WS_ACT + (size_t)M * FF * 2 <= WS_END && WS_PROJ + (size_t)M * PROJ_LD * 2 <= WS_MIXED && WS_MIXED + (size_t)M * D * 2 <= WS_XT && WS_Y + (size_t)M * 1024 * 4 <= WS_END, "ws map: overlay");
constexpr int CW_BAR = 4096;

constexpr int RING_OFF = 0, RING_BYTES = 131072;
constexpr int LDSCTL_OFF = RING_BYTES, MISC_OFF = LDSCTL_OFF + 320, RSTD_OFF = LDSCTL_OFF + 1024;
constexpr int LDS_BYTES = 147456;
static_assert(RSTD_OFF + 1024 <= LDS_BYTES, "LDS map");

struct Args { const float* in[21]; float* out; unsigned char* ws; int ph_lo, ph_hi; };
static_assert(sizeof(Args) == 21 * 8 + 8 + 8 + 8, "Args has no padding");

typedef unsigned u32x4 __attribute__((ext_vector_type(4)));
__device__ __forceinline__ unsigned cvtpk_s(float lo, float hi) { return pk2(lo, hi); }
__device__ __forceinline__ bf16x8 scale_frag(v4u a, f32x4 wl, f32x4 wh) {
    v4u r;
    r.x = pk2(__builtin_bit_cast(float, a.x << 16) * wl.x, __builtin_bit_cast(float, a.x & 0xffff0000u) * wl.y); r.y = pk2(__builtin_bit_cast(float, a.y << 16) * wl.z, __builtin_bit_cast(float, a.y & 0xffff0000u) * wl.w);
    r.z = pk2(__builtin_bit_cast(float, a.z << 16) * wh.x, __builtin_bit_cast(float, a.z & 0xffff0000u) * wh.y); r.w = pk2(__builtin_bit_cast(float, a.w << 16) * wh.z, __builtin_bit_cast(float, a.w & 0xffff0000u) * wh.w);
    return __builtin_bit_cast(bf16x8, r);
}
__device__ __forceinline__ float bf2f(bf16 b) { return __builtin_bit_cast(float, (unsigned)b << 16); }
__device__ __forceinline__ float wave_sum(float v, int lane) {
#pragma unroll
    for (int o = 1; o < 64; o <<= 1) v += pg8::shx(v, lane, o);
    return v;
}
__device__ __forceinline__ float softplus_f(float z) { return fmaxf(z, 0.f) + 0.6931471806f * __builtin_amdgcn_logf(1.0f + __builtin_amdgcn_exp2f(-1.4426950409f * fabsf(z))); }
__device__ __forceinline__ float silu_f(float z) { return z * __builtin_amdgcn_rcpf(1.0f + __builtin_amdgcn_exp2f(-1.4426950409f * z)); }

struct TItem { const float* W; const float* gain; bf16* WT; int K, N, drow0, scol, k0; };
__device__ __forceinline__ void titem_load(const TItem& t, int lane, f32x4 (&v)[8], f32x4& g0, f32x4& g1) {
    const int kr = lane >> 3;
#pragma unroll
    for (int i = 0; i < 8; ++i) { const f32x4 x_ = *(const f32x4*)(t.W + (size_t)(t.k0 + 8 * kr + i) * t.N + (t.scol >= 0 ? t.scol : 0));
        v[i] = x_ * ((t.scol >= 0) ? 1.0f : 0.0f); }
    g0 = (f32x4){1.f, 1.f, 1.f, 1.f}; g1 = g0;
    if (t.gain) { g0 = *(const f32x4*)(t.gain + t.k0 + 8 * kr); g1 = *(const f32x4*)(t.gain + t.k0 + 8 * kr + 4); }
}
__device__ __forceinline__ void titem_store(const TItem& t, int lane, const f32x4 (&v)[8], const f32x4& g0, const f32x4& g1) {
    const int kr = lane >> 3, c4 = lane & 7;
#pragma unroll
    for (int e = 0; e < 4; ++e) {
        v4u o; o.x = pk2(v[0][e] * g0.x, v[1][e] * g0.y); o.y = pk2(v[2][e] * g0.z, v[3][e] * g0.w); o.z = pk2(v[4][e] * g1.x, v[5][e] * g1.y); o.w = pk2(v[6][e] * g1.z, v[7][e] * g1.w);
        *(GAS v4u*)(t.WT + (size_t)(t.drow0 + 4 * c4 + e) * t.K + t.k0 + 8 * kr) = o; }
}
constexpr int TI_GU = (D / 64) * (NGU / 32), TI_D = (FF / 64) * (D / 32), TI_IN = (D / 64) * (NIN / 32), TI_OUT = (D / 64) * (D / 32);
constexpr int TI_TOTAL = 8 * (TI_GU + TI_D) + 4 * (TI_IN + TI_OUT);
__device__ __forceinline__ void titem_decode(int it, int lane, const float* const* in, bf16* WGU, bf16* WD, bf16* WIN, bf16* WOUT, TItem& t) {
    const int dl = 4 * (lane & 7);
    int r = it;
    if (r < 8 * TI_GU) {
        const int f = r / TI_GU; r -= f * TI_GU; const int l = f >> 1, second = f & 1;
        const int kb = r / (NGU / 32), db = r % (NGU / 32), tile = db >> 3, within = db & 7;
        t.W = ((within < 4) ? in[second ? 17 : 2] : in[second ? 18 : 3]) + (size_t)l * D * FF; t.gain = in[second ? 16 : 1] + l * D; t.WT = WGU + (size_t)f * WGU_STRIDE;
        t.K = D; t.N = FF; t.drow0 = db * 32; t.scol = tile * 128 + (within & 3) * 32 + dl; t.k0 = kb * 64; return;
    }
    r -= 8 * TI_GU;
    if (r < 8 * TI_D) {
        const int f = r / TI_D; r -= f * TI_D; const int l = f >> 1, second = f & 1;
        const int kb = r / (D / 32), db = r % (D / 32);
        t.W = in[second ? 19 : 4] + (size_t)l * FF * D; t.gain = nullptr; t.WT = WD + (size_t)f * WD_STRIDE; t.K = FF; t.N = D; t.drow0 = db * 32; t.scol = db * 32 + dl; t.k0 = kb * 64; return;
    }
    r -= 8 * TI_D;
    if (r < 4 * TI_IN) {
        const int l = r / TI_IN; r -= l * TI_IN;
        const int kb = r / (NIN / 32), db = r % (NIN / 32), d0 = db * 32;
        int scol;
        if (d0 < 3072) scol = d0 + dl;
        else if (d0 < 4608) scol = d0 + 16 + dl;
        else if (d0 == 4608) scol = (dl < 16) ? 3072 + dl : -1;
        else scol = -1;
        t.W = in[6] + (size_t)l * D * IN_W; t.gain = in[5] + l * D; t.WT = WIN + (size_t)l * WIN_STRIDE; t.K = D; t.N = IN_W; t.drow0 = d0; t.scol = scol; t.k0 = kb * 64; return;
    }
    r -= 4 * TI_IN;
    { const int l = r / TI_OUT; r -= l * TI_OUT; const int kb = r / (D / 32), db = r % (D / 32);
      t.W = in[15] + (size_t)l * D * D; t.gain = nullptr; t.WT = WOUT + (size_t)l * WOUT_STRIDE; t.K = D; t.N = D; t.drow0 = db * 32; t.scol = db * 32 + dl; t.k0 = kb * 64; }
}

__device__ __forceinline__ void mall_touch(const void* p, size_t bytes, int gw, int lane, int NGW) {
    const GAS u32x4* tp = (const GAS u32x4*)p;
    const size_t nv = bytes / 16, st = (size_t)NGW * 64;
    unsigned a = 0u;
    for (size_t o = (size_t)gw * 64 + lane; o < nv; o += 4 * st) {
        u32x4 v[4];
#pragma unroll
        for (int j = 0; j < 4; ++j) { const size_t q = o + j * st; v[j] = tp[q < nv ? q : o]; }
#pragma unroll
        for (int j = 0; j < 4; ++j) a |= v[j].x;
    }
    asm volatile("" :: "v"(a));
}
__device__ __forceinline__ void build_rstd(const float* part, int pm, LAS float* tab, int tid) {
    const int r = tid >> 1, hf = tid & 1;
    const f32x4* p = (const f32x4*)(part + (size_t)(pm * 256 + r) * 32 + hf * 16);
    const f32x4 a = p[0], b = p[1], c = p[2], d = p[3];
    float s = ((a.x + a.y) + (a.z + a.w)) + ((b.x + b.y) + (b.z + b.w)) + ((c.x + c.y) + (c.z + c.w)) + ((d.x + d.y) + (d.z + d.w));
    s += pg8::shx(s, tid & 63, 1);
    if (!hf) tab[r] = rsqrtf(s * (1.0f / D) + RMS_EPS);
    __syncthreads();
}

__global__ void __launch_bounds__(NWAVES * 64, 2) fwd(Args args) {
    extern __shared__ __attribute__((aligned(16))) unsigned char lds[];
    LAS unsigned char* const L = (LAS unsigned char*)lds;
    volatile LAS unsigned* const MISC = (volatile LAS unsigned*)(L + MISC_OFF);
    LAS float* const rstd_tab = (LAS float*)(L + RSTD_OFF);
    const int G = gridDim.x, bx = blockIdx.x, NGW = G * NWAVES, NGT = G * NWAVES * 64;
#define LANE_IDS() WS_BASE(); int tid = threadIdx.x; asm volatile("" : "+v"(tid)); const int lane = tid & 63, wave = __builtin_amdgcn_readfirstlane(tid >> 6); \
    const int gw = bx * NWAVES + wave; const int gt = bx * (NWAVES * 64) + tid; (void)lane; (void)gw; (void)gt
    gu32* const ctl = (gu32*)(args.ws + WS_CTL);
#define WS_BASE() __attribute__((address_space(1))) unsigned char* wsg_ = (__attribute__((address_space(1))) unsigned char*)args.ws; asm volatile("" : "+s"(wsg_)); unsigned char* wsb_ = (unsigned char*)wsg_;     \
    int bx = blockIdx.x; asm volatile("" : "+s"(bx))
#define WSP(T, off) ((T*)(wsb_ + (off)))
#define WGU WSP(bf16, WS_WGU)
#define WD WSP(bf16, WS_WD)
#define WIN WSP(bf16, WS_WIN)
#define WOUT WSP(bf16, WS_WOUT)
#define H WSP(float, WS_H)
#define HB WSP(bf16, WS_HB)
#define PART WSP(float, WS_PART)
#define DTRAW WSP(float, WS_DTRAW)
#define DT WSP(float, WS_DT)
#define ACT WSP(bf16, WS_ACT)
#define PROJ WSP(bf16, WS_PROJ)
#define MIXED WSP(bf16, WS_MIXED)
#define XT WSP(bf16, WS_XT)
#define WTG WSP(float, WS_XTS)
#define BC WSP(bf16, WS_BC)
#define BCT WSP(bf16, WS_BCT)
#define CC WSP(bf16, WS_CC)
#define PWT WSP(bf16, WS_PWT)
#define CS WSP(float, WS_CS)
#define ST WSP(float, WS_ST)
#define SIN WSP(bf16, WS_SIN)

    for (int u = threadIdx.x; u < (LDS_BYTES - LDSCTL_OFF) / 4; u += NWAVES * 64) ((LAS unsigned*)(L + LDSCTL_OFF))[u] = 0u;
    __syncthreads();
    const int lo = args.ph_lo, hi = args.ph_hi;
    XcdBarrier bar; bar.bar = (unsigned*)(ctl + CW_BAR); bar.x = 0; bar.st = nullptr;
    if (hi - lo > 1) bar = xcd_barrier_post((unsigned*)(ctl + CW_BAR), MISC + 8);
    int ps = 0;
#define PH_ON (ps >= lo && ps < hi)
#define PH_END do { if (PH_ON && ps + 1 < hi) xcd_barrier(bar); ++ps; } while (0)

#ifndef NO_PRO
    if (PH_ON) for (int rep_ = 0; rep_ < REP_PRO; ++rep_) { if (rep_) __syncthreads();
        LANE_IDS();
        for (int it = gw; it < TI_TOTAL; it += 2 * NGW) {
            TItem ta, tb; f32x4 va[8], vb[8], ga0, ga1, gb0, gb1;
            const bool two = (it + NGW < TI_TOTAL);
            titem_decode(it, lane, args.in, WGU, WD, WIN, WOUT, ta);
            titem_decode(two ? it + NGW : it, lane, args.in, WGU, WD, WIN, WOUT, tb);
            titem_load(ta, lane, va, ga0, ga1);
            titem_load(tb, lane, vb, gb0, gb1);
            titem_store(ta, lane, va, ga0, ga1);
            if (two) titem_store(tb, lane, vb, gb0, gb1);
        }
        for (int idx = gt; idx < 4 * 4 * 128 * 128; idx += NGT) { const int c = idx & 127, d = (idx >> 7) & 127, li = idx >> 14; PWT[idx] = (bf16)f2bf(args.in[7][((size_t)li * 128 + c) * 128 + d]); }
        for (int m = gw; m < M; m += NGW) {
            const GAS f32x4* xr = (const GAS f32x4*)(args.in[0] + (size_t)m * D) + lane;
            GAS unsigned long long* o8 = (GAS unsigned long long*)(HB + (size_t)m * D) + lane;
            float ss = 0.f;
            f32x4 xv[8];
#pragma unroll
            for (int j = 0; j < 8; ++j) xv[j] = xr[64 * j];
            __builtin_amdgcn_sched_barrier(0);
#pragma unroll
            for (int j = 0; j < 8; ++j) { const f32x4 v = xv[j]; const unsigned p0 = pk2(v.x, v.y), p1 = pk2(v.z, v.w);
                const float r0 = __builtin_bit_cast(float, p0 << 16), r1 = __builtin_bit_cast(float, p0 & 0xffff0000u), r2 = __builtin_bit_cast(float, p1 << 16), r3 = __builtin_bit_cast(float, p1 & 0xffff0000u);
                ss += (r0 * r0 + r1 * r1) + (r2 * r2 + r3 * r3);
                o8[64 * j] = (unsigned long long)p0 | ((unsigned long long)p1 << 32); }
            ss = wave_sum(ss, lane);
            if (lane < 32) PART[(size_t)m * 32 + lane] = (lane == 0) ? ss : 0.f;
        }
    }
#endif
    PH_END;

    for (int i = 0; i < 8; ++i) {
        const int l = i >> 1, second = i & 1;
#ifndef NO_UP
        if (PH_ON) for (int rep_ = 0; rep_ < REP_UP; ++rep_) { if (rep_) __syncthreads();
            LANE_IDS();
            pg8::StaticOrder S; S.init(M, NGU, G, bx); pg8::Unit u0; S.next(0, u0);
            pg8::Gemm g{HB, WGU + (size_t)i * WGU_STRIDE, M, NGU, D};
            pg8::EpiSwiGLU E{ACT, FF, rstd_tab};
            pg8::gemm_phase<pg8::EpiSwiGLU, pg8::StaticOrder, true, true, true>(L + RING_OFF, g, S, E, PART, rstd_tab, 1.0f / D, RMS_EPS);
            { int t_ = threadIdx.x; asm volatile("" : "+v"(t_)); mall_touch(WD + (size_t)i * WD_STRIDE, WD_STRIDE * 2, bx * NWAVES + (t_ >> 6), t_ & 63, NGW); }
        }
#endif
        PH_END;
#ifndef NO_DOWN
        if (PH_ON) {
            WS_BASE();
            pg8::StaticOrder S; S.init(M, D, G, bx);
            pg8::Gemm g{ACT, WD + (size_t)i * WD_STRIDE, M, D, FF};
            pg8::EpiResid E{HB, PART, 0.5f / REP_DOWN};
            pg8::gemm_phase<pg8::EpiResid, pg8::StaticOrder, true, true>(L + RING_OFF, g, S, E);
            { int t_ = threadIdx.x; asm volatile("" : "+v"(t_)); const int gw_ = bx * NWAVES + (t_ >> 6), ln_ = t_ & 63;
              if (!second) mall_touch(WIN + (size_t)l * WIN_STRIDE, (size_t)PROJ_LD * D * 2, gw_, ln_, NGW);
              else if (i < 7) mall_touch(WGU + (size_t)(i + 1) * WGU_STRIDE, WGU_STRIDE * 2, gw_, ln_, NGW); }
        }
#if REP_DOWN == 2
        if (PH_ON) {
            WS_BASE();
            pg8::StaticOrder S; S.init(M, D, G, bx);
            pg8::Gemm g{ACT, WD + (size_t)i * WD_STRIDE, M, D, FF};
            pg8::EpiResid E{HB, PART, 0.5f / REP_DOWN};
            pg8::gemm_phase<pg8::EpiResid, pg8::StaticOrder, true, true>(L + RING_OFF, g, S, E);
        }
#endif
#endif
        PH_END;
        if (second) continue;
#ifndef NO_WIN
        if (PH_ON) for (int rep_ = 0; rep_ < REP_WIN; ++rep_) { if (rep_) __syncthreads();
            LANE_IDS();
            pg8::StaticOrder S; S.init(M, PROJ_LD, G, bx); pg8::Unit u0; S.next(0, u0);
            pg8::Gemm g{HB, WIN + (size_t)l * WIN_STRIDE, M, PROJ_LD, D};
            pg8::EpiProj E{PROJ, DTRAW, rstd_tab};
            pg8::gemm_phase<pg8::EpiProj, pg8::StaticOrder, true, true, true>(L + RING_OFF, g, S, E, PART, rstd_tab, 1.0f / D, RMS_EPS);
            if (bx >= 128) {
                const int u = (bx - 128) * NWAVES + wave, rw0 = u * 16, lr = lane & 15, lq = lane >> 4;
                const bf16* Ap = HB + (size_t)(rw0 + lr) * D + lq * 8;
                const bf16* Bp = WIN + (size_t)l * WIN_STRIDE + (size_t)(PROJ_LD + lr) * D + lq * 8;
                float ssq; { const f32x4* pp = (const f32x4*)(PART + (size_t)(rw0 + lr) * 32 + lq * 8); const f32x4 a = pp[0], b = pp[1]; ssq = ((a.x + a.y) + (a.z + a.w)) + ((b.x + b.y) + (b.z + b.w)); }
                ssq += pg8::shx(ssq, lane, 16); ssq += pg8::shx(ssq, lane, 32);
                const float rsr = rsqrtf(ssq * (1.0f / D) + RMS_EPS);
                f32x4 dacc = {0.f, 0.f, 0.f, 0.f};
#pragma unroll 1
                for (int ks0 = 0; ks0 < D / 32; ks0 += 16) {
                    bf16x8 af[16], bfr[16];
#pragma unroll
                    for (int j = 0; j < 16; ++j) { af[j] = *(const bf16x8*)(Ap + (ks0 + j) * 32); bfr[j] = *(const bf16x8*)(Bp + (ks0 + j) * 32); }
                    __builtin_amdgcn_sched_barrier(0);
#pragma unroll
                    for (int j = 0; j < 16; ++j) dacc = __builtin_amdgcn_mfma_f32_16x16x32_bf16(af[j], bfr[j], dacc, 0, 0, 0);
                }
#pragma unroll
                for (int r = 0; r < 4; ++r) { const int row = lq * 4 + r; DTRAW[(size_t)(rw0 + row) * 16 + lr] = dacc[r] * pg8::shl_(rsr, row); }
            }
        }
#endif
        PH_END;
#ifndef NO_M1
        if (PH_ON) for (int rep_ = 0; rep_ < REP_MIX; ++rep_) { if (rep_) __syncthreads();
            LANE_IDS();
            {
                const int r32 = lane & 31, hi = lane >> 5;
                const float* pscale = args.in[8] + l * 512;
                LAS unsigned char* pst = L + RING_OFF + wave * 12288;
                for (int u = gw; u < (M / 32) * 4; u += NGW) {
                    const int gi = u & 3, r0 = (u >> 2) * 32, w = 2 << gi;
                    const int t = (r0 % SEQ) + r32, cnt = (t + 1 < w) ? t + 1 : w; const float inv = 1.0f / (float)cnt;
                    const int seq0 = r0 - (r0 % SEQ);
                    asm volatile("s_waitcnt lgkmcnt(0)" ::: "memory");
#pragma unroll
                    for (int i = 0; i < 12; ++i) { const int row = 4 * i + (lane >> 4), slot = lane & 15, chunk = slot ^ (row & 15);
                        int grow = r0 - 15 + row; grow = grow < seq0 ? seq0 : grow; grow = grow > r0 + 31 ? r0 + 31 : grow;
                        __builtin_amdgcn_global_load_lds((const unsigned*)(PROJ + (size_t)grow * PROJ_LD + P_POOL + gi * 128 + chunk * 8), (LAS unsigned*)(pst + i * 1024), 16, 0, 0); }
                    const bf16* wt = PWT + ((size_t)(l * 4 + gi) * 128 + r32) * 128 + hi * 8;
                    bf16x8 wa0 = *(const bf16x8*)(wt), wa1 = *(const bf16x8*)(wt + 32 * 128), wa2 = *(const bf16x8*)(wt + 64 * 128), wa3 = *(const bf16x8*)(wt + 96 * 128);
                    f32x16 acc0 = {}, acc1 = {}, acc2 = {}, acc3 = {};
                    asm volatile("s_waitcnt vmcnt(0)" ::: "memory");
#define POOL_RD(rr, c) (*(const LAS v4u*)(pst + (rr) * 256 + ((((c) ^ (rr)) & 15) << 4)))
#define POOL_ADD(j) do { const int rr_ = 15 + r32 - (j); const v4u r_ = POOL_RD(rr_, c_); const bool ok = ((j) < cnt); const unsigned rx = ok ? r_.x : 0u, ry = ok ? r_.y : 0u, rz = ok ? r_.z : 0u, rw = ok ? r_.w : 0u; \
                            sum[0] += __builtin_bit_cast(float, rx << 16); sum[1] += __builtin_bit_cast(float, rx & 0xffff0000u); sum[2] += __builtin_bit_cast(float, ry << 16); sum[3] += __builtin_bit_cast(float, ry & 0xffff0000u); \
                            sum[4] += __builtin_bit_cast(float, rz << 16); sum[5] += __builtin_bit_cast(float, rz & 0xffff0000u); sum[6] += __builtin_bit_cast(float, rw << 16); sum[7] += __builtin_bit_cast(float, rw & 0xffff0000u); } while (0)
#define POOL_KSTEPS(W) _Pragma("unroll 1") for (int ks = 0; ks < 8; ++ks) { \
                        const int c_ = 2 * ks + hi; const int kn_ = (ks < 7) ? ks + 1 : 7; \
                        const bf16x8 wn0 = *(const bf16x8*)(wt + kn_ * 16), wn1 = *(const bf16x8*)(wt + 32 * 128 + kn_ * 16), wn2 = *(const bf16x8*)(wt + 64 * 128 + kn_ * 16), wn3 = *(const bf16x8*)(wt + 96 * 128 + kn_ * 16);     asm volatile("" ::: "memory");     \
                        float sum[8], self[8]; \
                        { const v4u r0_ = POOL_RD(15 + r32, c_); \
                          self[0] = __builtin_bit_cast(float, r0_.x << 16); self[1] = __builtin_bit_cast(float, r0_.x & 0xffff0000u); self[2] = __builtin_bit_cast(float, r0_.y << 16); self[3] = __builtin_bit_cast(float, r0_.y & 0xffff0000u); \
                          self[4] = __builtin_bit_cast(float, r0_.z << 16); self[5] = __builtin_bit_cast(float, r0_.z & 0xffff0000u); self[6] = __builtin_bit_cast(float, r0_.w << 16); self[7] = __builtin_bit_cast(float, r0_.w & 0xffff0000u); } \
                        _Pragma("unroll") for (int e = 0; e < 8; ++e) sum[e] = self[e]; \
                        _Pragma("unroll 4") for (int j = 1; j < W; ++j) POOL_ADD(j); \
                        u32x4 q; q.x = cvtpk_s(sum[0] * inv - self[0], sum[1] * inv - self[1]); q.y = cvtpk_s(sum[2] * inv - self[2], sum[3] * inv - self[3]); \
                        q.z = cvtpk_s(sum[4] * inv - self[4], sum[5] * inv - self[5]); q.w = cvtpk_s(sum[6] * inv - self[6], sum[7] * inv - self[7]); \
                        const bf16x8 bfr = __builtin_bit_cast(bf16x8, q); \
                        acc0 = __builtin_amdgcn_mfma_f32_32x32x16_bf16(wa0, bfr, acc0, 0, 0, 0); acc1 = __builtin_amdgcn_mfma_f32_32x32x16_bf16(wa1, bfr, acc1, 0, 0, 0); \
                        acc2 = __builtin_amdgcn_mfma_f32_32x32x16_bf16(wa2, bfr, acc2, 0, 0, 0); acc3 = __builtin_amdgcn_mfma_f32_32x32x16_bf16(wa3, bfr, acc3, 0, 0, 0); \
                        wa0 = wn0; wa1 = wn1; wa2 = wn2; wa3 = wn3; }
                    if (gi == 0) { POOL_KSTEPS(2) } else if (gi == 1) { POOL_KSTEPS(4) } else if (gi == 2) { POOL_KSTEPS(8) } else { POOL_KSTEPS(16) }
#undef POOL_KSTEPS
#undef POOL_ADD
#undef POOL_RD
                    f32x4 psc[4][4];
                    { const float* sp_ = pscale + gi * 128 + 4 * hi;
#pragma unroll
                      for (int rq = 0; rq < 4; ++rq) { psc[rq][0] = *(const f32x4*)(sp_ + 8 * rq); psc[rq][1] = *(const f32x4*)(sp_ + 32 + 8 * rq); psc[rq][2] = *(const f32x4*)(sp_ + 64 + 8 * rq); psc[rq][3] = *(const f32x4*)(sp_ + 96 + 8 * rq); } }
                    __builtin_amdgcn_sched_barrier(0);
                    typedef unsigned u32x2 __attribute__((ext_vector_type(2)));
                    asm volatile("s_waitcnt lgkmcnt(0)" ::: "memory");
#pragma unroll
                    for (int rq = 0; rq < 4; ++rq) {
                        const f32x4 s0 = psc[rq][0], s1 = psc[rq][1], s2 = psc[rq][2], s3 = psc[rq][3];
                        u32x2 o; LAS unsigned char* tp_ = pst + r32 * 272 + rq * 16 + hi * 8;
                        o.x = pk2(acc0[4 * rq] * s0.x, acc0[4 * rq + 1] * s0.y); o.y = pk2(acc0[4 * rq + 2] * s0.z, acc0[4 * rq + 3] * s0.w); *(LAS u32x2*)(tp_) = o;
                        o.x = pk2(acc1[4 * rq] * s1.x, acc1[4 * rq + 1] * s1.y); o.y = pk2(acc1[4 * rq + 2] * s1.z, acc1[4 * rq + 3] * s1.w); *(LAS u32x2*)(tp_ + 64) = o;
                        o.x = pk2(acc2[4 * rq] * s2.x, acc2[4 * rq + 1] * s2.y); o.y = pk2(acc2[4 * rq + 2] * s2.z, acc2[4 * rq + 3] * s2.w); *(LAS u32x2*)(tp_ + 128) = o;
                        o.x = pk2(acc3[4 * rq] * s3.x, acc3[4 * rq + 1] * s3.y); o.y = pk2(acc3[4 * rq + 2] * s3.z, acc3[4 * rq + 3] * s3.w); *(LAS u32x2*)(tp_ + 192) = o;
                    }
                    bf16* op = MIXED + (size_t)(r0 + (lane >> 4)) * D + gi * 128 + (lane & 15) * 8;
#pragma unroll
                    for (int j = 0; j < 8; ++j) *(u32x4*)(op + (size_t)(4 * j) * D) = *(const LAS u32x4*)(pst + ((lane >> 4) + 4 * j) * 272 + (lane & 15) * 16);
                }
            }
            {
                const int r32 = lane & 31, hi = lane >> 5;
                LAS unsigned char* vst = L + RING_OFF + wave * 12288;
                const int wkey = lane >> 3, wcc = lane & 7, woff = (wcc >> 2) * 4096 + (wcc & 3) * 16 + wkey * 64;
                typedef short v4i16_t __attribute__((ext_vector_type(4)));
                LAS v4i16_t* vrd = (LAS v4i16_t*)(vst + ((lane >> 4) & 1) * 32 + (lane & 3) * 8 + (4 * hi + ((lane & 15) >> 2)) * 64);
                for (int ra_ = 0; ra_ < REP_ATT; ++ra_) for (int u = gw; u < 2 * 8 * 256; u += NGW) {
                    const int qt = u & 255, hh = (u >> 8) & 7, b = u >> 11, q0 = qt * 32;
                    const bf16* Pb = PROJ + (size_t)b * SEQ * PROJ_LD + hh * 64;
                    bf16x8 qf[4];
#pragma unroll
                    for (int d0 = 0; d0 < 4; ++d0) { const v4u raw = *(const v4u*)(Pb + (size_t)(q0 + r32) * PROJ_LD + P_Q + d0 * 16 + hi * 8); v4u sc;
                        sc.x = pk2(__builtin_bit_cast(float, raw.x << 16) * 0.125f, __builtin_bit_cast(float, raw.x & 0xffff0000u) * 0.125f); sc.y = pk2(__builtin_bit_cast(float, raw.y << 16) * 0.125f, __builtin_bit_cast(float, raw.y & 0xffff0000u) * 0.125f);
                        sc.z = pk2(__builtin_bit_cast(float, raw.z << 16) * 0.125f, __builtin_bit_cast(float, raw.z & 0xffff0000u) * 0.125f); sc.w = pk2(__builtin_bit_cast(float, raw.w << 16) * 0.125f, __builtin_bit_cast(float, raw.w & 0xffff0000u) * 0.125f);
                        qf[d0] = __builtin_bit_cast(bf16x8, sc); }
                    float carry = 0.f; f32x16 o0 = {}, o1 = {};
                    bf16x8 kn[8];
                    v4u vn[8];
#define ATT_LOAD(kt_) do { const bf16* Kb_ = Pb + (size_t)((kt_) * 64 + r32) * PROJ_LD + P_K + hi * 8; \
        _Pragma("unroll") for (int d0 = 0; d0 < 4; ++d0) { kn[2 * d0] = *(const bf16x8*)(Kb_ + d0 * 16); kn[2 * d0 + 1] = *(const bf16x8*)(Kb_ + (size_t)32 * PROJ_LD + d0 * 16); } \
        _Pragma("unroll") for (int i_ = 0; i_ < 8; ++i_) vn[i_] = *(const v4u*)(Pb + (size_t)((kt_) * 64 + wkey + 8 * i_) * PROJ_LD + P_V + wcc * 8); } while (0)
                    ATT_LOAD(q0 >> 6);
                    for (int kt = q0 >> 6; kt >= 0; --kt) {
                        bf16x8 kc[8]; v4u vc[8];
#pragma unroll
                        for (int i = 0; i < 8; ++i) { kc[i] = kn[i]; vc[i] = vn[i]; }
                        ATT_LOAD(kt > 0 ? kt - 1 : 0);
                        asm volatile("" ::: "memory");
                        f32x16 p0 = {}, p1 = {};
#pragma unroll
                        for (int d0 = 0; d0 < 4; ++d0) { p0 = __builtin_amdgcn_mfma_f32_32x32x16_bf16(kc[2 * d0], qf[d0], p0, 0, 0, 0); p1 = __builtin_amdgcn_mfma_f32_32x32x16_bf16(kc[2 * d0 + 1], qf[d0], p1, 0, 0, 0); }
#pragma unroll
                        for (int i = 0; i < 8; ++i) *(LAS v4u*)(vst + woff + (i >> 1) * 1024 + (i & 1) * 512) = vc[i];
                        const int lim = q0 + r32 - kt * 64;
                        float sp0[16], sp1[16];
#pragma unroll
                        for (int r = 0; r < 16; ++r) { const int kl = (r & 3) + 8 * (r >> 2) + 4 * hi;
                            const float z0 = p0[r], z1 = p1[r];
                            const float s0_ = fmaxf(z0, 0.f) + 0.6931471806f * __builtin_amdgcn_logf(1.0f + __builtin_amdgcn_exp2f(-1.4426950409f * fabsf(z0)));
                            const float s1_ = fmaxf(z1, 0.f) + 0.6931471806f * __builtin_amdgcn_logf(1.0f + __builtin_amdgcn_exp2f(-1.4426950409f * fabsf(z1)));
                            sp0[r] = (kl < lim) ? s0_ : 0.f; sp1[r] = (kl + 32 < lim) ? s1_ : 0.f; }
                        float PS[9], PSp[9];
                        PS[8] = 0.f; PSp[8] = 0.f;
#pragma unroll
                        for (int idx = 7; idx >= 0; --idx) { const int rq = idx & 3; const float gsum = (idx < 4) ? (sp0[4 * rq] + sp0[4 * rq + 1]) + (sp0[4 * rq + 2] + sp0[4 * rq + 3]) : (sp1[4 * rq] + sp1[4 * rq + 1]) + (sp1[4 * rq + 2] + sp1[4 * rq + 3]);
                            PS[idx] = PS[idx + 1] + gsum; }
#pragma unroll
                        for (int idx = 0; idx < 8; ++idx) PSp[idx] = pg8::shx(PS[idx], lane, 32);
#pragma unroll
                        for (int idx = 0; idx < 8; ++idx) { const int rq = idx & 3;
                            float run = carry + PS[idx + 1] + (hi ? PSp[idx + 1] : PSp[idx]);
#pragma unroll
                            for (int e = 3; e >= 0; --e) { const int r = 4 * rq + e, kl = e + 8 * rq + 4 * hi + ((idx < 4) ? 0 : 32);
                                if (idx < 4) { run += sp0[r]; const float w = __builtin_amdgcn_exp2f(1.4426950409f * (p0[r] - run)); p0[r] = (kl < lim) ? w : 0.f; }
                                else         { run += sp1[r]; const float w = __builtin_amdgcn_exp2f(1.4426950409f * (p1[r] - run)); p1[r] = (kl < lim) ? w : 0.f; } } }
                        carry += PS[0] + PSp[0];
                        u32x4 a0, a1, a2, a3;
                        a0.x = cvtpk_s(p0[0], p0[1]); a0.y = cvtpk_s(p0[2], p0[3]); a0.z = cvtpk_s(p0[4], p0[5]); a0.w = cvtpk_s(p0[6], p0[7]);
                        a1.x = cvtpk_s(p0[8], p0[9]); a1.y = cvtpk_s(p0[10], p0[11]); a1.z = cvtpk_s(p0[12], p0[13]); a1.w = cvtpk_s(p0[14], p0[15]);
                        a2.x = cvtpk_s(p1[0], p1[1]); a2.y = cvtpk_s(p1[2], p1[3]); a2.z = cvtpk_s(p1[4], p1[5]); a2.w = cvtpk_s(p1[6], p1[7]);
                        a3.x = cvtpk_s(p1[8], p1[9]); a3.y = cvtpk_s(p1[10], p1[11]); a3.z = cvtpk_s(p1[12], p1[13]); a3.w = cvtpk_s(p1[14], p1[15]);
                        const bf16x8 pa[4] = {__builtin_bit_cast(bf16x8, a0), __builtin_bit_cast(bf16x8, a1), __builtin_bit_cast(bf16x8, a2), __builtin_bit_cast(bf16x8, a3)};
#pragma unroll
                        for (int ks = 0; ks < 4; ++ks) {
                            const v4i16_t l0 = __builtin_amdgcn_ds_read_tr16_b64_v4i16(vrd + (ks * 1024) / 8), h0 = __builtin_amdgcn_ds_read_tr16_b64_v4i16(vrd + (ks * 1024 + 512) / 8);
                            const v4i16_t l1 = __builtin_amdgcn_ds_read_tr16_b64_v4i16(vrd + (4096 + ks * 1024) / 8), h1 = __builtin_amdgcn_ds_read_tr16_b64_v4i16(vrd + (4096 + ks * 1024 + 512) / 8);
                            const bf16x8 v0 = (bf16x8){l0[0], l0[1], l0[2], l0[3], h0[0], h0[1], h0[2], h0[3]}, v1 = (bf16x8){l1[0], l1[1], l1[2], l1[3], h1[0], h1[1], h1[2], h1[3]};
                            o0 = __builtin_amdgcn_mfma_f32_32x32x16_bf16(v0, pa[ks], o0, 0, 0, 0); o1 = __builtin_amdgcn_mfma_f32_32x32x16_bf16(v1, pa[ks], o1, 0, 0, 0);
                        }
                        if (__all(carry >= 88.f)) break;
                    }
#undef ATT_LOAD
                    typedef unsigned u32x2a __attribute__((ext_vector_type(2)));
#pragma unroll
                    for (int rq = 0; rq < 4; ++rq) { u32x2a w0, w1;
                        w0.x = pk2(o0[4 * rq], o0[4 * rq + 1]); w0.y = pk2(o0[4 * rq + 2], o0[4 * rq + 3]); w1.x = pk2(o1[4 * rq], o1[4 * rq + 1]); w1.y = pk2(o1[4 * rq + 2], o1[4 * rq + 3]);
                        *(LAS u32x2a*)(vst + r32 * 144 + rq * 16 + hi * 8) = w0; *(LAS u32x2a*)(vst + r32 * 144 + 64 + rq * 16 + hi * 8) = w1; }
                    bf16* Ob = MIXED + ((size_t)b * SEQ + q0 + (lane >> 3)) * D + 1536 + hh * 64 + (lane & 7) * 8;
#pragma unroll
                    for (int j = 0; j < 4; ++j) *(u32x4*)(Ob + (size_t)(8 * j) * D) = *(const LAS u32x4*)(vst + ((lane >> 3) + 8 * j) * 144 + (lane & 7) * 16);
                    asm volatile("s_waitcnt lgkmcnt(0)" ::: "memory");
                }
            }
            asm volatile("s_waitcnt lgkmcnt(0)\n\ts_barrier" ::: "memory");
            {
                const float* cw = args.in[9] + (size_t)l * 4 * 1536; const float* cb = args.in[10] + l * 1536; const float* dtb = args.in[11] + l * 16; const float* alog = args.in[12] + l * 16;
                { const int u = bx;
                    const int qt = u & 3, bc = u >> 2, r0 = bc * 256;
                    LAS unsigned char* img0 = L + RING_OFF + 16384;
                    const int tpos0 = r0 % SEQ;
#define S0_DMA(q_) do { LAS unsigned char* ib_ = img0 + ((q_) & 1) * 52224; \
        for (int i_ = wave; i_ < 51; i_ += NWAVES) { const int o_ = i_ * 1024 + lane * 16; int row_ = o_ / 768; const int col_ = o_ - row_ * 768; row_ = row_ > 66 ? 66 : row_; \
            int rel_ = 64 * (q_) - 3 + row_; rel_ = (tpos0 + rel_ < 0) ? 0 : rel_;                   \
            __builtin_amdgcn_global_load_lds((const unsigned*)(PROJ + (size_t)(r0 + rel_) * PROJ_LD + P_XBC + qt * 384 + (col_ >> 1)), (LAS unsigned*)(ib_ + i_ * 1024), 16, 0, 0); } } while (0)
                    S0_DMA(0);
                    if (qt == 0) { const int h = tid >> 5, seg = tid & 31; const float A = -__expf(alog[h]), bias = dtb[h];
                      float dtv[8], cs[8]; float run = 0.f;
#pragma unroll
                      for (int k = 0; k < 8; ++k) dtv[k] = DTRAW[(size_t)(r0 + seg * 8 + k) * 16 + h];
                      __builtin_amdgcn_sched_barrier(0);
#pragma unroll
                      for (int k = 0; k < 8; ++k) { dtv[k] = softplus_f(dtv[k] + bias); run += A * dtv[k]; cs[k] = run; }
                      float incl = run;
#pragma unroll
                      for (int d = 1; d < 32; d <<= 1) { const float v = pg8::shl_(incl, (seg >= d) ? lane - d : lane); if (seg >= d) incl += v; }
                      const float excl = incl - run, total = pg8::shl_(incl, lane | 31);
#pragma unroll
                      for (int k = 0; k < 8; ++k) { const float c_ = excl + cs[k]; WTG[(size_t)(bc * 16 + h) * 256 + seg * 8 + k] = dtv[k] * __expf(total - c_); CS[(size_t)(r0 + seg * 8 + k) * 16 + h] = c_; DT[(size_t)(r0 + seg * 8 + k) * 16 + h] = dtv[k]; } }
                    const int rsq = tid & 7, cgl = tid >> 3;
                    const int cg = qt * 48 + cgl, ch0 = cg * 8;
                    float cwr[4][8], cbr[8];
#pragma unroll
                    for (int e = 0; e < 8; ++e) { cwr[0][e] = cw[0 * 1536 + ch0 + e]; cwr[1][e] = cw[1 * 1536 + ch0 + e]; cwr[2][e] = cw[2 * 1536 + ch0 + e]; cwr[3][e] = cw[3 * 1536 + ch0 + e]; cbr[e] = cb[ch0 + e]; }
                    asm volatile("s_waitcnt vmcnt(0)" ::: "memory");
                    __syncthreads();
                    for (int q = 0; q < 4; ++q) {
                        if (q < 3) S0_DMA(q + 1);
                        if (tid < 384) {
                        const int s0 = 64 * q + rsq * 8;
                        const int t0 = tpos0 + s0;
                        const LAS unsigned char* ip = img0 + (q & 1) * 52224 + (rsq * 8) * 768 + cgl * 16;
                        float xin[11][8];
#pragma unroll
                        for (int k = 0; k < 11; ++k) { const bool ok = (t0 - 3 + k >= 0); v4u raw = *(const LAS v4u*)(ip + k * 768);
                            raw.x = ok ? raw.x : 0u; raw.y = ok ? raw.y : 0u; raw.z = ok ? raw.z : 0u; raw.w = ok ? raw.w : 0u;
                            xin[k][0] = __builtin_bit_cast(float, raw.x << 16); xin[k][1] = __builtin_bit_cast(float, raw.x & 0xffff0000u); xin[k][2] = __builtin_bit_cast(float, raw.y << 16); xin[k][3] = __builtin_bit_cast(float, raw.y & 0xffff0000u);
                            xin[k][4] = __builtin_bit_cast(float, raw.z << 16); xin[k][5] = __builtin_bit_cast(float, raw.z & 0xffff0000u); xin[k][6] = __builtin_bit_cast(float, raw.w << 16); xin[k][7] = __builtin_bit_cast(float, raw.w & 0xffff0000u); }
                        float o[8][8];
#pragma unroll
                        for (int e = 0; e < 8; ++e) { const float w0 = cwr[0][e], w1 = cwr[1][e], w2 = cwr[2][e], w3 = cwr[3][e], bb = cbr[e];
#pragma unroll
                            for (int j = 0; j < 8; ++j) o[j][e] = silu_f(bb + w0 * xin[j][e] + w1 * xin[j + 1][e] + w2 * xin[j + 2][e] + w3 * xin[j + 3][e]); }
#define S0_SWAP(a_) do { const bool odd_ = rsq & 1; const unsigned s0_ = odd_ ? a_.x : a_.z, s1_ = odd_ ? a_.y : a_.w; \
        const unsigned r0_ = (unsigned)__builtin_amdgcn_update_dpp(0, (int)s0_, 0xB1, 0xF, 0xF, true), r1_ = (unsigned)__builtin_amdgcn_update_dpp(0, (int)s1_, 0xB1, 0xF, 0xF, true); \
        a_ = odd_ ? (v4u){r0_, r1_, a_.z, a_.w} : (v4u){a_.x, a_.y, r0_, r1_}; } while (0)
                        if (cg < 128) {
                            const int h = cg >> 3, p0 = (cg & 7) * 8;
                            const size_t base = (size_t)(bc * 16 + h) * 16384 + (size_t)((((2 * q + (rsq >> 2)) * 4 + (p0 >> 5) * 2 + ((rsq >> 1) & 1)) * 64 + (rsq & 1) * 32 + (p0 & 31)) * 8);
#pragma unroll
                            for (int e = 0; e < 8; ++e) {
                                v4u a; a.x = pk2(o[0][e], o[1][e]); a.y = pk2(o[2][e], o[3][e]); a.z = pk2(o[4][e], o[5][e]); a.w = pk2(o[6][e], o[7][e]);
                                S0_SWAP(a);
                                *(v4u*)(XT + base + (size_t)e * 8) = a; }
                        } else if (cg < 160) {
                            const int gi = (cg - 128) >> 4, n0 = ((cg - 128) & 15) * 8;
#pragma unroll
                            for (int j = 0; j < 8; ++j) { v4u a; a.x = pk2(o[j][0], o[j][1]); a.y = pk2(o[j][2], o[j][3]); a.z = pk2(o[j][4], o[j][5]); a.w = pk2(o[j][6], o[j][7]);
                                *(v4u*)(BC + (size_t)(r0 + s0 + j) * 256 + gi * 128 + n0) = a; }
                            const size_t base = (size_t)(bc * 2 + gi) * 32768 + (size_t)(((((4 * q + (rsq >> 1)) * 4 + (n0 >> 5)) * 2 + (rsq & 1)) * 32 + (n0 & 31)) * 8);
#pragma unroll
                            for (int e = 0; e < 8; ++e) { v4u a; a.x = pk2(o[0][e], o[1][e]); a.y = pk2(o[2][e], o[3][e]); a.z = pk2(o[4][e], o[5][e]); a.w = pk2(o[6][e], o[7][e]);
                                S0_SWAP(a);
                                *(v4u*)(BCT + base + (size_t)e * 8) = a; }
                        } else {
                            const int gi = (cg - 160) >> 4, n0 = ((cg - 160) & 15) * 8;
#pragma unroll
                            for (int j = 0; j < 8; ++j) { v4u a; a.x = pk2(o[j][0], o[j][1]); a.y = pk2(o[j][2], o[j][3]); a.z = pk2(o[j][4], o[j][5]); a.w = pk2(o[j][6], o[j][7]);
                                *(v4u*)(CC + (size_t)(r0 + s0 + j) * 256 + gi * 128 + n0) = a; }
                        }
                        }
                        if (q < 3) {
                            const int nst = __builtin_amdgcn_readfirstlane((tid < 384) ? ((cg >= 128 && cg < 160) ? 16 : 8) : 0);
                            if (nst == 16) asm volatile("s_waitcnt vmcnt(16)" ::: "memory"); else if (nst == 8) asm volatile("s_waitcnt vmcnt(8)" ::: "memory"); else asm volatile("s_waitcnt vmcnt(0)" ::: "memory");
                        }
                        __syncthreads();
                    }
#undef S0_DMA
#undef S0_SWAP
                }
            }
        }
        PH_END;
#endif
#ifndef NO_M2
        if (PH_ON) for (int rep_ = 0; rep_ < REP_S1; ++rep_) { if (rep_) __syncthreads();
            LANE_IDS();
            const int r32 = lane & 31, hi = lane >> 5;
            for (int u = gw; u < 2 * 32 * 16 * 2; u += NGW) {
                const int nh = u & 1, h = (u >> 1) & 15, bc = u >> 5, g = h >> 3;
                const bf16* Ab = XT + (size_t)(bc * 16 + h) * 16384 + lane * 8;
                const float* Wb = WTG + (size_t)(bc * 16 + h) * 256 + hi * 4;
                const bf16* Bb = BCT + (size_t)(bc * 2 + g) * 32768 + (size_t)(nh * 2 * 64 * 8) + lane * 8;
                f32x16 acc00 = {}, acc01 = {}, acc10 = {}, acc11 = {};
#pragma unroll 1
                for (int kb = 0; kb < 16; kb += 4) {
                    f32x4 wl[4], wh[4]; v4u ar0[4], ar1[4]; bf16x8 b0[4], b1[4];
#pragma unroll
                    for (int j = 0; j < 4; ++j) { const int ks = kb + j;
                        wl[j] = *(const f32x4*)(Wb + ks * 16); wh[j] = *(const f32x4*)(Wb + ks * 16 + 8);
                        const bf16* ap_ = Ab + (((ks >> 1) * 4 + (ks & 1)) * 64) * 8;
                        ar0[j] = *(const v4u*)(ap_); ar1[j] = *(const v4u*)(ap_ + 2 * 64 * 8);
                        b0[j] = *(const bf16x8*)(Bb + (ks * 4) * 64 * 8); b1[j] = *(const bf16x8*)(Bb + (ks * 4 + 1) * 64 * 8); }
                    __builtin_amdgcn_sched_barrier(0);
#pragma unroll
                    for (int j = 0; j < 4; ++j) {
                        const bf16x8 a0 = scale_frag(ar0[j], wl[j], wh[j]), a1 = scale_frag(ar1[j], wl[j], wh[j]);
                        acc00 = __builtin_amdgcn_mfma_f32_32x32x16_bf16(a0, b0[j], acc00, 0, 0, 0); acc01 = __builtin_amdgcn_mfma_f32_32x32x16_bf16(a0, b1[j], acc01, 0, 0, 0);
                        acc10 = __builtin_amdgcn_mfma_f32_32x32x16_bf16(a1, b0[j], acc10, 0, 0, 0); acc11 = __builtin_amdgcn_mfma_f32_32x32x16_bf16(a1, b1[j], acc11, 0, 0, 0);
                    }
                }
                float* Sb = ST + (size_t)(bc * 16 + h) * 8192 + nh * 64 + r32;
#pragma unroll
                for (int r = 0; r < 16; ++r) { const int p = (r & 3) + 8 * (r >> 2) + 4 * hi;
                    Sb[(size_t)p * 128] = acc00[r]; Sb[(size_t)p * 128 + 32] = acc01[r]; Sb[(size_t)(p + 32) * 128] = acc10[r]; Sb[(size_t)(p + 32) * 128 + 32] = acc11[r]; }
            }
        }
        PH_END;
        if (PH_ON) for (int rep_ = 0; rep_ < REP_S2; ++rep_) { if (rep_) __syncthreads();
            LANE_IDS();
            for (int id = gt; id < 2 * 16 * 64 * 64; id += NGT) {
                const int n = ((id >> 6) & 7) * 16 + ((id >> 5) & 1) * 8 + (id & 3) * 2, p = ((id >> 9) & 7) * 8 + ((id >> 2) & 7), h = (id >> 12) & 15, b = id >> 16;
                const int so = ((((p >> 5) * 8 + (n >> 4)) * 2 + ((n >> 3) & 1)) * 32 + (p & 31)) * 8 + (n & 7);
                float c0 = 0.f, c1 = 0.f;
#pragma unroll 1
                for (int cb = 0; cb < 32; cb += 16) {
                    float2 st[16]; float dl[16];
#pragma unroll
                    for (int j = 0; j < 16; ++j) { const int c = cb + j; st[j] = *(const float2*)(ST + (size_t)((b * 32 + c) * 16 + h) * 8192 + p * 128 + n); dl[j] = CS[(size_t)(b * SEQ + c * 256 + 255) * 16 + h]; }
                    __builtin_amdgcn_sched_barrier(0);
#pragma unroll
                    for (int j = 0; j < 16; ++j) { const int c = cb + j;
                        *(unsigned*)(SIN + (size_t)((b * 32 + c) * 16 + h) * 8192 + so) = pk2(c0, c1);
                        const float dec = __expf(dl[j]);
                        c0 = c0 * dec + st[j].x; c1 = c1 * dec + st[j].y; }
                }
            }
        }
        PH_END;
        if (PH_ON) for (int rep_ = 0; rep_ < REP_S3; ++rep_) { if (rep_) __syncthreads();
            LANE_IDS();
            const int r32 = lane & 31, hi = lane >> 5;
            LAS unsigned char* CBl = L + RING_OFF;
            LAS unsigned char* Cl = L + RING_OFF + 73728;
            LAS float* wcs = (LAS float*)(L + RING_OFF + 108544) + wave * 512;
            LAS float* ssb = (LAS float*)(L + RING_OFF + 124928);
            unsigned char* hpark = WSP(unsigned char, WS_Y) + ((size_t)bx * 8 + wave) * 8192;
            LAS float* ssb2 = (LAS float*)(L + RSTD_OFF + 8192);
            LAS float* wG = (LAS float*)(L + RSTD_OFF) + wave * 256;
            static_assert(RSTD_OFF + 8 * 1024 + 4096 <= LDS_BYTES && 108544 + 16384 <= 124928 && 124928 + 4096 <= RING_BYTES && 73728 + 128 * 272 <= 108544 && 18 * 4096 <= 73728 && 256 * 272 <= 73728, "S3 LDS map");
            const float* ng = args.in[14] + l * 1024;
            typedef unsigned u32x2 __attribute__((ext_vector_type(2)));
            if (bx < 256) { const int u = bx;
                const int parity = u & 1, g = (u >> 1) & 1, bc = u >> 2, h = g * 8 + wave, r0 = bc * 256;
                const float Dk = args.in[13][l * 16 + h];
                const int jt0 = parity, jt1 = 3 - parity, jt2 = 4 + parity, jt3 = 7 - parity;
                const int of1 = jt0 + 1, of2 = of1 + jt1 + 1, of3 = of2 + jt2 + 1;
                {
                    const bf16* bsrc = BC + (size_t)(r0 + (tid >> 4)) * 256 + g * 128 + (tid & 15) * 8;
                    LAS unsigned char* bdst = CBl + (tid >> 4) * 272 + (tid & 15) * 16;
                    v4u tb[8], tc[4]; float c_[4], d_[4], ce_[4];
#pragma unroll
                    for (int i = 0; i < 8; ++i) tb[i] = *(const v4u*)(bsrc + (size_t)i * 32 * 256);
#pragma unroll
                    for (int i = 0; i < 4; ++i) { const int jt_ = 4 * (i >> 1) + ((i & 1) ? 3 - parity : parity);
                        tc[i] = *(const v4u*)(CC + (size_t)(r0 + 32 * jt_ + (tid >> 4)) * 256 + g * 128 + (tid & 15) * 8); }
#pragma unroll
                    for (int i = 0; i < 4; ++i) { const int s_ = lane + 64 * i; c_[i] = CS[(size_t)(r0 + s_) * 16 + h]; d_[i] = DT[(size_t)(r0 + s_) * 16 + h]; ce_[i] = CS[(size_t)(r0 + (s_ | 31)) * 16 + h]; }
#pragma unroll
                    for (int i = 0; i < 8; ++i) *(LAS v4u*)(bdst + i * 32 * 272) = tb[i];
#pragma unroll
                    for (int i = 0; i < 4; ++i) *(LAS v4u*)(Cl + (32 * i + (tid >> 4)) * 272 + (tid & 15) * 16) = tc[i];
#pragma unroll
                    for (int i = 0; i < 4; ++i) { const int s_ = lane + 64 * i; wcs[s_] = c_[i]; wcs[256 + s_] = d_[i]; wG[s_] = __expf(ce_[i] - c_[i]) * d_[i]; }
                }
                const bf16* XTh = XT + (size_t)(bc * 16 + h) * 16384 + lane * 8;
                const bf16* SINh = SIN + (size_t)(bc * 16 + h) * 8192 + lane * 8;
                bf16x8 sa[8];
#define SLOAD(base_) do { _Pragma("unroll") for (int ks = 0; ks < 8; ++ks) sa[ks] = *(const GAS bf16x8*)((base_) + ks * 512); } while (0)
                SLOAD((const GAS bf16*)SINh);
                __syncthreads();
                {
                    f32x16 cb0 = {}, cb1 = {}, cb2 = {};
#define S3_CB(dst, t_) do { const int t__ = (t_); if (t__ < 18) { const int k__ = (t__ >= of1) + (t__ >= of2) + (t__ >= of3); const int i__ = t__ - (k__ == 0 ? 0 : k__ == 1 ? of1 : k__ == 2 ? of2 : of3); \
        const LAS unsigned char* bp_ = CBl + (32 * i__ + r32) * 272 + hi * 16; const LAS unsigned char* cp_ = Cl + (32 * k__ + r32) * 272 + hi * 16; \
        _Pragma("unroll") for (int ks = 0; ks < 8; ++ks) dst = __builtin_amdgcn_mfma_f32_32x32x16_bf16(*(const LAS bf16x8*)(bp_ + ks * 32), *(const LAS bf16x8*)(cp_ + ks * 32), dst, 0, 0, 0); } } while (0)
                    S3_CB(cb0, wave); S3_CB(cb1, wave + 8); S3_CB(cb2, wave + 16);
#undef S3_CB
                    __syncthreads();
#define S3_CBW(src, t_) do { const int t__ = (t_); if (t__ < 18) { LAS unsigned char* wp_ = CBl + t__ * 4096 + lane * 16; \
        *(LAS f32x4*)(wp_) = (f32x4){src[0], src[1], src[2], src[3]}; *(LAS f32x4*)(wp_ + 1024) = (f32x4){src[4], src[5], src[6], src[7]}; \
        *(LAS f32x4*)(wp_ + 2048) = (f32x4){src[8], src[9], src[10], src[11]}; *(LAS f32x4*)(wp_ + 3072) = (f32x4){src[12], src[13], src[14], src[15]}; } } while (0)
                    S3_CBW(cb0, wave); S3_CBW(cb1, wave + 8); S3_CBW(cb2, wave + 16);
#undef S3_CBW
                }
#define XLOAD(dst, i_, pt_) do { const GAS bf16* xb_ = XTp + (i_) * 2048; dst[0] = *(const GAS u32x4*)(xb_); dst[1] = *(const GAS u32x4*)(xb_ + 512); } while (0)
#define ZLOAD(jt_, pt_) do { const bf16* zp = PROJ + ((size_t)r0 + 32 * (jt_) + r32) * PROJ_LD + P_Z + h * 64 + (pt_) * 32 + 4 * hi; \
        _Pragma("unroll") for (int rq = 0; rq < 4; ++rq) zr[rq] = *(const u32x2*)(zp + 8 * rq); } while (0)
#pragma unroll 1
                for (int pt = 0; pt < 2; ++pt) {
                    int lane_ = lane; asm volatile("" : "+v"(lane_));
                    const int r32 = lane_ & 31, hi = lane_ >> 5, lane = lane_;
                    u32x4 xc[2], xn[2];
                    const GAS bf16* XTp = (const GAS bf16*)(XTh + pt * 1024); asm volatile("" : "+v"(XTp));
                    const GAS bf16* SINp = (const GAS bf16*)(SINh + 4096); asm volatile("" : "+v"(SINp));
                    XLOAD(xc, 0, pt);
                    asm volatile("" ::: "memory");
                    f32x16 o[4];
#pragma unroll
                    for (int k = 0; k < 4; ++k) {
                        const LAS unsigned char* cfp = Cl + (k * 32 + r32) * 272 + hi * 16;
                        f32x16 a0 = {};
#pragma unroll
                        for (int ks = 0; ks < 8; ++ks) a0 = __builtin_amdgcn_mfma_f32_32x32x16_bf16(sa[ks], *(const LAS bf16x8*)(cfp + ks * 32), a0, 0, 0, 0);
                        const float e = __expf(wcs[32 * ((k == 0) ? jt0 : (k == 1) ? jt1 : (k == 2) ? jt2 : jt3) + r32]);
#pragma unroll
                        for (int r = 0; r < 16; ++r) a0[r] *= e;
                        o[k] = a0;
                    }
                    if (pt == 0) __syncthreads();
                    u32x2 zr[4];
#pragma unroll
                    for (int i = 0; i < 8; ++i) {
                        const int kd = i >> 1, jtd = (kd == 0) ? jt0 : (kd == 1) ? jt1 : (kd == 2) ? jt2 : jt3;
                        if (i < 7 || jt3 == 7) {
                            if ((i & 1) == 0) { ZLOAD(jtd, pt); }
                            if (i < 7) { XLOAD(xn, i + 1, pt); }
                            if (i == 6 && pt == 0) { SLOAD(SINp); }
                            asm volatile("" ::: "memory");
                            const float cse = wcs[32 * i + 31];
#pragma unroll
                            for (int k = 0; k < 4; ++k) if (k >= kd) {
                                const bool dk_ = (k == kd);
                                const int jt = (k == 0) ? jt0 : (k == 1) ? jt1 : (k == 2) ? jt2 : jt3, ofk = (k == 0) ? 0 : (k == 1) ? of1 : (k == 2) ? of2 : of3;
                                if (!dk_ || i <= jt) {
                                    f32x16 mt; const float csl_ = wcs[32 * jt + r32];
                                    { const LAS unsigned char* rp_ = CBl + (ofk + i) * 4096 + lane * 16;
                                      const f32x4 m0 = *(const LAS f32x4*)(rp_), m1 = *(const LAS f32x4*)(rp_ + 1024), m2 = *(const LAS f32x4*)(rp_ + 2048), m3 = *(const LAS f32x4*)(rp_ + 3072);
                                      mt[0] = m0.x; mt[1] = m0.y; mt[2] = m0.z; mt[3] = m0.w; mt[4] = m1.x; mt[5] = m1.y; mt[6] = m1.z; mt[7] = m1.w;
                                      mt[8] = m2.x; mt[9] = m2.y; mt[10] = m2.z; mt[11] = m2.w; mt[12] = m3.x; mt[13] = m3.y; mt[14] = m3.z; mt[15] = m3.w; }
                                    if (!dk_ || i < jt) {
                                        const float El = __expf(csl_ - cse);
#pragma unroll
                                        for (int r = 0; r < 16; ++r) mt[r] *= El * wG[32 * i + (r & 3) + 8 * (r >> 2) + 4 * hi];
                                    } else {
                                        const int l_loc = 32 * jt + r32;
#pragma unroll
                                        for (int r = 0; r < 16; ++r) { const int s_loc = 32 * i + (r & 3) + 8 * (r >> 2) + 4 * hi;
                                            const float f = __expf(csl_ - wcs[s_loc]) * wcs[256 + s_loc];
                                            float v = mt[r] * f;
                                            v = (s_loc > l_loc) ? 0.f : v; v += (s_loc == l_loc) ? Dk : 0.f;
                                            mt[r] = v; }
                                    }
                                    u32x4 q0, q1;
                                    q0.x = cvtpk_s(mt[0], mt[1]); q0.y = cvtpk_s(mt[2], mt[3]); q0.z = cvtpk_s(mt[4], mt[5]); q0.w = cvtpk_s(mt[6], mt[7]);
                                    q1.x = cvtpk_s(mt[8], mt[9]); q1.y = cvtpk_s(mt[10], mt[11]); q1.z = cvtpk_s(mt[12], mt[13]); q1.w = cvtpk_s(mt[14], mt[15]);
                                    o[k] = __builtin_amdgcn_mfma_f32_32x32x16_bf16(__builtin_bit_cast(bf16x8, xc[0]), __builtin_bit_cast(bf16x8, q0), o[k], 0, 0, 0);
                                    o[k] = __builtin_amdgcn_mfma_f32_32x32x16_bf16(__builtin_bit_cast(bf16x8, xc[1]), __builtin_bit_cast(bf16x8, q1), o[k], 0, 0, 0);
                                }
                            }
                            if (i == jtd) {
                                float ss = 0.f;
#pragma unroll
                                for (int rq = 0; rq < 4; ++rq) {
                                    const u32x2 z0 = zr[rq];
                                    const float za[4] = {__builtin_bit_cast(float, z0.x << 16), __builtin_bit_cast(float, z0.x & 0xffff0000u), __builtin_bit_cast(float, z0.y << 16), __builtin_bit_cast(float, z0.y & 0xffff0000u)};
#pragma unroll
                                    for (int e = 0; e < 4; ++e) { o[kd][4 * rq + e] *= silu_f(za[e]); ss += o[kd][4 * rq + e] * o[kd][4 * rq + e]; }
                                }
                                ss += pg8::shx(ss, lane, 32);
                                if (hi == 0) (pt == 0 ? ssb : ssb2)[kd * 256 + wave * 32 + r32] = ss;
                                if (pt == 0) {
                                    u32x4 h0, h1;
                                    h0.x = pk2(o[kd][0], o[kd][1]); h0.y = pk2(o[kd][2], o[kd][3]); h0.z = pk2(o[kd][4], o[kd][5]); h0.w = pk2(o[kd][6], o[kd][7]);
                                    h1.x = pk2(o[kd][8], o[kd][9]); h1.y = pk2(o[kd][10], o[kd][11]); h1.z = pk2(o[kd][12], o[kd][13]); h1.w = pk2(o[kd][14], o[kd][15]);
                                    *(u32x4*)(hpark + kd * 2048 + lane * 16) = h0; *(u32x4*)(hpark + kd * 2048 + 1024 + lane * 16) = h1; }
                            }
                            xc[0] = xn[0]; xc[1] = xn[1];
                        }
                    }
                    if (pt == 1) {
                        const float* ngp = ng + h * 64 + 4 * hi;
                        f32x4 gq0[4], gq1[4];
#pragma unroll
                        for (int rq = 0; rq < 4; ++rq) { gq0[rq] = *(const f32x4*)(ngp + 8 * rq); gq1[rq] = *(const f32x4*)(ngp + 32 + 8 * rq); }
                        u32x4 hv[4][2];
#pragma unroll
                        for (int k = 0; k < 4; ++k) { hv[k][0] = *(const u32x4*)(hpark + k * 2048 + lane * 16); hv[k][1] = *(const u32x4*)(hpark + k * 2048 + 1024 + lane * 16); }
                        __syncthreads();
                        LAS unsigned char* tb_ = CBl + wave * 4608;
#pragma unroll
                        for (int k = 0; k < 4; ++k) {
                            const int jt = (k == 0) ? jt0 : (k == 1) ? jt1 : (k == 2) ? jt2 : jt3;
                            float tot = 0.f;
#pragma unroll
                            for (int w = 0; w < 8; ++w) tot += ssb[k * 256 + w * 32 + r32] + ssb2[k * 256 + w * 32 + r32];
                            const float rs = rsqrtf(tot * (1.0f / 512.0f) + RMS_EPS);
#pragma unroll
                            for (int rq = 0; rq < 4; ++rq) {
                                const f32x4 g0 = gq0[rq], g1 = gq1[rq];
                                u32x2 w0, w1;
                                const u32x4 hq = hv[k][rq >> 1]; const unsigned ha = (rq & 1) ? hq.z : hq.x, hb = (rq & 1) ? hq.w : hq.y;
                                w0.x = pk2(__builtin_bit_cast(float, ha << 16) * rs * g0.x, __builtin_bit_cast(float, ha & 0xffff0000u) * rs * g0.y); w0.y = pk2(__builtin_bit_cast(float, hb << 16) * rs * g0.z, __builtin_bit_cast(float, hb & 0xffff0000u) * rs * g0.w);
                                w1.x = pk2(o[k][4 * rq] * rs * g1.x, o[k][4 * rq + 1] * rs * g1.y); w1.y = pk2(o[k][4 * rq + 2] * rs * g1.z, o[k][4 * rq + 3] * rs * g1.w);
                                *(LAS u32x2*)(tb_ + r32 * 144 + rq * 16 + hi * 8) = w0; *(LAS u32x2*)(tb_ + r32 * 144 + 64 + rq * 16 + hi * 8) = w1;
                            }
                            bf16* op = MIXED + ((size_t)r0 + 32 * jt + (lane >> 3)) * D + 512 + h * 64 + (lane & 7) * 8;
#pragma unroll
                            for (int j = 0; j < 4; ++j) *(u32x4*)(op + (size_t)(8 * j) * D) = *(const LAS u32x4*)(tb_ + ((lane >> 3) + 8 * j) * 144 + (lane & 7) * 16);
                        }
                    }
                }
#undef XLOAD
#undef ZLOAD
#undef SLOAD
                __syncthreads();
            }
            mall_touch(WOUT + (size_t)l * WOUT_STRIDE, WOUT_STRIDE * 2, gw, lane, NGW);
        }
        PH_END;
#endif
#ifndef NO_WOUT
        if (PH_ON) {
            WS_BASE();
            pg8::StaticOrder S; S.init(M, D, G, bx);
            pg8::Gemm g{MIXED, WOUT + (size_t)l * WOUT_STRIDE, M, D, D};
            pg8::EpiResid E{HB, PART, 1.0f / REP_WOUT};
            pg8::gemm_phase<pg8::EpiResid, pg8::StaticOrder, true, true>(L + RING_OFF, g, S, E);
            { int t_ = threadIdx.x; asm volatile("" : "+v"(t_)); mall_touch(WGU + (size_t)(i + 1) * WGU_STRIDE, WGU_STRIDE * 2, bx * NWAVES + (t_ >> 6), t_ & 63, NGW); }
        }
#if REP_WOUT == 2
        if (PH_ON) {
            WS_BASE();
            pg8::StaticOrder S; S.init(M, D, G, bx);
            pg8::Gemm g{MIXED, WOUT + (size_t)l * WOUT_STRIDE, M, D, D};
            pg8::EpiResid E{HB, PART, 1.0f / REP_WOUT};
            pg8::gemm_phase<pg8::EpiResid, pg8::StaticOrder, true, true>(L + RING_OFF, g, S, E);
        }
#endif
#endif
        PH_END;
    }
    if (PH_ON) {
        LANE_IDS();
        const float* fg = args.in[20];
        f32x4 gg[8];
#pragma unroll
        for (int j = 0; j < 8; ++j) gg[j] = ((const GAS f32x4*)fg + lane)[64 * j];
        static_assert(M % (4 * GRID * NWAVES) == 0, "final norm: four rows per trip");
        for (int m0 = gw; m0 < M; m0 += 4 * NGW) {
            float ps[4]; unsigned long long q[4][8];
#pragma unroll
            for (int r = 0; r < 4; ++r) { const int m = m0 + r * NGW; ps[r] = (lane < 32) ? PART[(size_t)m * 32 + lane] : 0.f;
                const GAS unsigned long long* hr = (const GAS unsigned long long*)(HB + (size_t)m * D) + lane;
#pragma unroll
                for (int j = 0; j < 8; ++j) q[r][j] = hr[64 * j]; }
#pragma unroll
            for (int r = 0; r < 4; ++r) { const int m = m0 + r * NGW;
                const float rs = rsqrtf(wave_sum(ps[r], lane) * (1.0f / D) + RMS_EPS);
                GAS f32x4* orow = (GAS f32x4*)(args.out + (size_t)m * D) + lane;
#pragma unroll
                for (int j = 0; j < 8; ++j) { const unsigned lo_ = (unsigned)q[r][j], hi_ = (unsigned)(q[r][j] >> 32);
                    f32x4 v; v.x = __builtin_bit_cast(float, lo_ << 16); v.y = __builtin_bit_cast(float, lo_ & 0xffff0000u); v.z = __builtin_bit_cast(float, hi_ << 16); v.w = __builtin_bit_cast(float, hi_ & 0xffff0000u);
                    orow[64 * j] = v * rs * gg[j]; }
            }
        }
    }
#undef PH_ON
#undef PH_END
}

constexpr int N_PHASES = 1 + 8 * 2 + 4 * 6 + 1;
#ifndef MK_PER_PHASE
#define MK_PER_PHASE 0
#endif
extern "C" void kernel_launch(void* const* d_in, const int* in_sizes, int n_in, void* d_out, int out_size, void* d_ws, size_t ws_size, hipStream_t stream) {
    static int ok = 0;
    if (ok == 0) {
        if (n_in != 21 || in_sizes[0] != M * D || out_size != M * D || ws_size < WS_END) { fprintf(stderr, "kernel_launch: unexpected shapes / workspace (%d inputs, ws %zu < %zu)\n", n_in, ws_size, (size_t)WS_END); ok = -1; return; }
        int dev = 0, cus = 0;
        if (hipGetDevice(&dev) != hipSuccess || hipDeviceGetAttribute(&cus, hipDeviceAttributeMultiprocessorCount, dev) != hipSuccess || cus < GRID) { fprintf(stderr, "kernel_launch: needs %d CUs, device has %d\n", GRID, cus); ok = -1; return; }
        if (hipFuncSetAttribute((const void*)fwd, hipFuncAttributeMaxDynamicSharedMemorySize, LDS_BYTES) != hipSuccess) { fprintf(stderr, "kernel_launch: hipFuncSetAttribute failed\n"); ok = -1; return; }
        int per_cu = 0;
        if (hipOccupancyMaxActiveBlocksPerMultiprocessor(&per_cu, (const void*)fwd, NWAVES * 64, LDS_BYTES) != hipSuccess || per_cu < 1) { fprintf(stderr, "kernel_launch: occupancy query says %d blocks per CU\n", per_cu); }
        (void)hipGetLastError();
        ok = 1;
    }
    if (ok < 0) return;
    if (hipMemsetAsync((char*)d_ws + WS_CTL, 0, CTL_ZERO_BYTES, stream) != hipSuccess) return;
    Args a{};
    for (int i = 0; i < 21; ++i) a.in[i] = (const float*)d_in[i];
    a.out = (float*)d_out; a.ws = (unsigned char*)d_ws;
#if MK_PER_PHASE
    for (int p = 0; p < N_PHASES; ++p) { a.ph_lo = p; a.ph_hi = p + 1; hipLaunchKernelGGL(fwd, dim3(GRID), dim3(NWAVES * 64), LDS_BYTES, stream, a); }
#else
    a.ph_lo = 0; a.ph_hi = N_PHASES;
    hipLaunchKernelGGL(fwd, dim3(GRID), dim3(NWAVES * 64), LDS_BYTES, stream, a);
#endif
}
```

```cpp
#include <hip/hip_runtime.h>
#include <cstdio>
#include <cstdint>
namespace pg8 {
#define PG8_LAS __attribute__((address_space(3)))
typedef unsigned short bf16_t;
typedef short bf16x8 __attribute__((ext_vector_type(8)));
typedef float f32x4 __attribute__((ext_vector_type(4)));
typedef unsigned u32x4 __attribute__((ext_vector_type(4)));
constexpr int BM = 256, BK = 64, HALF = 128, HTB = HALF * BK * 2  , STAGE_BYTES = 8 * HTB, NXCD = 8, WGM = 8;

__host__ __device__ __forceinline__ int lds_byte(int r, int c) { const int st = (r >> 4) * 2 + (c >> 5), rr = r & 15, cc = c & 31, ob = rr * 64 + cc * 2; return st * 1024 + (ob ^ (((ob >> 9) & 1) << 5)); }
__host__ __device__ __forceinline__ void stage_rc(int b, int& R, int& C) { const int st = b / 1024, sb = b % 1024, swz = sb ^ (((sb >> 9) & 1) << 5); R = (st >> 1) * 16 + swz / 64; C = (st & 1) * 32 + (swz % 64) / 2; }
__host__ __device__ __forceinline__ int perm32(int rho) { const int n = rho >> 4, i = rho & 15; return 8 * (i >> 2) + 4 * n + (i & 3); }

struct Unit { int pm, pn; };
struct Gemm { const bf16_t* A; const bf16_t* Bt; int M, N, K; };

struct StaticOrder {
    int nM, nN, nwg, G, c;
    __host__ __device__ __forceinline__ void init(int M, int N, int G_, int c_) { nM = M / BM; nN = N / BM; nwg = nM * nN; G = G_; c = c_; }
    __host__ __device__ __forceinline__ bool next(int i, Unit& u) const {
        const long L = (long)i * G + c; if (L >= nwg) return false;
        int wgid = (int)L; { const int q = nwg / NXCD, r = nwg % NXCD, xcd = wgid % NXCD, off = wgid / NXCD; wgid = (xcd < r ? xcd * (q + 1) : r * (q + 1) + (xcd - r) * q) + off; }
        const int nig = WGM * nN, gid = wgid / nig, fm = gid * WGM, gsz = (nM - fm) < WGM ? (nM - fm) : WGM;
        u.pm = fm + ((wgid % nig) % gsz); u.pn = (wgid % nig) / gsz; return true;
    }
    __device__ __forceinline__ void a_ready(const Unit&) const {}
    __device__ __forceinline__ void done(const Unit&) const {}
};

__device__ __forceinline__ unsigned cvt_pk_bf16(float lo, float hi) { unsigned r; asm volatile("v_cvt_pk_bf16_f32 %0, %1, %2" : "=v"(r) : "v"(lo), "v"(hi)); return r; }
__device__ __forceinline__ float shx(float v, int lane, int k) { return __builtin_bit_cast(float, __builtin_amdgcn_ds_bpermute((lane ^ k) << 2, __builtin_bit_cast(int, v))); }
__device__ __forceinline__ float shl_(float v, int srclane) { return __builtin_bit_cast(float, __builtin_amdgcn_ds_bpermute(srclane << 2, __builtin_bit_cast(int, v))); }
__device__ __forceinline__ float fast_silu(float g) { return g * __builtin_amdgcn_rcpf(1.0f + __builtin_amdgcn_exp2f(-1.4426950408889634f * g)); }
struct EpiSwiGLU {
    static constexpr bool PERM = true, AFTER_DRAIN = false;
    bf16_t* O; int ldc; const PG8_LAS float* rstd;
    __device__ __forceinline__ void operator()(const f32x4 (&acc)[2][2][4][2], const Unit& u, int wr, int wc, int fr_, int fq_) const {
        int fr = fr_, fq = fq_; asm volatile("" : "+v"(fr), "+v"(fq));
        const int rl0 = wr * 64 + fr;
        bf16_t* base = O + (size_t)(u.pm * BM) * ldc + u.pn * HALF + wc * 32 + 8 * fq;
#pragma unroll
        for (int ai = 0; ai < 2; ++ai)
#pragma unroll
            for (int m = 0; m < 4; ++m) {
                const int rl = rl0 + ai * HALF + m * 16; const float r = rstd[rl];
                const float rn = -1.4426950408889634f * r, r2 = r * r;
                u32x4 w;
#pragma unroll
                for (int n = 0; n < 2; ++n) {
                    const f32x4 ag = acc[ai][0][m][n], au = acc[ai][1][m][n];
                    const f32x4 t = ag * rn;
                    f32x4 d; d[0] = __builtin_amdgcn_exp2f(t[0]); d[1] = __builtin_amdgcn_exp2f(t[1]); d[2] = __builtin_amdgcn_exp2f(t[2]); d[3] = __builtin_amdgcn_exp2f(t[3]);
                    d = d + 1.0f;
                    f32x4 rc; rc[0] = __builtin_amdgcn_rcpf(d[0]); rc[1] = __builtin_amdgcn_rcpf(d[1]); rc[2] = __builtin_amdgcn_rcpf(d[2]); rc[3] = __builtin_amdgcn_rcpf(d[3]);
                    const f32x4 o_ = (ag * au) * (rc * r2);
                    if (n == 0) { w.x = cvt_pk_bf16(o_[0], o_[1]); w.y = cvt_pk_bf16(o_[2], o_[3]); } else { w.z = cvt_pk_bf16(o_[0], o_[1]); w.w = cvt_pk_bf16(o_[2], o_[3]); }
                }
                *(u32x4*)(base + (size_t)rl * ldc) = w;
            }
    }
};
struct EpiResid {
    static constexpr bool PERM = true, AFTER_DRAIN = false;
    bf16_t* Hb; float* part; float scale;
    __device__ __forceinline__ void operator()(const f32x4 (&acc)[2][2][4][2], const Unit& u, int wr, int wc, int fr_, int fq_) const {
        int fr = fr_, fq = fq_; asm volatile("" : "+v"(fr), "+v"(fq));
        const int row0 = u.pm * BM + wr * 64 + fr, col0 = u.pn * BM + wc * 32 + 8 * fq;
        u32x4 hq[2][4][2];
#pragma unroll
        for (int ai = 0; ai < 2; ++ai)
#pragma unroll
            for (int m = 0; m < 4; ++m)
#pragma unroll
                for (int bj = 0; bj < 2; ++bj) hq[ai][m][bj] = *(const u32x4*)(Hb + (size_t)(row0 + ai * HALF + m * 16) * 2048 + col0 + bj * HALF);
        __builtin_amdgcn_sched_barrier(0);
#pragma unroll
        for (int ai = 0; ai < 2; ++ai)
#pragma unroll
            for (int m = 0; m < 4; ++m) {
                const int row = row0 + ai * HALF + m * 16; float ss = 0.f;
#pragma unroll
                for (int bj = 0; bj < 2; ++bj) {
                    const size_t off = (size_t)row * 2048 + col0 + bj * HALF;
                    const u32x4 h_ = hq[ai][m][bj];
                    f32x4 v0, v1;
                    v0[0] = __builtin_bit_cast(float, h_.x << 16); v0[1] = __builtin_bit_cast(float, h_.x & 0xffff0000u); v0[2] = __builtin_bit_cast(float, h_.y << 16); v0[3] = __builtin_bit_cast(float, h_.y & 0xffff0000u);
                    v1[0] = __builtin_bit_cast(float, h_.z << 16); v1[1] = __builtin_bit_cast(float, h_.z & 0xffff0000u); v1[2] = __builtin_bit_cast(float, h_.w << 16); v1[3] = __builtin_bit_cast(float, h_.w & 0xffff0000u);
                    v0 = v0 + acc[ai][bj][m][0] * scale; v1 = v1 + acc[ai][bj][m][1] * scale;
                    u32x4 w; w.x = cvt_pk_bf16(v0[0], v0[1]); w.y = cvt_pk_bf16(v0[2], v0[3]); w.z = cvt_pk_bf16(v1[0], v1[1]); w.w = cvt_pk_bf16(v1[2], v1[3]);
                    *(u32x4*)(Hb + off) = w;
                    const float r0 = __builtin_bit_cast(float, w.x << 16), r1 = __builtin_bit_cast(float, w.x & 0xffff0000u), r2 = __builtin_bit_cast(float, w.y << 16), r3 = __builtin_bit_cast(float, w.y & 0xffff0000u);
                    const float r4 = __builtin_bit_cast(float, w.z << 16), r5 = __builtin_bit_cast(float, w.z & 0xffff0000u), r6 = __builtin_bit_cast(float, w.w << 16), r7 = __builtin_bit_cast(float, w.w & 0xffff0000u);
                    ss += (r0 * r0 + r1 * r1) + (r2 * r2 + r3 * r3) + (r4 * r4 + r5 * r5) + (r6 * r6 + r7 * r7);
                }
                { const int ln = fq * 16 + fr; ss += shx(ss, ln, 16); ss += shx(ss, ln, 32); }
                if (fq == 0) part[(size_t)row * 32 + u.pn * 4 + wc] = ss;
            }
    }
};
struct EpiProj {
    static constexpr bool PERM = true, AFTER_DRAIN = false;
    bf16_t* O; float* dtraw; const PG8_LAS float* rstd;
    __device__ __forceinline__ void operator()(const f32x4 (&acc)[2][2][4][2], const Unit& u, int wr, int wc, int fr_, int fq_) const {
        int fr = fr_, fq = fq_; asm volatile("" : "+v"(fr), "+v"(fq));
        const int rl0 = wr * 64 + fr;
        {
            bf16_t* base = O + (size_t)(u.pm * BM) * 4608 + u.pn * BM + wc * 32 + 8 * fq;
#pragma unroll
            for (int ai = 0; ai < 2; ++ai)
#pragma unroll
                for (int m = 0; m < 4; ++m) {
                    const int rl = rl0 + ai * HALF + m * 16; const float r = rstd[rl];
#pragma unroll
                    for (int bj = 0; bj < 2; ++bj) {
                        const f32x4 v0 = acc[ai][bj][m][0] * r, v1 = acc[ai][bj][m][1] * r;
                        u32x4 w; w.x = cvt_pk_bf16(v0[0], v0[1]); w.y = cvt_pk_bf16(v0[2], v0[3]); w.z = cvt_pk_bf16(v1[0], v1[1]); w.w = cvt_pk_bf16(v1[2], v1[3]);
                        *(u32x4*)(base + (size_t)rl * 4608 + bj * HALF) = w;
                    }
                }
        }
    }
};
template <class Epi, class Sched, bool ALIGN_EPI = false, bool SP2 = false, bool RS = false>
__device__ __forceinline__ void gemm_phase(PG8_LAS unsigned char* lds, const Gemm g, const Sched& S, const Epi& E, const float* rpart = nullptr, PG8_LAS float* rtab = nullptr, float rinvd = 0.f, float reps = 0.f) {
    int tid_ = threadIdx.x; asm volatile("" : "+v"(tid_));
    const int tid = tid_, wid = __builtin_amdgcn_readfirstlane(tid >> 6), lane = tid & 63, wr = wid >> 2, wc = wid & 3, fr = lane & 15, fq = lane >> 4;
    const int K = g.K, nt = K / BK;
    unsigned voffA[2], voffB[2];
#pragma unroll
    for (int i = 0; i < 2; ++i) { int R, C; stage_rc(tid * 16 + i * 8192, R, C); const int Rb = Epi::PERM ? ((R & ~31) + perm32(R & 31)) : R;
        voffA[i] = (unsigned)(R * K + C) * 2u; voffB[i] = (unsigned)(Rb * K + C) * 2u; }
    const size_t kstep = (size_t)(BK * 2);
    const size_t hstep = (size_t)HALF * K * 2;
    const size_t tstep = 2 * hstep;
    const unsigned ldsw = (unsigned)wid * 1024u;
    const int aoff = lds_byte(wr * 64 + fr, fq * 8), boff = lds_byte(wc * 32 + fr, fq * 8);
#define PG8_SA(b, h) (((b) * 2 + (h)) * HTB)
#define PG8_SB(b, h) ((4 + (b) * 2 + (h)) * HTB)
#define PG8_STAGE(bufoff, gbase, voff) do { _Pragma("unroll") for (int _i = 0; _i < 2; ++_i) \
        __builtin_amdgcn_global_load_lds((const unsigned*)((const char*)(gbase) + (voff)[_i]), (PG8_LAS unsigned*)(lds + (bufoff) + ldsw + _i * 8192), 16, 0, 0); } while (0)
#define PG8_LDA(dst, b, h) do { _Pragma("unroll") for (int m = 0; m < 4; ++m) _Pragma("unroll") for (int k = 0; k < 2; ++k) dst[m][k] = *(const PG8_LAS bf16x8*)(lds + PG8_SA(b, h) + aoff + m * 2048 + k * 1024); } while (0)
#define PG8_LDB(dst, b, h) do { _Pragma("unroll") for (int n = 0; n < 2; ++n) _Pragma("unroll") for (int k = 0; k < 2; ++k) dst[n][k] = *(const PG8_LAS bf16x8*)(lds + PG8_SB(b, h) + boff + n * 2048 + k * 1024); } while (0)
#define PG8_MMA(ai, bj, At, Bt) do { __builtin_amdgcn_s_setprio(1); _Pragma("unroll") for (int m = 0; m < 4; ++m) _Pragma("unroll") for (int n = 0; n < 2; ++n) _Pragma("unroll") for (int k = 0; k < 2; ++k) \
        acc[ai][bj][m][n] = __builtin_amdgcn_mfma_f32_16x16x32_bf16(Bt[n][k], At[m][k], acc[ai][bj][m][n], 0, 0, 0); __builtin_amdgcn_s_setprio(0); } while (0)
#define PG8_WAIT_V(n) asm volatile("s_waitcnt vmcnt(" #n ")" ::: "memory")
#define PG8_WAIT_L(n) asm volatile("s_waitcnt lgkmcnt(" #n ")" ::: "memory")
#define PG8_BAR __builtin_amdgcn_s_barrier()
#define PG8_SCHED __builtin_amdgcn_sched_barrier(0)
    Unit cur, nxt; int ui = 0;
    if (!S.next(0, cur)) return;
    f32x4 acc[2][2][4][2];
#pragma unroll
    for (int a = 0; a < 2; ++a)
#pragma unroll
        for (int b = 0; b < 2; ++b)
#pragma unroll
            for (int m = 0; m < 4; ++m)
#pragma unroll
                for (int n = 0; n < 2; ++n) acc[a][b][m][n] = (f32x4){0.f, 0.f, 0.f, 0.f};
    bf16x8 At[4][2], B0[2][2], B1[2][2];
    const char* cA = (const char*)g.A + (size_t)cur.pm * tstep; const char* cB = (const char*)g.Bt + (size_t)cur.pn * tstep;
    S.a_ready(cur);
    f32x4 rq0 = {}, rq1 = {}, rq2 = {}, rq3 = {};
    if constexpr (RS) { const f32x4* rp_ = (const f32x4*)(rpart + (size_t)(cur.pm * 256 + (tid >> 1)) * 32 + (tid & 1) * 16); rq0 = rp_[0]; rq1 = rp_[1]; rq2 = rp_[2]; rq3 = rp_[3]; }
    if constexpr (SP2) {
        PG8_STAGE(PG8_SB(0, 0), cB, voffB); PG8_STAGE(PG8_SB(0, 1), cB + hstep, voffB); PG8_STAGE(PG8_SA(0, 0), cA, voffA); PG8_STAGE(PG8_SA(0, 1), cA + hstep, voffA);
        if (wr == 1) PG8_BAR;
        PG8_WAIT_V(2); PG8_BAR;
        PG8_STAGE(PG8_SB(1, 0), cB + kstep, voffB); PG8_STAGE(PG8_SA(1, 0), cA + kstep, voffA); PG8_STAGE(PG8_SB(1, 1), cB + hstep + kstep, voffB);
        if constexpr (RS) { float s_ = ((rq0.x + rq0.y) + (rq0.z + rq0.w)) + ((rq1.x + rq1.y) + (rq1.z + rq1.w)) + ((rq2.x + rq2.y) + (rq2.z + rq2.w)) + ((rq3.x + rq3.y) + (rq3.z + rq3.w));
            s_ += shx(s_, lane, 1); if (!(tid & 1)) rtab[tid >> 1] = rsqrtf(s_ * rinvd + reps); }
        PG8_WAIT_V(6); PG8_BAR;
    } else {
        PG8_STAGE(PG8_SB(0, 0), cB, voffB); PG8_STAGE(PG8_SA(0, 0), cA, voffA); PG8_STAGE(PG8_SB(0, 1), cB + hstep, voffB); PG8_STAGE(PG8_SA(0, 1), cA + hstep, voffA);
        if (wr == 1) PG8_BAR;
        PG8_WAIT_V(4); PG8_BAR;
        PG8_STAGE(PG8_SB(1, 0), cB + kstep, voffB); PG8_STAGE(PG8_SA(1, 0), cA + kstep, voffA); PG8_STAGE(PG8_SB(1, 1), cB + hstep + kstep, voffB);
        PG8_WAIT_V(6); PG8_BAR;
    }
    for (;;) {
        const bool has_next = S.next(ui + 1, nxt);
        const char* nA = has_next ? (const char*)g.A + (size_t)nxt.pm * tstep : cA; const char* nB = has_next ? (const char*)g.Bt + (size_t)nxt.pn * tstep : cB;
        for (int t = 0; t < nt; t += 2) {
            const bool last = (t == nt - 2);
            const char* a1 = cA + (size_t)(t + 1) * kstep;
            const char* a2 = last ? nA : cA + (size_t)(t + 2) * kstep; const char* b2 = last ? nB : cB + (size_t)(t + 2) * kstep;
            const char* a3 = a2 + kstep; const char* b3 = b2 + kstep;
            if (last && has_next) S.a_ready(nxt);
            if constexpr (SP2) {
            PG8_LDB(B0, 0, 0); PG8_LDB(B1, 0, 1); PG8_SCHED; PG8_LDA(At, 0, 0); PG8_STAGE(PG8_SA(1, 1), a1 + hstep, voffA);
            PG8_WAIT_V(8); PG8_WAIT_L(0); PG8_BAR; PG8_MMA(0, 0, At, B0); PG8_MMA(0, 1, At, B1); PG8_BAR; PG8_SCHED;
            PG8_LDA(At, 0, 1); PG8_STAGE(PG8_SB(0, 0), b2, voffB); PG8_STAGE(PG8_SB(0, 1), b2 + hstep, voffB); PG8_STAGE(PG8_SA(0, 0), a2, voffA);
            PG8_WAIT_V(8); PG8_WAIT_L(0); PG8_BAR; PG8_MMA(1, 0, At, B0); PG8_MMA(1, 1, At, B1); PG8_BAR; PG8_SCHED;
            PG8_LDB(B0, 1, 0); PG8_LDB(B1, 1, 1); PG8_SCHED; PG8_LDA(At, 1, 0); PG8_STAGE(PG8_SA(0, 1), a2 + hstep, voffA);
            PG8_WAIT_V(8); PG8_WAIT_L(0); PG8_BAR; PG8_MMA(0, 0, At, B0); PG8_MMA(0, 1, At, B1); PG8_BAR; PG8_SCHED;
            PG8_LDA(At, 1, 1); PG8_STAGE(PG8_SB(1, 0), b3, voffB); PG8_STAGE(PG8_SB(1, 1), b3 + hstep, voffB); PG8_STAGE(PG8_SA(1, 0), a3, voffA);
            PG8_WAIT_V(8); PG8_WAIT_L(0); PG8_BAR; PG8_MMA(1, 0, At, B0); PG8_MMA(1, 1, At, B1); PG8_BAR; PG8_SCHED;
            } else {
            PG8_LDB(B0, 0, 0); PG8_SCHED; PG8_LDA(At, 0, 0); PG8_STAGE(PG8_SA(1, 1), a1 + hstep, voffA);
            PG8_WAIT_L(8); PG8_BAR; PG8_WAIT_L(0); PG8_MMA(0, 0, At, B0); PG8_BAR; PG8_SCHED;
            PG8_LDB(B1, 0, 1); PG8_STAGE(PG8_SB(0, 0), b2, voffB);
            PG8_BAR; PG8_WAIT_L(0); PG8_MMA(0, 1, At, B1); PG8_BAR;
            PG8_LDA(At, 0, 1); PG8_STAGE(PG8_SA(0, 0), a2, voffA);
            PG8_BAR; PG8_WAIT_L(0); PG8_MMA(1, 0, At, B0); PG8_BAR; PG8_SCHED;
            PG8_STAGE(PG8_SB(0, 1), b2 + hstep, voffB);
            PG8_WAIT_V(6); PG8_BAR; PG8_MMA(1, 1, At, B1); PG8_BAR;
            PG8_LDB(B0, 1, 0); PG8_SCHED; PG8_LDA(At, 1, 0); PG8_STAGE(PG8_SA(0, 1), a2 + hstep, voffA);
            PG8_WAIT_L(8); PG8_BAR; PG8_WAIT_L(0); PG8_MMA(0, 0, At, B0); PG8_BAR; PG8_SCHED;
            PG8_LDB(B1, 1, 1); PG8_STAGE(PG8_SB(1, 0), b3, voffB);
            PG8_BAR; PG8_WAIT_L(0); PG8_MMA(0, 1, At, B1); PG8_BAR;
            PG8_LDA(At, 1, 1); PG8_STAGE(PG8_SA(1, 0), a3, voffA);
            PG8_BAR; PG8_WAIT_L(0); PG8_MMA(1, 0, At, B0); PG8_BAR; PG8_SCHED;
            PG8_STAGE(PG8_SB(1, 1), b3 + hstep, voffB);
            PG8_WAIT_V(6); PG8_BAR; PG8_MMA(1, 1, At, B1); PG8_BAR;
            }
        }
        if constexpr (ALIGN_EPI) { if (wr == 0) PG8_BAR; }
        if constexpr (!Epi::AFTER_DRAIN) { E(acc, cur, wr, wc, fr, fq); S.done(cur); }
        if (!has_next) break;
#pragma unroll
        for (int a = 0; a < 2; ++a)
#pragma unroll
            for (int b = 0; b < 2; ++b)
#pragma unroll
                for (int m = 0; m < 4; ++m)
#pragma unroll
                    for (int n = 0; n < 2; ++n) acc[a][b][m][n] = (f32x4){0.f, 0.f, 0.f, 0.f};
        cur = nxt; cA = nA; cB = nB; ++ui;
        if constexpr (ALIGN_EPI) { if (wr == 1) PG8_BAR; }
    }
    PG8_WAIT_V(0);
    if constexpr (!ALIGN_EPI) { if (wr == 0) PG8_BAR; }
    PG8_BAR;
    if constexpr (Epi::AFTER_DRAIN) { E.fused(acc, cur, wr, wc, fr, fq, lds, wid, lane); S.done(cur); }
#undef PG8_SA
#undef PG8_SB
#undef PG8_STAGE
#undef PG8_LDA
#undef PG8_LDB
#undef PG8_MMA
#undef PG8_WAIT_V
#undef PG8_WAIT_L
#undef PG8_BAR
#undef PG8_SCHED
}
}
#define GAS __attribute__((address_space(1)))
#define LAS __attribute__((address_space(3)))
typedef unsigned short bf16;
typedef unsigned v4u __attribute__((ext_vector_type(4)));
typedef float f32x4 __attribute__((ext_vector_type(4)));
typedef short bf16x8 __attribute__((ext_vector_type(8)));
typedef float f32x16 __attribute__((ext_vector_type(16)));
typedef GAS unsigned gu32;
typedef GAS unsigned long long gu64;
#define RLX_AGENT __ATOMIC_RELAXED, __HIP_MEMORY_SCOPE_AGENT
#define LDS_WAIT() asm volatile("s_waitcnt lgkmcnt(0)" ::: "memory")
#define VM_WAIT() asm volatile("s_waitcnt vmcnt(0)" ::: "memory")
__device__ __forceinline__ unsigned long long rt() { return __builtin_amdgcn_s_memrealtime(); }
__device__ __forceinline__ unsigned f2bf(float f) { unsigned u = __builtin_bit_cast(unsigned, f); return (u + 0x7fffu + ((u >> 16) & 1u)) >> 16; }
typedef float f32x2_t __attribute__((ext_vector_type(2))); typedef __bf16 bf16x2_t __attribute__((ext_vector_type(2)));
__device__ __forceinline__ unsigned pk2(float lo, float hi) { f32x2_t v = {lo, hi}; bf16x2_t b = __builtin_convertvector(v, bf16x2_t); return __builtin_bit_cast(unsigned, b); }

#define XB_TMO      128
#define XB_XCNT(j)  (256  + 64 * (j))
#define XB_XSUB(j)  (1280 + 64 * (j))
#define XB_XGEN(j)  (2304 + 64 * (j))
#define XB_TOP      3328
#define XB_TOPGEN   3392
#define XCD_BAR_WORDS 3456
#define XB_SPIN_CAP (1u << 18)

__device__ __forceinline__ unsigned xb_ld(unsigned* p)              { return __hip_atomic_load(p, __ATOMIC_RELAXED, __HIP_MEMORY_SCOPE_AGENT); }
__device__ __forceinline__ unsigned xb_add(unsigned* p, unsigned v) { return __hip_atomic_fetch_add(p, v, __ATOMIC_RELAXED, __HIP_MEMORY_SCOPE_AGENT); }
__device__ __forceinline__ unsigned xb_xcc_id() { return (unsigned)__builtin_amdgcn_s_getreg((3 << 11) | 20) & 0xFu; }
#define XB_SPIN(cond, bar) do { unsigned _sp = 0; while (cond) { __builtin_amdgcn_s_sleep(1); \
    if ((++_sp & 255u) == 0u) { if (xb_ld(&(bar)[XB_TMO])) break; if (_sp > XB_SPIN_CAP) { atomicAdd(&(bar)[XB_TMO], 1u); break; } } } } while (0)

struct XcdBarrier {
    unsigned* bar; unsigned x;
    volatile LAS unsigned* st;
};

__device__ __forceinline__ XcdBarrier xcd_barrier_post(unsigned* bar, volatile LAS unsigned* st) {
    XcdBarrier b; b.bar = bar; b.x = xb_xcc_id(); b.st = st;
    if (threadIdx.x == 0) (void)xb_add(&bar[XB_XCNT(b.x)], 1u);
    return b;
}
__device__ __forceinline__ void xcd_barrier_complete(unsigned* bar, unsigned x, unsigned& nloc, unsigned& nx) {
    const unsigned G = gridDim.x * gridDim.y * gridDim.z;
    unsigned sum, cnt, mine, sp = 0u;
    for (;;) {
        sum = 0u; cnt = 0u; mine = 0u;
#pragma unroll 1
        for (unsigned j = 0; j < 16; ++j) { const unsigned c = xb_ld(&bar[XB_XCNT(j)]); sum += c; cnt += (c > 0u) ? 1u : 0u; mine = (j == x) ? c : mine; }
        if (sum == G) break;
        __builtin_amdgcn_s_sleep(1);
        if ((++sp & 255u) == 0u) { if (xb_ld(&bar[XB_TMO])) break; if (sp > XB_SPIN_CAP) { atomicAdd(&bar[XB_TMO], 1u); break; } }
    }
    nloc = mine > 0u ? mine : 1u; nx = cnt > 0u ? cnt : 1u;
}

__device__ __forceinline__ void xcd_barrier(const XcdBarrier& b, const void* tp = nullptr, unsigned tbytes = 0u, LAS unsigned char* junk = nullptr) {
    asm volatile("s_waitcnt vmcnt(0)" ::: "memory");
    __syncthreads();
    if (tp != nullptr) {
        int t_ = threadIdx.x; asm volatile("" : "+v"(t_));
        const unsigned w_ = (unsigned)__builtin_amdgcn_readfirstlane(t_ >> 6), ln_ = (unsigned)(t_ & 63);
        if (w_ != 0u) {
            const unsigned step_ = gridDim.x * 7u * 1024u;
            for (unsigned o_ = (blockIdx.x * 7u + (w_ - 1u)) * 1024u; o_ < tbytes; o_ += step_)
                __builtin_amdgcn_global_load_lds((const unsigned*)((const char*)tp + o_ + ln_ * 16u), (LAS unsigned*)junk, 16, 0, 0);
        }
    }
    if (threadIdx.x == 0) {
        unsigned* bar = b.bar;
        __builtin_amdgcn_s_waitcnt(0);
        unsigned nloc = b.st[0], nx = b.st[1];
        if (nloc == 0u) { xcd_barrier_complete(bar, b.x, nloc, nx); b.st[0] = nloc; b.st[1] = nx; }
        const unsigned old = xb_add(&bar[XB_XSUB(b.x)], 1u);
        const unsigned gen = old / nloc;
        if (old + 1u == (gen + 1u) * nloc) {
            __builtin_amdgcn_fence(__ATOMIC_RELEASE, "agent");
            asm volatile("s_waitcnt vmcnt(0)" ::: "memory");
            const unsigned og = xb_add(&bar[XB_TOP], 1u);
            const unsigned tg = og / nx;
            if (og + 1u == (tg + 1u) * nx) xb_add(&bar[XB_TOPGEN], 1u);
            else XB_SPIN(xb_ld(&bar[XB_TOPGEN]) == tg, bar);
            __builtin_amdgcn_fence(__ATOMIC_ACQUIRE, "agent");
            xb_add(&bar[XB_XGEN(b.x)], 1u);
            asm volatile("s_waitcnt vmcnt(0)" ::: "memory");
        } else {
            XB_SPIN(xb_ld(&bar[XB_XGEN(b.x)]) == gen, bar);
            __builtin_amdgcn_fence(__ATOMIC_ACQUIRE, "agent");
            asm volatile("s_waitcnt vmcnt(0)" ::: "memory");
        }
    }
    __syncthreads();
}

#ifndef REP_PRO
#define REP_PRO 1
#endif
#ifndef REP_UP
#define REP_UP 1
#endif
#ifndef REP_WIN
#define REP_WIN 1
#endif
#ifndef REP_MIX
#define REP_MIX 1
#endif
#ifndef REP_DOWN
#define REP_DOWN 1
#endif
#ifndef REP_WOUT
#define REP_WOUT 1
#endif
#ifndef REP_ATT
#define REP_ATT 1
#endif
#ifndef REP_S1
#define REP_S1 1
#endif
#ifndef REP_S2
#define REP_S2 1
#endif
#ifndef REP_S3
#define REP_S3 1
#endif
constexpr int NWAVES = 8;
constexpr int BATCH = 2, SEQ = 8192, M = BATCH * SEQ, D = 2048, FF = 5632, NGU = 2 * FF, DEPTH = 4;
constexpr int NIN = 4864, PROJ_LD = 4608;
constexpr int P_POOL = 0, P_Z = 512, P_XBC = 1536, P_Q = 3072, P_K = 3584, P_V = 4096;
constexpr int IN_W = 4624;
constexpr float RMS_EPS = 1e-6f;
constexpr int GRID = 256;

constexpr size_t MiB = 1u << 20;
constexpr size_t WS_CTL = 0, CTL_ZERO_BYTES = 1 * MiB;
constexpr size_t WS_PWT = 1 * MiB;
constexpr size_t WS_WGU = 2 * MiB;        constexpr size_t WGU_STRIDE = (size_t)NGU * D;
constexpr size_t WS_WD = 354 * MiB;       constexpr size_t WD_STRIDE = (size_t)D * FF;
constexpr size_t WS_WIN = 530 * MiB;      constexpr size_t WIN_STRIDE = (size_t)NIN * D;
constexpr size_t WS_WOUT = 606 * MiB;     constexpr size_t WOUT_STRIDE = (size_t)D * D;
constexpr size_t WS_H = 638 * MiB, WS_HB = 766 * MiB, WS_PART = 830 * MiB, WS_DTRAW = 832 * MiB, WS_DT = 833 * MiB;
constexpr size_t WS_X = 834 * MiB;
constexpr size_t WS_ACT = WS_X;
constexpr size_t WS_PROJ = WS_X, WS_MIXED = WS_X + 144 * MiB;
constexpr size_t WS_XT = WS_X + 208 * MiB, WS_XTS = WS_X + 240 * MiB, WS_BC = WS_X + 272 * MiB, WS_BCT = WS_X + 280 * MiB, WS_CC = WS_X + 288 * MiB, WS_CS = WS_X + 296 * MiB;
constexpr size_t WS_ST = WS_X + 297 * MiB, WS_SIN = WS_X + 329 * MiB, WS_Y = WS_X + 345 * MiB;
constexpr size_t WS_END = WS_X + 409 * MiB;
static_assert(WS_WGU + 8 * WGU_STRIDE * 2 <= WS_WD && WS_WD + 8 * WD_STRIDE * 2 <= WS_WIN && WS_WIN + 4 * WIN_STRIDE * 2 <= WS_WOUT && WS_WOUT + 4 * WOUT_STRIDE * 2 <= WS_H, "ws map: weights");
static_assert(WS_H + (size_t)M * D * 4 <= WS_HB && WS_HB + (size_t)M * D * 2 <= WS_PART && WS_PART + (size_t)M * 32 * 4 <= WS_DTRAW && WS_DTRAW + (size_t)M * 16 * 4 <= WS_DT && WS_DT + (size_t)M * 16 * 4 <= WS_X, "ws map: state");
static_assert(WS_ACT + (size_t)M * FF * 2 <= WS_END && WS_PROJ + (size_t)M * PROJ_LD * 2 <= WS_MIXED && WS_MIXED + (size_t)M * D * 2 <= WS_XT && WS_Y + (size_t)M * 1024 * 4 <= WS_END, "ws map: overlay");
constexpr int CW_BAR = 4096;

constexpr int RING_OFF = 0, RING_BYTES = 131072;
constexpr int LDSCTL_OFF = RING_BYTES, MISC_OFF = LDSCTL_OFF + 320, RSTD_OFF = LDSCTL_OFF + 1024;
constexpr int LDS_BYTES = 147456;
static_assert(RSTD_OFF + 1024 <= LDS_BYTES, "LDS map");

struct Args { const float* in[21]; float* out; unsigned char* ws; int ph_lo, ph_hi; };
static_assert(sizeof(Args) == 21 * 8 + 8 + 8 + 8, "Args has no padding");

typedef unsigned u32x4 __attribute__((ext_vector_type(4)));
__device__ __forceinline__ unsigned cvtpk_s(float lo, float hi) { return pk2(lo, hi); }
__device__ __forceinline__ bf16x8 scale_frag(v4u a, f32x4 wl, f32x4 wh) {
    v4u r;
    r.x = pk2(__builtin_bit_cast(float, a.x << 16) * wl.x, __builtin_bit_cast(float, a.x & 0xffff0000u) * wl.y); r.y = pk2(__builtin_bit_cast(float, a.y << 16) * wl.z, __builtin_bit_cast(float, a.y & 0xffff0000u) * wl.w);
    r.z = pk2(__builtin_bit_cast(float, a.z << 16) * wh.x, __builtin_bit_cast(float, a.z & 0xffff0000u) * wh.y); r.w = pk2(__builtin_bit_cast(float, a.w << 16) * wh.z, __builtin_bit_cast(float, a.w & 0xffff0000u) * wh.w);
    return __builtin_bit_cast(bf16x8, r);
}
__device__ __forceinline__ float bf2f(bf16 b) { return __builtin_bit_cast(float, (unsigned)b << 16); }
__device__ __forceinline__ float wave_sum(float v, int lane) {
#pragma unroll
    for (int o = 1; o < 64; o <<= 1) v += pg8::shx(v, lane, o);
    return v;
}
__device__ __forceinline__ float softplus_f(float z) { return fmaxf(z, 0.f) + 0.6931471806f * __builtin_amdgcn_logf(1.0f + __builtin_amdgcn_exp2f(-1.4426950409f * fabsf(z))); }
__device__ __forceinline__ float silu_f(float z) { return z * __builtin_amdgcn_rcpf(1.0f + __builtin_amdgcn_exp2f(-1.4426950409f * z)); }

struct TItem { const float* W; const float* gain; bf16* WT; int K, N, drow0, scol, k0; };
__device__ __forceinline__ void titem_load(const TItem& t, int lane, f32x4 (&v)[8], f32x4& g0, f32x4& g1) {
    const int kr = lane >> 3;
#pragma unroll
    for (int i = 0; i < 8; ++i) { const f32x4 x_ = *(const f32x4*)(t.W + (size_t)(t.k0 + 8 * kr + i) * t.N + (t.scol >= 0 ? t.scol : 0));
        v[i] = x_ * ((t.scol >= 0) ? 1.0f : 0.0f); }
    g0 = (f32x4){1.f, 1.f, 1.f, 1.f}; g1 = g0;
    if (t.gain) { g0 = *(const f32x4*)(t.gain + t.k0 + 8 * kr); g1 = *(const f32x4*)(t.gain + t.k0 + 8 * kr + 4); }
}
__device__ __forceinline__ void titem_store(const TItem& t, int lane, const f32x4 (&v)[8], const f32x4& g0, const f32x4& g1) {
    const int kr = lane >> 3, c4 = lane & 7;
#pragma unroll
    for (int e = 0; e < 4; ++e) {
        v4u o; o.x = pk2(v[0][e] * g0.x, v[1][e] * g0.y); o.y = pk2(v[2][e] * g0.z, v[3][e] * g0.w); o.z = pk2(v[4][e] * g1.x, v[5][e] * g1.y); o.w = pk2(v[6][e] * g1.z, v[7][e] * g1.w);
        *(GAS v4u*)(t.WT + (size_t)(t.drow0 + 4 * c4 + e) * t.K + t.k0 + 8 * kr) = o; }
}
constexpr int TI_GU = (D / 64) * (NGU / 32), TI_D = (FF / 64) * (D / 32), TI_IN = (D / 64) * (NIN / 32), TI_OUT = (D / 64) * (D / 32);
constexpr int TI_TOTAL = 8 * (TI_GU + TI_D) + 4 * (TI_IN + TI_OUT);
__device__ __forceinline__ void titem_decode(int it, int lane, const float* const* in, bf16* WGU, bf16* WD, bf16* WIN, bf16* WOUT, TItem& t) {
    const int dl = 4 * (lane & 7);
    int r = it;
    if (r < 8 * TI_GU) {
        const int f = r / TI_GU; r -= f * TI_GU; const int l = f >> 1, second = f & 1;
        const int kb = r / (NGU / 32), db = r % (NGU / 32), tile = db >> 3, within = db & 7;
        t.W = ((within < 4) ? in[second ? 17 : 2] : in[second ? 18 : 3]) + (size_t)l * D * FF; t.gain = in[second ? 16 : 1] + l * D; t.WT = WGU + (size_t)f * WGU_STRIDE;
        t.K = D; t.N = FF; t.drow0 = db * 32; t.scol = tile * 128 + (within & 3) * 32 + dl; t.k0 = kb * 64; return;
    }
    r -= 8 * TI_GU;
    if (r < 8 * TI_D) {
        const int f = r / TI_D; r -= f * TI_D; const int l = f >> 1, second = f & 1;
        const int kb = r / (D / 32), db = r % (D / 32);
        t.W = in[second ? 19 : 4] + (size_t)l * FF * D; t.gain = nullptr; t.WT = WD + (size_t)f * WD_STRIDE; t.K = FF; t.N = D; t.drow0 = db * 32; t.scol = db * 32 + dl; t.k0 = kb * 64; return;
    }
    r -= 8 * TI_D;
    if (r < 4 * TI_IN) {
        const int l = r / TI_IN; r -= l * TI_IN;
        const int kb = r / (NIN / 32), db = r % (NIN / 32), d0 = db * 32;
        int scol;
        if (d0 < 3072) scol = d0 + dl;
        else if (d0 < 4608) scol = d0 + 16 + dl;
        else if (d0 == 4608) scol = (dl < 16) ? 3072 + dl : -1;
        else scol = -1;
        t.W = in[6] + (size_t)l * D * IN_W; t.gain = in[5] + l * D; t.WT = WIN + (size_t)l * WIN_STRIDE; t.K = D; t.N = IN_W; t.drow0 = d0; t.scol = scol; t.k0 = kb * 64; return;
    }
    r -= 4 * TI_IN;
    { const int l = r / TI_OUT; r -= l * TI_OUT; const int kb = r / (D / 32), db = r % (D / 32);
      t.W = in[15] + (size_t)l * D * D; t.gain = nullptr; t.WT = WOUT + (size_t)l * WOUT_STRIDE; t.K = D; t.N = D; t.drow0 = db * 32; t.scol = db * 32 + dl; t.k0 = kb * 64; }
}

__device__ __forceinline__ void mall_touch(const void* p, size_t bytes, int gw, int lane, int NGW) {
    const GAS u32x4* tp = (const GAS u32x4*)p;
    const size_t nv = bytes / 16, st = (size_t)NGW * 64;
    unsigned a = 0u;
    for (size_t o = (size_t)gw * 64 + lane; o < nv; o += 4 * st) {
        u32x4 v[4];
#pragma unroll
        for (int j = 0; j < 4; ++j) { const size_t q = o + j * st; v[j] = tp[q < nv ? q : o]; }
#pragma unroll
        for (int j = 0; j < 4; ++j) a |= v[j].x;
    }
    asm volatile("" :: "v"(a));
}
__device__ __forceinline__ void build_rstd(const float* part, int pm, LAS float* tab, int tid) {
    const int r = tid >> 1, hf = tid & 1;
    const f32x4* p = (const f32x4*)(part + (size_t)(pm * 256 + r) * 32 + hf * 16);
    const f32x4 a = p[0], b = p[1], c = p[2], d = p[3];
    float s = ((a.x + a.y) + (a.z + a.w)) + ((b.x + b.y) + (b.z + b.w)) + ((c.x + c.y) + (c.z + c.w)) + ((d.x + d.y) + (d.z + d.w));
    s += pg8::shx(s, tid & 63, 1);
    if (!hf) tab[r] = rsqrtf(s * (1.0f / D) + RMS_EPS);
    __syncthreads();
}

__global__ void __launch_bounds__(NWAVES * 64, 2) fwd(Args args) {
    extern __shared__ __attribute__((aligned(16))) unsigned char lds[];
    LAS unsigned char* const L = (LAS unsigned char*)lds;
    volatile LAS unsigned* const MISC = (volatile LAS unsigned*)(L + MISC_OFF);
    LAS float* const rstd_tab = (LAS float*)(L + RSTD_OFF);
    const int G = gridDim.x, bx = blockIdx.x, NGW = G * NWAVES, NGT = G * NWAVES * 64;
#define LANE_IDS() WS_BASE(); int tid = threadIdx.x; asm volatile("" : "+v"(tid)); const int lane = tid & 63, wave = __builtin_amdgcn_readfirstlane(tid >> 6); \
    const int gw = bx * NWAVES + wave; const int gt = bx * (NWAVES * 64) + tid; (void)lane; (void)gw; (void)gt
    gu32* const ctl = (gu32*)(args.ws + WS_CTL);
#define WS_BASE() __attribute__((address_space(1))) unsigned char* wsg_ = (__attribute__((address_space(1))) unsigned char*)args.ws; asm volatile("" : "+s"(wsg_)); unsigned char* wsb_ = (unsigned char*)wsg_;     \
    int bx = blockIdx.x; asm volatile("" : "+s"(bx))
#define WSP(T, off) ((T*)(wsb_ + (off)))
#define WGU WSP(bf16, WS_WGU)
#define WD WSP(bf16, WS_WD)
#define WIN WSP(bf16, WS_WIN)
#define WOUT WSP(bf16, WS_WOUT)
#define H WSP(float, WS_H)
#define HB WSP(bf16, WS_HB)
#define PART WSP(float, WS_PART)
#define DTRAW WSP(float, WS_DTRAW)
#define DT WSP(float, WS_DT)
#define ACT WSP(bf16, WS_ACT)
#define PROJ WSP(bf16, WS_PROJ)
#define MIXED WSP(bf16, WS_MIXED)
#define XT WSP(bf16, WS_XT)
#define WTG WSP(float, WS_XTS)
#define BC WSP(bf16, WS_BC)
#define BCT WSP(bf16, WS_BCT)
#define CC WSP(bf16, WS_CC)
#define PWT WSP(bf16, WS_PWT)
#define CS WSP(float, WS_CS)
#define ST WSP(float, WS_ST)
#define SIN WSP(bf16, WS_SIN)

    for (int u = threadIdx.x; u < (LDS_BYTES - LDSCTL_OFF) / 4; u += NWAVES * 64) ((LAS unsigned*)(L + LDSCTL_OFF))[u] = 0u;
    __syncthreads();
    const int lo = args.ph_lo, hi = args.ph_hi;
    XcdBarrier bar; bar.bar = (unsigned*)(ctl + CW_BAR); bar.x = 0; bar.st = nullptr;
    if (hi - lo > 1) bar = xcd_barrier_post((unsigned*)(ctl + CW_BAR), MISC + 8);
    int ps = 0;
#define PH_ON (ps >= lo && ps < hi)
#define PH_END do { if (PH_ON && ps + 1 < hi) xcd_barrier(bar); ++ps; } while (0)
    static_assert(RSTD_OFF + 8192 + 4096 + 1024 <= LDS_BYTES, "LDS map: the barrier's junk KiB lies above everything any phase uses");
#define PH_END_T(p_, n_) do { if (PH_ON && ps + 1 < hi) xcd_barrier(bar, (const void*)(p_), (unsigned)(n_), L + RSTD_OFF + 8192 + 4096); ++ps; } while (0)

#ifndef NO_PRO
    if (PH_ON) for (int rep_ = 0; rep_ < REP_PRO; ++rep_) { if (rep_) __syncthreads();
        LANE_IDS();
        for (int it = gw; it < TI_TOTAL; it += 2 * NGW) {
            TItem ta, tb; f32x4 va[8], vb[8], ga0, ga1, gb0, gb1;
            const bool two = (it + NGW < TI_TOTAL);
            titem_decode(it, lane, args.in, WGU, WD, WIN, WOUT, ta);
            titem_decode(two ? it + NGW : it, lane, args.in, WGU, WD, WIN, WOUT, tb);
            titem_load(ta, lane, va, ga0, ga1);
            titem_load(tb, lane, vb, gb0, gb1);
            titem_store(ta, lane, va, ga0, ga1);
            if (two) titem_store(tb, lane, vb, gb0, gb1);
        }
        for (int idx = gt; idx < 4 * 4 * 128 * 128; idx += NGT) { const int c = idx & 127, d = (idx >> 7) & 127, li = idx >> 14; PWT[idx] = (bf16)f2bf(args.in[7][((size_t)li * 128 + c) * 128 + d]); }
        for (int m = gw; m < M; m += NGW) {
            const GAS f32x4* xr = (const GAS f32x4*)(args.in[0] + (size_t)m * D) + lane;
            GAS unsigned long long* o8 = (GAS unsigned long long*)(HB + (size_t)m * D) + lane;
            float ss = 0.f;
            f32x4 xv[8];
#pragma unroll
            for (int j = 0; j < 8; ++j) xv[j] = xr[64 * j];
            __builtin_amdgcn_sched_barrier(0);
#pragma unroll
            for (int j = 0; j < 8; ++j) { const f32x4 v = xv[j]; const unsigned p0 = pk2(v.x, v.y), p1 = pk2(v.z, v.w);
                const float r0 = __builtin_bit_cast(float, p0 << 16), r1 = __builtin_bit_cast(float, p0 & 0xffff0000u), r2 = __builtin_bit_cast(float, p1 << 16), r3 = __builtin_bit_cast(float, p1 & 0xffff0000u);
                ss += (r0 * r0 + r1 * r1) + (r2 * r2 + r3 * r3);
                o8[64 * j] = (unsigned long long)p0 | ((unsigned long long)p1 << 32); }
            ss = wave_sum(ss, lane);
            if (lane < 32) PART[(size_t)m * 32 + lane] = (lane == 0) ? ss : 0.f;
        }
    }
#endif
    PH_END;

    for (int i = 0; i < 8; ++i) {
        const int l = i >> 1, second = i & 1;
#ifndef NO_UP
        if (PH_ON) for (int rep_ = 0; rep_ < REP_UP; ++rep_) { if (rep_) __syncthreads();
            LANE_IDS();
            pg8::StaticOrder S; S.init(M, NGU, G, bx); pg8::Unit u0; S.next(0, u0);
            pg8::Gemm g{HB, WGU + (size_t)i * WGU_STRIDE, M, NGU, D};
            pg8::EpiSwiGLU E{ACT, FF, rstd_tab};
            pg8::gemm_phase<pg8::EpiSwiGLU, pg8::StaticOrder, true, true, true>(L + RING_OFF, g, S, E, PART, rstd_tab, 1.0f / D, RMS_EPS);
        }
#endif
        PH_END_T(args.ws + WS_WD + (size_t)i * WD_STRIDE * 2, WD_STRIDE * 2);
#ifndef NO_DOWN
        if (PH_ON) {
            WS_BASE();
            pg8::StaticOrder S; S.init(M, D, G, bx);
            pg8::Gemm g{ACT, WD + (size_t)i * WD_STRIDE, M, D, FF};
            pg8::EpiResid E{HB, PART, 0.5f / REP_DOWN};
            pg8::gemm_phase<pg8::EpiResid, pg8::StaticOrder, true, true>(L + RING_OFF, g, S, E);
        }
#if REP_DOWN == 2
        if (PH_ON) {
            WS_BASE();
            pg8::StaticOrder S; S.init(M, D, G, bx);
            pg8::Gemm g{ACT, WD + (size_t)i * WD_STRIDE, M, D, FF};
            pg8::EpiResid E{HB, PART, 0.5f / REP_DOWN};
            pg8::gemm_phase<pg8::EpiResid, pg8::StaticOrder, true, true>(L + RING_OFF, g, S, E);
        }
#endif
#endif
        if (!second) { PH_END_T(args.ws + WS_WIN + (size_t)l * WIN_STRIDE * 2, (size_t)PROJ_LD * D * 2); }
        else if (i < 7) { PH_END_T(args.ws + WS_WGU + (size_t)(i + 1) * WGU_STRIDE * 2, WGU_STRIDE * 2); }
        else { PH_END; }
        if (second) continue;
#ifndef NO_WIN
        if (PH_ON) for (int rep_ = 0; rep_ < REP_WIN; ++rep_) { if (rep_) __syncthreads();
            LANE_IDS();
            pg8::StaticOrder S; S.init(M, PROJ_LD, G, bx); pg8::Unit u0; S.next(0, u0);
            pg8::Gemm g{HB, WIN + (size_t)l * WIN_STRIDE, M, PROJ_LD, D};
            pg8::EpiProj E{PROJ, DTRAW, rstd_tab};
            pg8::gemm_phase<pg8::EpiProj, pg8::StaticOrder, true, true, true>(L + RING_OFF, g, S, E, PART, rstd_tab, 1.0f / D, RMS_EPS);
            if (bx >= 128) {
                const int u = (bx - 128) * NWAVES + wave, rw0 = u * 16, lr = lane & 15, lq = lane >> 4;
                const bf16* Ap = HB + (size_t)(rw0 + lr) * D + lq * 8;
                const bf16* Bp = WIN + (size_t)l * WIN_STRIDE + (size_t)(PROJ_LD + lr) * D + lq * 8;
                float ssq; { const f32x4* pp = (const f32x4*)(PART + (size_t)(rw0 + lr) * 32 + lq * 8); const f32x4 a = pp[0], b = pp[1]; ssq = ((a.x + a.y) + (a.z + a.w)) + ((b.x + b.y) + (b.z + b.w)); }
                ssq += pg8::shx(ssq, lane, 16); ssq += pg8::shx(ssq, lane, 32);
                const float rsr = rsqrtf(ssq * (1.0f / D) + RMS_EPS);
                f32x4 dacc = {0.f, 0.f, 0.f, 0.f};
#pragma unroll 1
                for (int ks0 = 0; ks0 < D / 32; ks0 += 16) {
                    bf16x8 af[16], bfr[16];
#pragma unroll
                    for (int j = 0; j < 16; ++j) { af[j] = *(const bf16x8*)(Ap + (ks0 + j) * 32); bfr[j] = *(const bf16x8*)(Bp + (ks0 + j) * 32); }
                    __builtin_amdgcn_sched_barrier(0);
#pragma unroll
                    for (int j = 0; j < 16; ++j) dacc = __builtin_amdgcn_mfma_f32_16x16x32_bf16(af[j], bfr[j], dacc, 0, 0, 0);
                }
#pragma unroll
                for (int r = 0; r < 4; ++r) { const int row = lq * 4 + r; DTRAW[(size_t)(rw0 + row) * 16 + lr] = dacc[r] * pg8::shl_(rsr, row); }
            }
        }
#endif
        PH_END;
#ifndef NO_M1
        if (PH_ON) for (int rep_ = 0; rep_ < REP_MIX; ++rep_) { if (rep_) __syncthreads();
            LANE_IDS();
            {
                const int r32 = lane & 31, hi = lane >> 5;
                const float* pscale = args.in[8] + l * 512;
                LAS unsigned char* pst = L + RING_OFF + wave * 12288;
                for (int u = gw; u < (M / 32) * 4; u += NGW) {
                    const int gi = u & 3, r0 = (u >> 2) * 32, w = 2 << gi;
                    const int t = (r0 % SEQ) + r32, cnt = (t + 1 < w) ? t + 1 : w; const float inv = 1.0f / (float)cnt;
                    const int seq0 = r0 - (r0 % SEQ);
                    asm volatile("s_waitcnt lgkmcnt(0)" ::: "memory");
#pragma unroll
                    for (int i = 0; i < 12; ++i) { const int row = 4 * i + (lane >> 4), slot = lane & 15, chunk = slot ^ (row & 15);
                        int grow = r0 - 15 + row; grow = grow < seq0 ? seq0 : grow; grow = grow > r0 + 31 ? r0 + 31 : grow;
                        __builtin_amdgcn_global_load_lds((const unsigned*)(PROJ + (size_t)grow * PROJ_LD + P_POOL + gi * 128 + chunk * 8), (LAS unsigned*)(pst + i * 1024), 16, 0, 0); }
                    const bf16* wt = PWT + ((size_t)(l * 4 + gi) * 128 + r32) * 128 + hi * 8;
                    bf16x8 wa0 = *(const bf16x8*)(wt), wa1 = *(const bf16x8*)(wt + 32 * 128), wa2 = *(const bf16x8*)(wt + 64 * 128), wa3 = *(const bf16x8*)(wt + 96 * 128);
                    f32x16 acc0 = {}, acc1 = {}, acc2 = {}, acc3 = {};
                    asm volatile("s_waitcnt vmcnt(0)" ::: "memory");
#define POOL_RD(rr, c) (*(const LAS v4u*)(pst + (rr) * 256 + ((((c) ^ (rr)) & 15) << 4)))
#define POOL_ADD(j) do { const int rr_ = 15 + r32 - (j); const v4u r_ = POOL_RD(rr_, c_); const bool ok = ((j) < cnt); const unsigned rx = ok ? r_.x : 0u, ry = ok ? r_.y : 0u, rz = ok ? r_.z : 0u, rw = ok ? r_.w : 0u; \
                            sum[0] += __builtin_bit_cast(float, rx << 16); sum[1] += __builtin_bit_cast(float, rx & 0xffff0000u); sum[2] += __builtin_bit_cast(float, ry << 16); sum[3] += __builtin_bit_cast(float, ry & 0xffff0000u); \
                            sum[4] += __builtin_bit_cast(float, rz << 16); sum[5] += __builtin_bit_cast(float, rz & 0xffff0000u); sum[6] += __builtin_bit_cast(float, rw << 16); sum[7] += __builtin_bit_cast(float, rw & 0xffff0000u); } while (0)
#define POOL_KSTEPS(W) _Pragma("unroll 1") for (int ks = 0; ks < 8; ++ks) { \
                        const int c_ = 2 * ks + hi; const int kn_ = (ks < 7) ? ks + 1 : 7; \
                        const bf16x8 wn0 = *(const bf16x8*)(wt + kn_ * 16), wn1 = *(const bf16x8*)(wt + 32 * 128 + kn_ * 16), wn2 = *(const bf16x8*)(wt + 64 * 128 + kn_ * 16), wn3 = *(const bf16x8*)(wt + 96 * 128 + kn_ * 16);     asm volatile("" ::: "memory");     \
                        float sum[8], self[8]; \
                        { const v4u r0_ = POOL_RD(15 + r32, c_); \
                          self[0] = __builtin_bit_cast(float, r0_.x << 16); self[1] = __builtin_bit_cast(float, r0_.x & 0xffff0000u); self[2] = __builtin_bit_cast(float, r0_.y << 16); self[3] = __builtin_bit_cast(float, r0_.y & 0xffff0000u); \
                          self[4] = __builtin_bit_cast(float, r0_.z << 16); self[5] = __builtin_bit_cast(float, r0_.z & 0xffff0000u); self[6] = __builtin_bit_cast(float, r0_.w << 16); self[7] = __builtin_bit_cast(float, r0_.w & 0xffff0000u); } \
                        _Pragma("unroll") for (int e = 0; e < 8; ++e) sum[e] = self[e]; \
                        _Pragma("unroll 4") for (int j = 1; j < W; ++j) POOL_ADD(j); \
                        u32x4 q; q.x = cvtpk_s(sum[0] * inv - self[0], sum[1] * inv - self[1]); q.y = cvtpk_s(sum[2] * inv - self[2], sum[3] * inv - self[3]); \
                        q.z = cvtpk_s(sum[4] * inv - self[4], sum[5] * inv - self[5]); q.w = cvtpk_s(sum[6] * inv - self[6], sum[7] * inv - self[7]); \
                        const bf16x8 bfr = __builtin_bit_cast(bf16x8, q); \
                        acc0 = __builtin_amdgcn_mfma_f32_32x32x16_bf16(wa0, bfr, acc0, 0, 0, 0); acc1 = __builtin_amdgcn_mfma_f32_32x32x16_bf16(wa1, bfr, acc1, 0, 0, 0); \
                        acc2 = __builtin_amdgcn_mfma_f32_32x32x16_bf16(wa2, bfr, acc2, 0, 0, 0); acc3 = __builtin_amdgcn_mfma_f32_32x32x16_bf16(wa3, bfr, acc3, 0, 0, 0); \
                        wa0 = wn0; wa1 = wn1; wa2 = wn2; wa3 = wn3; }
                    if (gi == 0) { POOL_KSTEPS(2) } else if (gi == 1) { POOL_KSTEPS(4) } else if (gi == 2) { POOL_KSTEPS(8) } else { POOL_KSTEPS(16) }
#undef POOL_KSTEPS
#undef POOL_ADD
#undef POOL_RD
                    f32x4 psc[4][4];
                    { const float* sp_ = pscale + gi * 128 + 4 * hi;
#pragma unroll
                      for (int rq = 0; rq < 4; ++rq) { psc[rq][0] = *(const f32x4*)(sp_ + 8 * rq); psc[rq][1] = *(const f32x4*)(sp_ + 32 + 8 * rq); psc[rq][2] = *(const f32x4*)(sp_ + 64 + 8 * rq); psc[rq][3] = *(const f32x4*)(sp_ + 96 + 8 * rq); } }
                    __builtin_amdgcn_sched_barrier(0);
                    typedef unsigned u32x2 __attribute__((ext_vector_type(2)));
                    asm volatile("s_waitcnt lgkmcnt(0)" ::: "memory");
#pragma unroll
                    for (int rq = 0; rq < 4; ++rq) {
                        const f32x4 s0 = psc[rq][0], s1 = psc[rq][1], s2 = psc[rq][2], s3 = psc[rq][3];
                        u32x2 o; LAS unsigned char* tp_ = pst + r32 * 272 + rq * 16 + hi * 8;
                        o.x = pk2(acc0[4 * rq] * s0.x, acc0[4 * rq + 1] * s0.y); o.y = pk2(acc0[4 * rq + 2] * s0.z, acc0[4 * rq + 3] * s0.w); *(LAS u32x2*)(tp_) = o;
                        o.x = pk2(acc1[4 * rq] * s1.x, acc1[4 * rq + 1] * s1.y); o.y = pk2(acc1[4 * rq + 2] * s1.z, acc1[4 * rq + 3] * s1.w); *(LAS u32x2*)(tp_ + 64) = o;
                        o.x = pk2(acc2[4 * rq] * s2.x, acc2[4 * rq + 1] * s2.y); o.y = pk2(acc2[4 * rq + 2] * s2.z, acc2[4 * rq + 3] * s2.w); *(LAS u32x2*)(tp_ + 128) = o;
                        o.x = pk2(acc3[4 * rq] * s3.x, acc3[4 * rq + 1] * s3.y); o.y = pk2(acc3[4 * rq + 2] * s3.z, acc3[4 * rq + 3] * s3.w); *(LAS u32x2*)(tp_ + 192) = o;
                    }
                    bf16* op = MIXED + (size_t)(r0 + (lane >> 4)) * D + gi * 128 + (lane & 15) * 8;
#pragma unroll
                    for (int j = 0; j < 8; ++j) *(u32x4*)(op + (size_t)(4 * j) * D) = *(const LAS u32x4*)(pst + ((lane >> 4) + 4 * j) * 272 + (lane & 15) * 16);
                }
            }
            {
                const int r32 = lane & 31, hi = lane >> 5;
                LAS unsigned char* vst = L + RING_OFF + wave * 12288;
                const int wkey = lane >> 3, wcc = lane & 7, woff = (wcc >> 2) * 4096 + (wcc & 3) * 16 + wkey * 64;
                typedef short v4i16_t __attribute__((ext_vector_type(4)));
                LAS v4i16_t* vrd = (LAS v4i16_t*)(vst + ((lane >> 4) & 1) * 32 + (lane & 3) * 8 + (4 * hi + ((lane & 15) >> 2)) * 64);
                for (int ra_ = 0; ra_ < REP_ATT; ++ra_) for (int u = gw; u < 2 * 8 * 256; u += NGW) {
                    const int qt = u & 255, hh = (u >> 8) & 7, b = u >> 11, q0 = qt * 32;
                    const bf16* Pb = PROJ + (size_t)b * SEQ * PROJ_LD + hh * 64;
                    bf16x8 qf[4];
#pragma unroll
                    for (int d0 = 0; d0 < 4; ++d0) { const v4u raw = *(const v4u*)(Pb + (size_t)(q0 + r32) * PROJ_LD + P_Q + d0 * 16 + hi * 8); v4u sc;
                        sc.x = pk2(__builtin_bit_cast(float, raw.x << 16) * 0.125f, __builtin_bit_cast(float, raw.x & 0xffff0000u) * 0.125f); sc.y = pk2(__builtin_bit_cast(float, raw.y << 16) * 0.125f, __builtin_bit_cast(float, raw.y & 0xffff0000u) * 0.125f);
                        sc.z = pk2(__builtin_bit_cast(float, raw.z << 16) * 0.125f, __builtin_bit_cast(float, raw.z & 0xffff0000u) * 0.125f); sc.w = pk2(__builtin_bit_cast(float, raw.w << 16) * 0.125f, __builtin_bit_cast(float, raw.w & 0xffff0000u) * 0.125f);
                        qf[d0] = __builtin_bit_cast(bf16x8, sc); }
                    float carry = 0.f; f32x16 o0 = {}, o1 = {};
                    bf16x8 kn[8];
                    v4u vn[8];
#define ATT_LOAD(kt_) do { const bf16* Kb_ = Pb + (size_t)((kt_) * 64 + r32) * PROJ_LD + P_K + hi * 8; \
        _Pragma("unroll") for (int d0 = 0; d0 < 4; ++d0) { kn[2 * d0] = *(const bf16x8*)(Kb_ + d0 * 16); kn[2 * d0 + 1] = *(const bf16x8*)(Kb_ + (size_t)32 * PROJ_LD + d0 * 16); } \
        _Pragma("unroll") for (int i_ = 0; i_ < 8; ++i_) vn[i_] = *(const v4u*)(Pb + (size_t)((kt_) * 64 + wkey + 8 * i_) * PROJ_LD + P_V + wcc * 8); } while (0)
                    ATT_LOAD(q0 >> 6);
                    for (int kt = q0 >> 6; kt >= 0; --kt) {
                        bf16x8 kc[8]; v4u vc[8];
#pragma unroll
                        for (int i = 0; i < 8; ++i) { kc[i] = kn[i]; vc[i] = vn[i]; }
                        ATT_LOAD(kt > 0 ? kt - 1 : 0);
                        asm volatile("" ::: "memory");
                        f32x16 p0 = {}, p1 = {};
#pragma unroll
                        for (int d0 = 0; d0 < 4; ++d0) { p0 = __builtin_amdgcn_mfma_f32_32x32x16_bf16(kc[2 * d0], qf[d0], p0, 0, 0, 0); p1 = __builtin_amdgcn_mfma_f32_32x32x16_bf16(kc[2 * d0 + 1], qf[d0], p1, 0, 0, 0); }
#pragma unroll
                        for (int i = 0; i < 8; ++i) *(LAS v4u*)(vst + woff + (i >> 1) * 1024 + (i & 1) * 512) = vc[i];
                        const int lim = q0 + r32 - kt * 64;
                        float sp0[16], sp1[16];
#pragma unroll
                        for (int r = 0; r < 16; ++r) { const int kl = (r & 3) + 8 * (r >> 2) + 4 * hi;
                            const float z0 = p0[r], z1 = p1[r];
                            const float s0_ = fmaxf(z0, 0.f) + 0.6931471806f * __builtin_amdgcn_logf(1.0f + __builtin_amdgcn_exp2f(-1.4426950409f * fabsf(z0)));
                            const float s1_ = fmaxf(z1, 0.f) + 0.6931471806f * __builtin_amdgcn_logf(1.0f + __builtin_amdgcn_exp2f(-1.4426950409f * fabsf(z1)));
                            sp0[r] = (kl < lim) ? s0_ : 0.f; sp1[r] = (kl + 32 < lim) ? s1_ : 0.f; }
                        float PS[9], PSp[9];
                        PS[8] = 0.f; PSp[8] = 0.f;
#pragma unroll
                        for (int idx = 7; idx >= 0; --idx) { const int rq = idx & 3; const float gsum = (idx < 4) ? (sp0[4 * rq] + sp0[4 * rq + 1]) + (sp0[4 * rq + 2] + sp0[4 * rq + 3]) : (sp1[4 * rq] + sp1[4 * rq + 1]) + (sp1[4 * rq + 2] + sp1[4 * rq + 3]);
                            PS[idx] = PS[idx + 1] + gsum; }
#pragma unroll
                        for (int idx = 0; idx < 8; ++idx) PSp[idx] = pg8::shx(PS[idx], lane, 32);
#pragma unroll
                        for (int idx = 0; idx < 8; ++idx) { const int rq = idx & 3;
                            float run = carry + PS[idx + 1] + (hi ? PSp[idx + 1] : PSp[idx]);
#pragma unroll
                            for (int e = 3; e >= 0; --e) { const int r = 4 * rq + e, kl = e + 8 * rq + 4 * hi + ((idx < 4) ? 0 : 32);
                                if (idx < 4) { run += sp0[r]; const float w = __builtin_amdgcn_exp2f(1.4426950409f * (p0[r] - run)); p0[r] = (kl < lim) ? w : 0.f; }
                                else         { run += sp1[r]; const float w = __builtin_amdgcn_exp2f(1.4426950409f * (p1[r] - run)); p1[r] = (kl < lim) ? w : 0.f; } } }
                        carry += PS[0] + PSp[0];
                        u32x4 a0, a1, a2, a3;
                        a0.x = cvtpk_s(p0[0], p0[1]); a0.y = cvtpk_s(p0[2], p0[3]); a0.z = cvtpk_s(p0[4], p0[5]); a0.w = cvtpk_s(p0[6], p0[7]);
                        a1.x = cvtpk_s(p0[8], p0[9]); a1.y = cvtpk_s(p0[10], p0[11]); a1.z = cvtpk_s(p0[12], p0[13]); a1.w = cvtpk_s(p0[14], p0[15]);
                        a2.x = cvtpk_s(p1[0], p1[1]); a2.y = cvtpk_s(p1[2], p1[3]); a2.z = cvtpk_s(p1[4], p1[5]); a2.w = cvtpk_s(p1[6], p1[7]);
                        a3.x = cvtpk_s(p1[8], p1[9]); a3.y = cvtpk_s(p1[10], p1[11]); a3.z = cvtpk_s(p1[12], p1[13]); a3.w = cvtpk_s(p1[14], p1[15]);
                        const bf16x8 pa[4] = {__builtin_bit_cast(bf16x8, a0), __builtin_bit_cast(bf16x8, a1), __builtin_bit_cast(bf16x8, a2), __builtin_bit_cast(bf16x8, a3)};
#pragma unroll
                        for (int ks = 0; ks < 4; ++ks) {
                            const v4i16_t l0 = __builtin_amdgcn_ds_read_tr16_b64_v4i16(vrd + (ks * 1024) / 8), h0 = __builtin_amdgcn_ds_read_tr16_b64_v4i16(vrd + (ks * 1024 + 512) / 8);
                            const v4i16_t l1 = __builtin_amdgcn_ds_read_tr16_b64_v4i16(vrd + (4096 + ks * 1024) / 8), h1 = __builtin_amdgcn_ds_read_tr16_b64_v4i16(vrd + (4096 + ks * 1024 + 512) / 8);
                            const bf16x8 v0 = (bf16x8){l0[0], l0[1], l0[2], l0[3], h0[0], h0[1], h0[2], h0[3]}, v1 = (bf16x8){l1[0], l1[1], l1[2], l1[3], h1[0], h1[1], h1[2], h1[3]};
                            o0 = __builtin_amdgcn_mfma_f32_32x32x16_bf16(v0, pa[ks], o0, 0, 0, 0); o1 = __builtin_amdgcn_mfma_f32_32x32x16_bf16(v1, pa[ks], o1, 0, 0, 0);
                        }
                        if (__all(carry >= 88.f)) break;
                    }
#undef ATT_LOAD
                    typedef unsigned u32x2a __attribute__((ext_vector_type(2)));
#pragma unroll
                    for (int rq = 0; rq < 4; ++rq) { u32x2a w0, w1;
                        w0.x = pk2(o0[4 * rq], o0[4 * rq + 1]); w0.y = pk2(o0[4 * rq + 2], o0[4 * rq + 3]); w1.x = pk2(o1[4 * rq], o1[4 * rq + 1]); w1.y = pk2(o1[4 * rq + 2], o1[4 * rq + 3]);
                        *(LAS u32x2a*)(vst + r32 * 144 + rq * 16 + hi * 8) = w0; *(LAS u32x2a*)(vst + r32 * 144 + 64 + rq * 16 + hi * 8) = w1; }
                    bf16* Ob = MIXED + ((size_t)b * SEQ + q0 + (lane >> 3)) * D + 1536 + hh * 64 + (lane & 7) * 8;
#pragma unroll
                    for (int j = 0; j < 4; ++j) *(u32x4*)(Ob + (size_t)(8 * j) * D) = *(const LAS u32x4*)(vst + ((lane >> 3) + 8 * j) * 144 + (lane & 7) * 16);
                    asm volatile("s_waitcnt lgkmcnt(0)" ::: "memory");
                }
            }
            asm volatile("s_waitcnt lgkmcnt(0)\n\ts_barrier" ::: "memory");
            {
                const float* cw = args.in[9] + (size_t)l * 4 * 1536; const float* cb = args.in[10] + l * 1536; const float* dtb = args.in[11] + l * 16; const float* alog = args.in[12] + l * 16;
                { const int u = bx;
                    const int qt = u & 3, bc = u >> 2, r0 = bc * 256;
                    LAS unsigned char* img0 = L + RING_OFF + 16384;
                    const int tpos0 = r0 % SEQ;
#define S0_DMA(q_) do { LAS unsigned char* ib_ = img0 + ((q_) & 1) * 52224; \
        for (int i_ = wave; i_ < 51; i_ += NWAVES) { const int o_ = i_ * 1024 + lane * 16; int row_ = o_ / 768; const int col_ = o_ - row_ * 768; row_ = row_ > 66 ? 66 : row_; \
            int rel_ = 64 * (q_) - 3 + row_; rel_ = (tpos0 + rel_ < 0) ? 0 : rel_;                   \
            __builtin_amdgcn_global_load_lds((const unsigned*)(PROJ + (size_t)(r0 + rel_) * PROJ_LD + P_XBC + qt * 384 + (col_ >> 1)), (LAS unsigned*)(ib_ + i_ * 1024), 16, 0, 0); } } while (0)
                    S0_DMA(0);
                    if (qt == 0) { const int h = tid >> 5, seg = tid & 31; const float A = -__expf(alog[h]), bias = dtb[h];
                      float dtv[8], cs[8]; float run = 0.f;
#pragma unroll
                      for (int k = 0; k < 8; ++k) dtv[k] = DTRAW[(size_t)(r0 + seg * 8 + k) * 16 + h];
                      __builtin_amdgcn_sched_barrier(0);
#pragma unroll
                      for (int k = 0; k < 8; ++k) { dtv[k] = softplus_f(dtv[k] + bias); run += A * dtv[k]; cs[k] = run; }
                      float incl = run;
#pragma unroll
                      for (int d = 1; d < 32; d <<= 1) { const float v = pg8::shl_(incl, (seg >= d) ? lane - d : lane); if (seg >= d) incl += v; }
                      const float excl = incl - run, total = pg8::shl_(incl, lane | 31);
#pragma unroll
                      for (int k = 0; k < 8; ++k) { const float c_ = excl + cs[k]; WTG[(size_t)(bc * 16 + h) * 256 + seg * 8 + k] = dtv[k] * __expf(total - c_); CS[(size_t)(r0 + seg * 8 + k) * 16 + h] = c_; DT[(size_t)(r0 + seg * 8 + k) * 16 + h] = dtv[k]; } }
                    const int rsq = tid & 7, cgl = tid >> 3;
                    const int cg = qt * 48 + cgl, ch0 = cg * 8;
                    float cwr[4][8], cbr[8];
#pragma unroll
                    for (int e = 0; e < 8; ++e) { cwr[0][e] = cw[0 * 1536 + ch0 + e]; cwr[1][e] = cw[1 * 1536 + ch0 + e]; cwr[2][e] = cw[2 * 1536 + ch0 + e]; cwr[3][e] = cw[3 * 1536 + ch0 + e]; cbr[e] = cb[ch0 + e]; }
                    asm volatile("s_waitcnt vmcnt(0)" ::: "memory");
                    __syncthreads();
                    for (int q = 0; q < 4; ++q) {
                        if (q < 3) S0_DMA(q + 1);
                        if (tid < 384) {
                        const int s0 = 64 * q + rsq * 8;
                        const int t0 = tpos0 + s0;
                        const LAS unsigned char* ip = img0 + (q & 1) * 52224 + (rsq * 8) * 768 + cgl * 16;
                        float xin[11][8];
#pragma unroll
                        for (int k = 0; k < 11; ++k) { const bool ok = (t0 - 3 + k >= 0); v4u raw = *(const LAS v4u*)(ip + k * 768);
                            raw.x = ok ? raw.x : 0u; raw.y = ok ? raw.y : 0u; raw.z = ok ? raw.z : 0u; raw.w = ok ? raw.w : 0u;
                            xin[k][0] = __builtin_bit_cast(float, raw.x << 16); xin[k][1] = __builtin_bit_cast(float, raw.x & 0xffff0000u); xin[k][2] = __builtin_bit_cast(float, raw.y << 16); xin[k][3] = __builtin_bit_cast(float, raw.y & 0xffff0000u);
                            xin[k][4] = __builtin_bit_cast(float, raw.z << 16); xin[k][5] = __builtin_bit_cast(float, raw.z & 0xffff0000u); xin[k][6] = __builtin_bit_cast(float, raw.w << 16); xin[k][7] = __builtin_bit_cast(float, raw.w & 0xffff0000u); }
                        float o[8][8];
#pragma unroll
                        for (int e = 0; e < 8; ++e) { const float w0 = cwr[0][e], w1 = cwr[1][e], w2 = cwr[2][e], w3 = cwr[3][e], bb = cbr[e];
#pragma unroll
                            for (int j = 0; j < 8; ++j) o[j][e] = silu_f(bb + w0 * xin[j][e] + w1 * xin[j + 1][e] + w2 * xin[j + 2][e] + w3 * xin[j + 3][e]); }
#define S0_SWAP(a_) do { const bool odd_ = rsq & 1; const unsigned s0_ = odd_ ? a_.x : a_.z, s1_ = odd_ ? a_.y : a_.w; \
        const unsigned r0_ = (unsigned)__builtin_amdgcn_update_dpp(0, (int)s0_, 0xB1, 0xF, 0xF, true), r1_ = (unsigned)__builtin_amdgcn_update_dpp(0, (int)s1_, 0xB1, 0xF, 0xF, true); \
        a_ = odd_ ? (v4u){r0_, r1_, a_.z, a_.w} : (v4u){a_.x, a_.y, r0_, r1_}; } while (0)
                        if (cg < 128) {
                            const int h = cg >> 3, p0 = (cg & 7) * 8;
                            const size_t base = (size_t)(bc * 16 + h) * 16384 + (size_t)((((2 * q + (rsq >> 2)) * 4 + (p0 >> 5) * 2 + ((rsq >> 1) & 1)) * 64 + (rsq & 1) * 32 + (p0 & 31)) * 8);
#pragma unroll
                            for (int e = 0; e < 8; ++e) {
                                v4u a; a.x = pk2(o[0][e], o[1][e]); a.y = pk2(o[2][e], o[3][e]); a.z = pk2(o[4][e], o[5][e]); a.w = pk2(o[6][e], o[7][e]);
                                S0_SWAP(a);
                                *(v4u*)(XT + base + (size_t)e * 8) = a; }
                        } else if (cg < 160) {
                            const int gi = (cg - 128) >> 4, n0 = ((cg - 128) & 15) * 8;
#pragma unroll
                            for (int j = 0; j < 8; ++j) { v4u a; a.x = pk2(o[j][0], o[j][1]); a.y = pk2(o[j][2], o[j][3]); a.z = pk2(o[j][4], o[j][5]); a.w = pk2(o[j][6], o[j][7]);
                                *(v4u*)(BC + (size_t)(r0 + s0 + j) * 256 + gi * 128 + n0) = a; }
                            const size_t base = (size_t)(bc * 2 + gi) * 32768 + (size_t)(((((4 * q + (rsq >> 1)) * 4 + (n0 >> 5)) * 2 + (rsq & 1)) * 32 + (n0 & 31)) * 8);
#pragma unroll
                            for (int e = 0; e < 8; ++e) { v4u a; a.x = pk2(o[0][e], o[1][e]); a.y = pk2(o[2][e], o[3][e]); a.z = pk2(o[4][e], o[5][e]); a.w = pk2(o[6][e], o[7][e]);
                                S0_SWAP(a);
                                *(v4u*)(BCT + base + (size_t)e * 8) = a; }
                        } else {
                            const int gi = (cg - 160) >> 4, n0 = ((cg - 160) & 15) * 8;
#pragma unroll
                            for (int j = 0; j < 8; ++j) { v4u a; a.x = pk2(o[j][0], o[j][1]); a.y = pk2(o[j][2], o[j][3]); a.z = pk2(o[j][4], o[j][5]); a.w = pk2(o[j][6], o[j][7]);
                                *(v4u*)(CC + (size_t)(r0 + s0 + j) * 256 + gi * 128 + n0) = a; }
                        }
                        }
                        if (q < 3) {
                            const int nst = __builtin_amdgcn_readfirstlane((tid < 384) ? ((cg >= 128 && cg < 160) ? 16 : 8) : 0);
                            if (nst == 16) asm volatile("s_waitcnt vmcnt(16)" ::: "memory"); else if (nst == 8) asm volatile("s_waitcnt vmcnt(8)" ::: "memory"); else asm volatile("s_waitcnt vmcnt(0)" ::: "memory");
                        }
                        __syncthreads();
                    }
#undef S0_DMA
#undef S0_SWAP
                }
            }
        }
        PH_END;
#endif
#ifndef NO_M2
        if (PH_ON) for (int rep_ = 0; rep_ < REP_S1; ++rep_) { if (rep_) __syncthreads();
            LANE_IDS();
            const int r32 = lane & 31, hi = lane >> 5;
            for (int u = gw; u < 2 * 32 * 16 * 2; u += NGW) {
                const int nh = u & 1, h = (u >> 1) & 15, bc = u >> 5, g = h >> 3;
                const bf16* Ab = XT + (size_t)(bc * 16 + h) * 16384 + lane * 8;
                const float* Wb = WTG + (size_t)(bc * 16 + h) * 256 + hi * 4;
                const bf16* Bb = BCT + (size_t)(bc * 2 + g) * 32768 + (size_t)(nh * 2 * 64 * 8) + lane * 8;
                f32x16 acc00 = {}, acc01 = {}, acc10 = {}, acc11 = {};
#pragma unroll 1
                for (int kb = 0; kb < 16; kb += 4) {
                    f32x4 wl[4], wh[4]; v4u ar0[4], ar1[4]; bf16x8 b0[4], b1[4];
#pragma unroll
                    for (int j = 0; j < 4; ++j) { const int ks = kb + j;
                        wl[j] = *(const f32x4*)(Wb + ks * 16); wh[j] = *(const f32x4*)(Wb + ks * 16 + 8);
                        const bf16* ap_ = Ab + (((ks >> 1) * 4 + (ks & 1)) * 64) * 8;
                        ar0[j] = *(const v4u*)(ap_); ar1[j] = *(const v4u*)(ap_ + 2 * 64 * 8);
                        b0[j] = *(const bf16x8*)(Bb + (ks * 4) * 64 * 8); b1[j] = *(const bf16x8*)(Bb + (ks * 4 + 1) * 64 * 8); }
                    __builtin_amdgcn_sched_barrier(0);
#pragma unroll
                    for (int j = 0; j < 4; ++j) {
                        const bf16x8 a0 = scale_frag(ar0[j], wl[j], wh[j]), a1 = scale_frag(ar1[j], wl[j], wh[j]);
                        acc00 = __builtin_amdgcn_mfma_f32_32x32x16_bf16(a0, b0[j], acc00, 0, 0, 0); acc01 = __builtin_amdgcn_mfma_f32_32x32x16_bf16(a0, b1[j], acc01, 0, 0, 0);
                        acc10 = __builtin_amdgcn_mfma_f32_32x32x16_bf16(a1, b0[j], acc10, 0, 0, 0); acc11 = __builtin_amdgcn_mfma_f32_32x32x16_bf16(a1, b1[j], acc11, 0, 0, 0);
                    }
                }
                float* Sb = ST + (size_t)(bc * 16 + h) * 8192 + nh * 64 + r32;
#pragma unroll
                for (int r = 0; r < 16; ++r) { const int p = (r & 3) + 8 * (r >> 2) + 4 * hi;
                    Sb[(size_t)p * 128] = acc00[r]; Sb[(size_t)p * 128 + 32] = acc01[r]; Sb[(size_t)(p + 32) * 128] = acc10[r]; Sb[(size_t)(p + 32) * 128 + 32] = acc11[r]; }
            }
        }
        PH_END;
        if (PH_ON) for (int rep_ = 0; rep_ < REP_S2; ++rep_) { if (rep_) __syncthreads();
            LANE_IDS();
            for (int id = gt; id < 2 * 16 * 64 * 64; id += NGT) {
                const int n = ((id >> 6) & 7) * 16 + ((id >> 5) & 1) * 8 + (id & 3) * 2, p = ((id >> 9) & 7) * 8 + ((id >> 2) & 7), h = (id >> 12) & 15, b = id >> 16;
                const int so = ((((p >> 5) * 8 + (n >> 4)) * 2 + ((n >> 3) & 1)) * 32 + (p & 31)) * 8 + (n & 7);
                float c0 = 0.f, c1 = 0.f;
#pragma unroll 1
                for (int cb = 0; cb < 32; cb += 16) {
                    float2 st[16]; float dl[16];
#pragma unroll
                    for (int j = 0; j < 16; ++j) { const int c = cb + j; st[j] = *(const float2*)(ST + (size_t)((b * 32 + c) * 16 + h) * 8192 + p * 128 + n); dl[j] = CS[(size_t)(b * SEQ + c * 256 + 255) * 16 + h]; }
                    __builtin_amdgcn_sched_barrier(0);
#pragma unroll
                    for (int j = 0; j < 16; ++j) { const int c = cb + j;
                        *(unsigned*)(SIN + (size_t)((b * 32 + c) * 16 + h) * 8192 + so) = pk2(c0, c1);
                        const float dec = __expf(dl[j]);
                        c0 = c0 * dec + st[j].x; c1 = c1 * dec + st[j].y; }
                }
            }
        }
        PH_END;
        if (PH_ON) for (int rep_ = 0; rep_ < REP_S3; ++rep_) { if (rep_) __syncthreads();
            LANE_IDS();
            const int r32 = lane & 31, hi = lane >> 5;
            LAS unsigned char* CBl = L + RING_OFF;
            LAS unsigned char* Cl = L + RING_OFF + 73728;
            LAS float* wcs = (LAS float*)(L + RING_OFF + 108544) + wave * 512;
            LAS float* ssb = (LAS float*)(L + RING_OFF + 124928);
            unsigned char* hpark = WSP(unsigned char, WS_Y) + ((size_t)bx * 8 + wave) * 8192;
            LAS float* ssb2 = (LAS float*)(L + RSTD_OFF + 8192);
            LAS float* wG = (LAS float*)(L + RSTD_OFF) + wave * 256;
            static_assert(RSTD_OFF + 8 * 1024 + 4096 <= LDS_BYTES && 108544 + 16384 <= 124928 && 124928 + 4096 <= RING_BYTES && 73728 + 128 * 272 <= 108544 && 18 * 4096 <= 73728 && 256 * 272 <= 73728, "S3 LDS map");
            const float* ng = args.in[14] + l * 1024;
            typedef unsigned u32x2 __attribute__((ext_vector_type(2)));
            if (bx < 256) { const int u = bx;
                const int parity = u & 1, g = (u >> 1) & 1, bc = u >> 2, h = g * 8 + wave, r0 = bc * 256;
                const float Dk = args.in[13][l * 16 + h];
                const int jt0 = parity, jt1 = 3 - parity, jt2 = 4 + parity, jt3 = 7 - parity;
                const int of1 = jt0 + 1, of2 = of1 + jt1 + 1, of3 = of2 + jt2 + 1;
                {
                    const bf16* bsrc = BC + (size_t)(r0 + (tid >> 4)) * 256 + g * 128 + (tid & 15) * 8;
                    LAS unsigned char* bdst = CBl + (tid >> 4) * 272 + (tid & 15) * 16;
                    v4u tb[8], tc[4]; float c_[4], d_[4], ce_[4];
#pragma unroll
                    for (int i = 0; i < 8; ++i) tb[i] = *(const v4u*)(bsrc + (size_t)i * 32 * 256);
#pragma unroll
                    for (int i = 0; i < 4; ++i) { const int jt_ = 4 * (i >> 1) + ((i & 1) ? 3 - parity : parity);
                        tc[i] = *(const v4u*)(CC + (size_t)(r0 + 32 * jt_ + (tid >> 4)) * 256 + g * 128 + (tid & 15) * 8); }
#pragma unroll
                    for (int i = 0; i < 4; ++i) { const int s_ = lane + 64 * i; c_[i] = CS[(size_t)(r0 + s_) * 16 + h]; d_[i] = DT[(size_t)(r0 + s_) * 16 + h]; ce_[i] = CS[(size_t)(r0 + (s_ | 31)) * 16 + h]; }
#pragma unroll
                    for (int i = 0; i < 8; ++i) *(LAS v4u*)(bdst + i * 32 * 272) = tb[i];
#pragma unroll
                    for (int i = 0; i < 4; ++i) *(LAS v4u*)(Cl + (32 * i + (tid >> 4)) * 272 + (tid & 15) * 16) = tc[i];
#pragma unroll
                    for (int i = 0; i < 4; ++i) { const int s_ = lane + 64 * i; wcs[s_] = c_[i]; wcs[256 + s_] = d_[i]; wG[s_] = __expf(ce_[i] - c_[i]) * d_[i]; }
                }
                const bf16* XTh = XT + (size_t)(bc * 16 + h) * 16384 + lane * 8;
                const bf16* SINh = SIN + (size_t)(bc * 16 + h) * 8192 + lane * 8;
                bf16x8 sa[8];
#define SLOAD(base_) do { _Pragma("unroll") for (int ks = 0; ks < 8; ++ks) sa[ks] = *(const GAS bf16x8*)((base_) + ks * 512); } while (0)
                SLOAD((const GAS bf16*)SINh);
                __syncthreads();
                {
                    f32x16 cb0 = {}, cb1 = {}, cb2 = {};
#define S3_CB(dst, t_) do { const int t__ = (t_); if (t__ < 18) { const int k__ = (t__ >= of1) + (t__ >= of2) + (t__ >= of3); const int i__ = t__ - (k__ == 0 ? 0 : k__ == 1 ? of1 : k__ == 2 ? of2 : of3); \
        const LAS unsigned char* bp_ = CBl + (32 * i__ + r32) * 272 + hi * 16; const LAS unsigned char* cp_ = Cl + (32 * k__ + r32) * 272 + hi * 16; \
        _Pragma("unroll") for (int ks = 0; ks < 8; ++ks) dst = __builtin_amdgcn_mfma_f32_32x32x16_bf16(*(const LAS bf16x8*)(bp_ + ks * 32), *(const LAS bf16x8*)(cp_ + ks * 32), dst, 0, 0, 0); } } while (0)
                    S3_CB(cb0, wave); S3_CB(cb1, wave + 8); S3_CB(cb2, wave + 16);
#undef S3_CB
                    __syncthreads();
#define S3_CBW(src, t_) do { const int t__ = (t_); if (t__ < 18) { LAS unsigned char* wp_ = CBl + t__ * 4096 + lane * 16; \
        *(LAS f32x4*)(wp_) = (f32x4){src[0], src[1], src[2], src[3]}; *(LAS f32x4*)(wp_ + 1024) = (f32x4){src[4], src[5], src[6], src[7]}; \
        *(LAS f32x4*)(wp_ + 2048) = (f32x4){src[8], src[9], src[10], src[11]}; *(LAS f32x4*)(wp_ + 3072) = (f32x4){src[12], src[13], src[14], src[15]}; } } while (0)
                    S3_CBW(cb0, wave); S3_CBW(cb1, wave + 8); S3_CBW(cb2, wave + 16);
#undef S3_CBW
                }
#define XLOAD(dst, i_, pt_) do { const GAS bf16* xb_ = XTp + (i_) * 2048; dst[0] = *(const GAS u32x4*)(xb_); dst[1] = *(const GAS u32x4*)(xb_ + 512); } while (0)
#define ZLOAD(jt_, pt_) do { const bf16* zp = PROJ + ((size_t)r0 + 32 * (jt_) + r32) * PROJ_LD + P_Z + h * 64 + (pt_) * 32 + 4 * hi; \
        _Pragma("unroll") for (int rq = 0; rq < 4; ++rq) zr[rq] = *(const u32x2*)(zp + 8 * rq); } while (0)
#pragma unroll 1
                for (int pt = 0; pt < 2; ++pt) {
                    int lane_ = lane; asm volatile("" : "+v"(lane_));
                    const int r32 = lane_ & 31, hi = lane_ >> 5, lane = lane_;
                    u32x4 xc[2], xn[2];
                    const GAS bf16* XTp = (const GAS bf16*)(XTh + pt * 1024); asm volatile("" : "+v"(XTp));
                    const GAS bf16* SINp = (const GAS bf16*)(SINh + 4096); asm volatile("" : "+v"(SINp));
                    XLOAD(xc, 0, pt);
                    asm volatile("" ::: "memory");
                    f32x16 o[4];
#pragma unroll
                    for (int k = 0; k < 4; ++k) {
                        const LAS unsigned char* cfp = Cl + (k * 32 + r32) * 272 + hi * 16;
                        f32x16 a0 = {};
#pragma unroll
                        for (int ks = 0; ks < 8; ++ks) a0 = __builtin_amdgcn_mfma_f32_32x32x16_bf16(sa[ks], *(const LAS bf16x8*)(cfp + ks * 32), a0, 0, 0, 0);
                        const float e = __expf(wcs[32 * ((k == 0) ? jt0 : (k == 1) ? jt1 : (k == 2) ? jt2 : jt3) + r32]);
#pragma unroll
                        for (int r = 0; r < 16; ++r) a0[r] *= e;
                        o[k] = a0;
                    }
                    if (pt == 0) __syncthreads();
                    u32x2 zr[4];
#pragma unroll
                    for (int i = 0; i < 8; ++i) {
                        const int kd = i >> 1, jtd = (kd == 0) ? jt0 : (kd == 1) ? jt1 : (kd == 2) ? jt2 : jt3;
                        if (i < 7 || jt3 == 7) {
                            if ((i & 1) == 0) { ZLOAD(jtd, pt); }
                            if (i < 7) { XLOAD(xn, i + 1, pt); }
                            if (i == 6 && pt == 0) { SLOAD(SINp); }
                            asm volatile("" ::: "memory");
                            const float cse = wcs[32 * i + 31];
#pragma unroll
                            for (int k = 0; k < 4; ++k) if (k >= kd) {
                                const bool dk_ = (k == kd);
                                const int jt = (k == 0) ? jt0 : (k == 1) ? jt1 : (k == 2) ? jt2 : jt3, ofk = (k == 0) ? 0 : (k == 1) ? of1 : (k == 2) ? of2 : of3;
                                if (!dk_ || i <= jt) {
                                    f32x16 mt; const float csl_ = wcs[32 * jt + r32];
                                    { const LAS unsigned char* rp_ = CBl + (ofk + i) * 4096 + lane * 16;
                                      const f32x4 m0 = *(const LAS f32x4*)(rp_), m1 = *(const LAS f32x4*)(rp_ + 1024), m2 = *(const LAS f32x4*)(rp_ + 2048), m3 = *(const LAS f32x4*)(rp_ + 3072);
                                      mt[0] = m0.x; mt[1] = m0.y; mt[2] = m0.z; mt[3] = m0.w; mt[4] = m1.x; mt[5] = m1.y; mt[6] = m1.z; mt[7] = m1.w;
                                      mt[8] = m2.x; mt[9] = m2.y; mt[10] = m2.z; mt[11] = m2.w; mt[12] = m3.x; mt[13] = m3.y; mt[14] = m3.z; mt[15] = m3.w; }
                                    if (!dk_ || i < jt) {
                                        const float El = __expf(csl_ - cse);
#pragma unroll
                                        for (int r = 0; r < 16; ++r) mt[r] *= El * wG[32 * i + (r & 3) + 8 * (r >> 2) + 4 * hi];
                                    } else {
                                        const int l_loc = 32 * jt + r32;
#pragma unroll
                                        for (int r = 0; r < 16; ++r) { const int s_loc = 32 * i + (r & 3) + 8 * (r >> 2) + 4 * hi;
                                            const float f = __expf(csl_ - wcs[s_loc]) * wcs[256 + s_loc];
                                            float v = mt[r] * f;
                                            v = (s_loc > l_loc) ? 0.f : v; v += (s_loc == l_loc) ? Dk : 0.f;
                                            mt[r] = v; }
                                    }
                                    u32x4 q0, q1;
                                    q0.x = cvtpk_s(mt[0], mt[1]); q0.y = cvtpk_s(mt[2], mt[3]); q0.z = cvtpk_s(mt[4], mt[5]); q0.w = cvtpk_s(mt[6], mt[7]);
                                    q1.x = cvtpk_s(mt[8], mt[9]); q1.y = cvtpk_s(mt[10], mt[11]); q1.z = cvtpk_s(mt[12], mt[13]); q1.w = cvtpk_s(mt[14], mt[15]);
                                    o[k] = __builtin_amdgcn_mfma_f32_32x32x16_bf16(__builtin_bit_cast(bf16x8, xc[0]), __builtin_bit_cast(bf16x8, q0), o[k], 0, 0, 0);
                                    o[k] = __builtin_amdgcn_mfma_f32_32x32x16_bf16(__builtin_bit_cast(bf16x8, xc[1]), __builtin_bit_cast(bf16x8, q1), o[k], 0, 0, 0);
                                }
                            }
                            if (i == jtd) {
                                float ss = 0.f;
#pragma unroll
                                for (int rq = 0; rq < 4; ++rq) {
                                    const u32x2 z0 = zr[rq];
                                    const float za[4] = {__builtin_bit_cast(float, z0.x << 16), __builtin_bit_cast(float, z0.x & 0xffff0000u), __builtin_bit_cast(float, z0.y << 16), __builtin_bit_cast(float, z0.y & 0xffff0000u)};
#pragma unroll
                                    for (int e = 0; e < 4; ++e) { o[kd][4 * rq + e] *= silu_f(za[e]); ss += o[kd][4 * rq + e] * o[kd][4 * rq + e]; }
                                }
                                ss += pg8::shx(ss, lane, 32);
                                if (hi == 0) (pt == 0 ? ssb : ssb2)[kd * 256 + wave * 32 + r32] = ss;
                                if (pt == 0) {
                                    u32x4 h0, h1;
                                    h0.x = pk2(o[kd][0], o[kd][1]); h0.y = pk2(o[kd][2], o[kd][3]); h0.z = pk2(o[kd][4], o[kd][5]); h0.w = pk2(o[kd][6], o[kd][7]);
                                    h1.x = pk2(o[kd][8], o[kd][9]); h1.y = pk2(o[kd][10], o[kd][11]); h1.z = pk2(o[kd][12], o[kd][13]); h1.w = pk2(o[kd][14], o[kd][15]);
                                    *(u32x4*)(hpark + kd * 2048 + lane * 16) = h0; *(u32x4*)(hpark + kd * 2048 + 1024 + lane * 16) = h1; }
                            }
                            xc[0] = xn[0]; xc[1] = xn[1];
                        }
                    }
                    if (pt == 1) {
                        const float* ngp = ng + h * 64 + 4 * hi;
                        f32x4 gq0[4], gq1[4];
#pragma unroll
                        for (int rq = 0; rq < 4; ++rq) { gq0[rq] = *(const f32x4*)(ngp + 8 * rq); gq1[rq] = *(const f32x4*)(ngp + 32 + 8 * rq); }
                        u32x4 hv[4][2];
#pragma unroll
                        for (int k = 0; k < 4; ++k) { hv[k][0] = *(const u32x4*)(hpark + k * 2048 + lane * 16); hv[k][1] = *(const u32x4*)(hpark + k * 2048 + 1024 + lane * 16); }
                        __syncthreads();
                        LAS unsigned char* tb_ = CBl + wave * 4608;
#pragma unroll
                        for (int k = 0; k < 4; ++k) {
                            const int jt = (k == 0) ? jt0 : (k == 1) ? jt1 : (k == 2) ? jt2 : jt3;
                            float tot = 0.f;
#pragma unroll
                            for (int w = 0; w < 8; ++w) tot += ssb[k * 256 + w * 32 + r32] + ssb2[k * 256 + w * 32 + r32];
                            const float rs = rsqrtf(tot * (1.0f / 512.0f) + RMS_EPS);
#pragma unroll
                            for (int rq = 0; rq < 4; ++rq) {
                                const f32x4 g0 = gq0[rq], g1 = gq1[rq];
                                u32x2 w0, w1;
                                const u32x4 hq = hv[k][rq >> 1]; const unsigned ha = (rq & 1) ? hq.z : hq.x, hb = (rq & 1) ? hq.w : hq.y;
                                w0.x = pk2(__builtin_bit_cast(float, ha << 16) * rs * g0.x, __builtin_bit_cast(float, ha & 0xffff0000u) * rs * g0.y); w0.y = pk2(__builtin_bit_cast(float, hb << 16) * rs * g0.z, __builtin_bit_cast(float, hb & 0xffff0000u) * rs * g0.w);
                                w1.x = pk2(o[k][4 * rq] * rs * g1.x, o[k][4 * rq + 1] * rs * g1.y); w1.y = pk2(o[k][4 * rq + 2] * rs * g1.z, o[k][4 * rq + 3] * rs * g1.w);
                                *(LAS u32x2*)(tb_ + r32 * 144 + rq * 16 + hi * 8) = w0; *(LAS u32x2*)(tb_ + r32 * 144 + 64 + rq * 16 + hi * 8) = w1;
                            }
                            bf16* op = MIXED + ((size_t)r0 + 32 * jt + (lane >> 3)) * D + 512 + h * 64 + (lane & 7) * 8;
#pragma unroll
                            for (int j = 0; j < 4; ++j) *(u32x4*)(op + (size_t)(8 * j) * D) = *(const LAS u32x4*)(tb_ + ((lane >> 3) + 8 * j) * 144 + (lane & 7) * 16);
                        }
                    }
                }
#undef XLOAD
#undef ZLOAD
#undef SLOAD
                __syncthreads();
            }
        }
        PH_END_T(args.ws + WS_WOUT + (size_t)l * WOUT_STRIDE * 2, WOUT_STRIDE * 2);
#endif
#ifndef NO_WOUT
        if (PH_ON) {
            WS_BASE();
            pg8::StaticOrder S; S.init(M, D, G, bx);
            pg8::Gemm g{MIXED, WOUT + (size_t)l * WOUT_STRIDE, M, D, D};
            pg8::EpiResid E{HB, PART, 1.0f / REP_WOUT};
            pg8::gemm_phase<pg8::EpiResid, pg8::StaticOrder, true, true>(L + RING_OFF, g, S, E);
        }
#if REP_WOUT == 2
        if (PH_ON) {
            WS_BASE();
            pg8::StaticOrder S; S.init(M, D, G, bx);
            pg8::Gemm g{MIXED, WOUT + (size_t)l * WOUT_STRIDE, M, D, D};
            pg8::EpiResid E{HB, PART, 1.0f / REP_WOUT};
            pg8::gemm_phase<pg8::EpiResid, pg8::StaticOrder, true, true>(L + RING_OFF, g, S, E);
        }
#endif
#endif
        PH_END_T(args.ws + WS_WGU + (size_t)(i + 1) * WGU_STRIDE * 2, WGU_STRIDE * 2);
    }
    if (PH_ON) {
        LANE_IDS();
        const float* fg = args.in[20];
        f32x4 gg[8];
#pragma unroll
        for (int j = 0; j < 8; ++j) gg[j] = ((const GAS f32x4*)fg + lane)[64 * j];
        static_assert(M % (4 * GRID * NWAVES) == 0, "final norm: four rows per trip");
        for (int m0 = gw; m0 < M; m0 += 4 * NGW) {
            float ps[4]; unsigned long long q[4][8];
#pragma unroll
            for (int r = 0; r < 4; ++r) { const int m = m0 + r * NGW; ps[r] = (lane < 32) ? PART[(size_t)m * 32 + lane] : 0.f;
                const GAS unsigned long long* hr = (const GAS unsigned long long*)(HB + (size_t)m * D) + lane;
#pragma unroll
                for (int j = 0; j < 8; ++j) q[r][j] = hr[64 * j]; }
#pragma unroll
            for (int r = 0; r < 4; ++r) { const int m = m0 + r * NGW;
                const float rs = rsqrtf(wave_sum(ps[r], lane) * (1.0f / D) + RMS_EPS);
                GAS f32x4* orow = (GAS f32x4*)(args.out + (size_t)m * D) + lane;
#pragma unroll
                for (int j = 0; j < 8; ++j) { const unsigned lo_ = (unsigned)q[r][j], hi_ = (unsigned)(q[r][j] >> 32);
                    f32x4 v; v.x = __builtin_bit_cast(float, lo_ << 16); v.y = __builtin_bit_cast(float, lo_ & 0xffff0000u); v.z = __builtin_bit_cast(float, hi_ << 16); v.w = __builtin_bit_cast(float, hi_ & 0xffff0000u);
                    orow[64 * j] = v * rs * gg[j]; }
            }
        }
    }
#undef PH_ON
#undef PH_END
#undef PH_END_T
}

constexpr int N_PHASES = 1 + 8 * 2 + 4 * 6 + 1;
#ifndef MK_PER_PHASE
#define MK_PER_PHASE 0
#endif
extern "C" void kernel_launch(void* const* d_in, const int* in_sizes, int n_in, void* d_out, int out_size, void* d_ws, size_t ws_size, hipStream_t stream) {
    static int ok = 0;
    if (ok == 0) {
        if (n_in != 21 || in_sizes[0] != M * D || out_size != M * D || ws_size < WS_END) { fprintf(stderr, "kernel_launch: unexpected shapes / workspace (%d inputs, ws %zu < %zu)\n", n_in, ws_size, (size_t)WS_END); ok = -1; return; }
        int dev = 0, cus = 0;
        if (hipGetDevice(&dev) != hipSuccess || hipDeviceGetAttribute(&cus, hipDeviceAttributeMultiprocessorCount, dev) != hipSuccess || cus < GRID) { fprintf(stderr, "kernel_launch: needs %d CUs, device has %d\n", GRID, cus); ok = -1; return; }
        if (hipFuncSetAttribute((const void*)fwd, hipFuncAttributeMaxDynamicSharedMemorySize, LDS_BYTES) != hipSuccess) { fprintf(stderr, "kernel_launch: hipFuncSetAttribute failed\n"); ok = -1; return; }
        int per_cu = 0;
        if (hipOccupancyMaxActiveBlocksPerMultiprocessor(&per_cu, (const void*)fwd, NWAVES * 64, LDS_BYTES) != hipSuccess || per_cu < 1) { fprintf(stderr, "kernel_launch: occupancy query says %d blocks per CU\n", per_cu); }
        (void)hipGetLastError();
        ok = 1;
    }
    if (ok < 0) return;
    if (hipMemsetAsync((char*)d_ws + WS_CTL, 0, CTL_ZERO_BYTES, stream) != hipSuccess) return;
    Args a{};
    for (int i = 0; i < 21; ++i) a.in[i] = (const float*)d_in[i];
    a.out = (float*)d_out; a.ws = (unsigned char*)d_ws;
#if MK_PER_PHASE
    for (int p = 0; p < N_PHASES; ++p) { a.ph_lo = p; a.ph_hi = p + 1; hipLaunchKernelGGL(fwd, dim3(GRID), dim3(NWAVES * 64), LDS_BYTES, stream, a); }
#else
    a.ph_lo = 0; a.ph_hi = N_PHASES;
    hipLaunchKernelGGL(fwd, dim3(GRID), dim3(NWAVES * 64), LDS_BYTES, stream, a);
#endif
}
```
